# Optimizing an MI355X kernel written in HIP

```python
import jax, jax.numpy as jnp
from jax import lax
import numpy as np

D_MODEL = 1024
BATCH = 4
SEQ = 4096
DEPTH = 4
DEC_BATCH = 128
DEC_SEQ = 8
PAST_LEN = 8192
PAGE_SIZE = 128

N_MIXERS = 3
N_ATTN = (DEPTH + 2) // 3
N_RGLRU = (DEPTH + 1) // 3
N_SCONV = DEPTH // 3

HEAD_DIM = 64
N_HEADS = D_MODEL // HEAD_DIM
N_KV_HEADS = max(1, N_HEADS // 8)
GQA_GROUP = N_HEADS // N_KV_HEADS
Q_DIM = N_HEADS * HEAD_DIM
KV_DIM = N_KV_HEADS * HEAD_DIM
WINDOW = 128
ROPE_THETA = 10000.0
NEG_INF = -1e30

D_RNN = D_MODEL
RG_BLOCKS = 4
RG_BLOCK_W = D_RNN // RG_BLOCKS
RG_CONV_W = 4
RG_C = 8.0

D_SCONV = D_MODEL
SCONV_W = 3

D_FF = -(-8 * D_MODEL // (3 * 256)) * 256

EPS = 1e-6

kernel_name = "hybrid_swa_rglru_shortconv_decoder_step"


def rmsnorm(x, g):
    xf = x.astype(jnp.float32)
    y = xf * lax.rsqrt(jnp.mean(xf * xf, axis=-1, keepdims=True) + EPS)
    return (y * g.astype(jnp.float32)).astype(x.dtype)


def rope(x, pos):
    half = HEAD_DIM // 2
    inv = ROPE_THETA ** (-jnp.arange(half, dtype=jnp.float32) / half)
    ang = pos.astype(jnp.float32)[:, None] * inv[None, :]
    cos = jnp.cos(ang)[None, :, None, :]
    sin = jnp.sin(ang)[None, :, None, :]
    xf = x.astype(jnp.float32)
    x1, x2 = xf[..., :half], xf[..., half:]
    out = jnp.concatenate([x1 * cos - x2 * sin, x2 * cos + x1 * sin], axis=-1)
    return out.astype(x.dtype)


def swa_project(h, w_qkv, b_qkv, pos):
    B, T, _ = h.shape
    qkv = h @ w_qkv + b_qkv
    q = qkv[..., :Q_DIM].reshape(B, T, N_HEADS, HEAD_DIM)
    k = qkv[..., Q_DIM:Q_DIM + KV_DIM].reshape(B, T, N_KV_HEADS, HEAD_DIM)
    v = qkv[..., Q_DIM + KV_DIM:].reshape(B, T, N_KV_HEADS, HEAD_DIM)
    q = rope(q, pos).reshape(B, T, N_KV_HEADS, GQA_GROUP, HEAD_DIM)
    k = rope(k, pos)
    return q, k, v


def attn_core(q, k, v, mask, sinks):
    s = jnp.einsum('...qkgd,...skd->...kgqs', q.astype(jnp.float32), k.astype(jnp.float32)) * (HEAD_DIM ** -0.5)
    s = jnp.where(mask, s, NEG_INF)
    sink = jnp.broadcast_to(sinks.astype(jnp.float32).reshape(N_KV_HEADS, GQA_GROUP, 1, 1), s.shape[:-1] + (1,))
    p = jax.nn.softmax(jnp.concatenate([s, sink], axis=-1), axis=-1)[..., :-1]
    return jnp.einsum('...kgqs,...skd->...qkgd', p.astype(v.dtype), v)


def swa_prompt(h, w_qkv, b_qkv, w_o, b_o, sinks):
    B, T, _ = h.shape
    pos = jnp.arange(T, dtype=jnp.int32)
    q, k, v = swa_project(h, w_qkv, b_qkv, pos)
    nb = T // WINDOW
    qb = q.reshape(B, nb, WINDOW, N_KV_HEADS, GQA_GROUP, HEAD_DIM)
    kb = k.reshape(B, nb, WINDOW, N_KV_HEADS, HEAD_DIM)
    vb = v.reshape(B, nb, WINDOW, N_KV_HEADS, HEAD_DIM)
    kk = jnp.concatenate([jnp.concatenate([jnp.zeros_like(kb[:, :1]), kb[:, :-1]], axis=1), kb], axis=2)
    vv = jnp.concatenate([jnp.concatenate([jnp.zeros_like(vb[:, :1]), vb[:, :-1]], axis=1), vb], axis=2)
    i = jnp.arange(WINDOW)[:, None]
    c = jnp.arange(2 * WINDOW)[None, :]
    diff = i + WINDOW - c
    blk = jnp.arange(nb)[:, None, None]
    mask = (diff >= 0) & (diff < WINDOW) & (blk * WINDOW + c - WINDOW >= 0)
    o = attn_core(qb, kk, vv, mask[:, None, None], sinks)
    out = o.reshape(B, T, Q_DIM) @ w_o + b_o
    return out, k[:, T - WINDOW:], v[:, T - WINDOW:]


def swa_sample(h, ck, cv, w_qkv, b_qkv, w_o, b_o, sinks):
    B, T, _ = h.shape
    pos = PAST_LEN + jnp.arange(T, dtype=jnp.int32)
    q, k, v = swa_project(h, w_qkv, b_qkv, pos)
    kk = jnp.concatenate([ck.astype(k.dtype), k], axis=1)
    vv = jnp.concatenate([cv.astype(v.dtype), v], axis=1)
    i = jnp.arange(T)[:, None]
    c = jnp.arange(WINDOW + T)[None, :]
    diff = i + WINDOW - c
    mask = (diff >= 0) & (diff < WINDOW)
    o = attn_core(q, kk, vv, mask, sinks)
    out = o.reshape(B, T, Q_DIM) @ w_o + b_o
    return out, kk[:, T:], vv[:, T:]


def causal_dwconv(u, buf, w):
    T = u.shape[1]
    kw = w.shape[0]
    ext = jnp.concatenate([buf.astype(u.dtype), u], axis=1)
    y = ext[:, 0:T] * w[0]
    for j in range(1, kw):
        y = y + ext[:, j:j + T] * w[j]
    return y, ext[:, -(kw - 1):]


def linear_recurrence(a, b, h0):
    def combine(left, right):
        a1, b1 = left
        a2, b2 = right
        return a1 * a2, a2 * b1 + b2
    a_cum, b_cum = lax.associative_scan(combine, (a, b), axis=1)
    return a_cum * h0[:, None] + b_cum


def rglru_mixer(h, h0, conv_buf, w_gate, w_in, conv_w, conv_b, wa, ba, wx, bx, lam, w_out):
    B, T, _ = h.shape
    gate = jax.nn.gelu(h @ w_gate)
    u, new_buf = causal_dwconv(h @ w_in, conv_buf, conv_w)
    u = u + conv_b
    ub = u.reshape(B, T, RG_BLOCKS, RG_BLOCK_W)
    r = jax.nn.sigmoid(jnp.einsum('btnd,nde->btne', ub, wa).reshape(B, T, D_RNN) + ba)
    ig = jax.nn.sigmoid(jnp.einsum('btnd,nde->btne', ub, wx).reshape(B, T, D_RNN) + bx)
    log_a = RG_C * r.astype(jnp.float32) * jax.nn.log_sigmoid(lam.astype(jnp.float32))
    a = jnp.exp(log_a)
    mult = jnp.sqrt(-jnp.expm1(2.0 * log_a))
    hs = linear_recurrence(a, mult * (ig * u).astype(jnp.float32), h0.astype(jnp.float32))
    y = (hs.astype(h.dtype) * gate) @ w_out
    return y, hs[:, -1].astype(h0.dtype), new_buf


def sconv_mixer(h, buf, w_in, conv_w, w_out):
    bcx = h @ w_in
    bg = bcx[..., :D_SCONV]
    cg = bcx[..., D_SCONV:2 * D_SCONV]
    xv = bcx[..., 2 * D_SCONV:]
    y, new_buf = causal_dwconv(cg * xv, buf, conv_w)
    return (bg * y) @ w_out, new_buf


def swiglu(h, wg, wu, wd):
    return (jax.nn.silu(h @ wg) * (h @ wu)) @ wd


def setup_inputs(seed: int = 0) -> dict:
    key = jax.random.key(seed)
    keys = iter(jax.random.split(key, 64))

    def nrm(shape, scale):
        return scale * jax.random.normal(next(keys), shape, jnp.float32)

    x_prompt = nrm((BATCH, SEQ, D_MODEL), 1.0)
    x_sample = nrm((DEC_BATCH, DEC_SEQ, D_MODEL), 1.0)
    cache_k = nrm((N_ATTN, DEC_BATCH, WINDOW, N_KV_HEADS, HEAD_DIM), 1.0)
    cache_v = nrm((N_ATTN, DEC_BATCH, WINDOW, N_KV_HEADS, HEAD_DIM), 1.0)
    state_rglru_h = nrm((N_RGLRU, DEC_BATCH, D_RNN), 0.5)
    state_rglru_conv = nrm((N_RGLRU, DEC_BATCH, RG_CONV_W - 1, D_RNN), 1.0)
    state_shortconv = nrm((N_SCONV, DEC_BATCH, SCONV_W - 1, D_SCONV), 1.0)
    norm_mixer = 1.0 + nrm((DEPTH, D_MODEL), 0.02)
    norm_ffn = 1.0 + nrm((DEPTH, D_MODEL), 0.02)
    norm_final = 1.0 + nrm((D_MODEL,), 0.02)
    attn_w_qkv = nrm((N_ATTN, D_MODEL, Q_DIM + 2 * KV_DIM), D_MODEL ** -0.5)
    attn_b_qkv = nrm((N_ATTN, Q_DIM + 2 * KV_DIM), 0.02)
    attn_w_o = nrm((N_ATTN, Q_DIM, D_MODEL), Q_DIM ** -0.5)
    attn_b_o = nrm((N_ATTN, D_MODEL), 0.02)
    attn_sinks = nrm((N_ATTN, N_HEADS), 0.5)
    rglru_w_gate = nrm((N_RGLRU, D_MODEL, D_RNN), D_MODEL ** -0.5)
    rglru_w_in = nrm((N_RGLRU, D_MODEL, D_RNN), D_MODEL ** -0.5)
    rglru_conv_w = nrm((N_RGLRU, RG_CONV_W, D_RNN), RG_CONV_W ** -0.5)
    rglru_conv_b = nrm((N_RGLRU, D_RNN), 0.02)
    rglru_wa = nrm((N_RGLRU, RG_BLOCKS, RG_BLOCK_W, RG_BLOCK_W), RG_BLOCK_W ** -0.5)
    rglru_ba = nrm((N_RGLRU, D_RNN), 0.02)
    rglru_wx = nrm((N_RGLRU, RG_BLOCKS, RG_BLOCK_W, RG_BLOCK_W), RG_BLOCK_W ** -0.5)
    rglru_bx = nrm((N_RGLRU, D_RNN), 0.02)
    a_c = jax.random.uniform(next(keys), (N_RGLRU, D_RNN), jnp.float32, 0.9, 0.999)
    sig = a_c ** (1.0 / RG_C)
    rglru_lambda = jnp.log(sig) - jnp.log1p(-sig)
    rglru_w_out = nrm((N_RGLRU, D_RNN, D_MODEL), D_RNN ** -0.5)
    sconv_w_in = nrm((N_SCONV, D_MODEL, 3 * D_SCONV), D_MODEL ** -0.5)
    sconv_conv_w = nrm((N_SCONV, SCONV_W, D_SCONV), SCONV_W ** -0.5)
    sconv_w_out = nrm((N_SCONV, D_SCONV, D_MODEL), D_SCONV ** -0.5)
    ffn_w_gate = nrm((DEPTH, D_MODEL, D_FF), D_MODEL ** -0.5)
    ffn_w_up = nrm((DEPTH, D_MODEL, D_FF), D_MODEL ** -0.5)
    ffn_w_down = nrm((DEPTH, D_FF, D_MODEL), D_FF ** -0.5)
    return {
        "x_prompt": x_prompt, "x_sample": x_sample,
        "cache_k": cache_k, "cache_v": cache_v,
        "state_rglru_h": state_rglru_h, "state_rglru_conv": state_rglru_conv,
        "state_shortconv": state_shortconv,
        "norm_mixer": norm_mixer, "norm_ffn": norm_ffn, "norm_final": norm_final,
        "attn_w_qkv": attn_w_qkv, "attn_b_qkv": attn_b_qkv, "attn_w_o": attn_w_o,
        "attn_b_o": attn_b_o, "attn_sinks": attn_sinks,
        "rglru_w_gate": rglru_w_gate, "rglru_w_in": rglru_w_in, "rglru_conv_w": rglru_conv_w,
        "rglru_conv_b": rglru_conv_b, "rglru_wa": rglru_wa, "rglru_ba": rglru_ba,
        "rglru_wx": rglru_wx, "rglru_bx": rglru_bx, "rglru_lambda": rglru_lambda,
        "rglru_w_out": rglru_w_out,
        "sconv_w_in": sconv_w_in, "sconv_conv_w": sconv_conv_w, "sconv_w_out": sconv_w_out,
        "ffn_w_gate": ffn_w_gate, "ffn_w_up": ffn_w_up, "ffn_w_down": ffn_w_down,
    }


def reference(x_prompt, x_sample, cache_k, cache_v, state_rglru_h, state_rglru_conv, state_shortconv,
              norm_mixer, norm_ffn, norm_final,
              attn_w_qkv, attn_b_qkv, attn_w_o, attn_b_o, attn_sinks,
              rglru_w_gate, rglru_w_in, rglru_conv_w, rglru_conv_b, rglru_wa, rglru_ba,
              rglru_wx, rglru_bx, rglru_lambda, rglru_w_out,
              sconv_w_in, sconv_conv_w, sconv_w_out,
              ffn_w_gate, ffn_w_up, ffn_w_down):
    xp, xs = x_prompt, x_sample
    Bp = xp.shape[0]
    kp_l, vp_l, ks_l, vs_l = [], [], [], []
    hp_l, hs_l, rcp_l, rcs_l = [], [], [], []
    scp_l, scs_l = [], []
    for i in range(DEPTH):
        kind = i % N_MIXERS
        j = i // N_MIXERS
        hp = rmsnorm(xp, norm_mixer[i])
        hs = rmsnorm(xs, norm_mixer[i])
        if kind == 0:
            mp, kp, vp = swa_prompt(hp, attn_w_qkv[j], attn_b_qkv[j], attn_w_o[j], attn_b_o[j], attn_sinks[j])
            ms, ks, vs = swa_sample(hs, cache_k[j], cache_v[j], attn_w_qkv[j], attn_b_qkv[j],
                                    attn_w_o[j], attn_b_o[j], attn_sinks[j])
            kp_l.append(kp); vp_l.append(vp); ks_l.append(ks); vs_l.append(vs)
        elif kind == 1:
            rg = (rglru_w_gate[j], rglru_w_in[j], rglru_conv_w[j], rglru_conv_b[j], rglru_wa[j],
                  rglru_ba[j], rglru_wx[j], rglru_bx[j], rglru_lambda[j], rglru_w_out[j])
            h0p = jnp.zeros((Bp, D_RNN), xp.dtype)
            bufp = jnp.zeros((Bp, RG_CONV_W - 1, D_RNN), xp.dtype)
            mp, hfp, rcp = rglru_mixer(hp, h0p, bufp, *rg)
            ms, hfs, rcs = rglru_mixer(hs, state_rglru_h[j], state_rglru_conv[j], *rg)
            hp_l.append(hfp); hs_l.append(hfs); rcp_l.append(rcp); rcs_l.append(rcs)
        else:
            bufp = jnp.zeros((Bp, SCONV_W - 1, D_SCONV), xp.dtype)
            mp, scp = sconv_mixer(hp, bufp, sconv_w_in[j], sconv_conv_w[j], sconv_w_out[j])
            ms, scs = sconv_mixer(hs, state_shortconv[j], sconv_w_in[j], sconv_conv_w[j], sconv_w_out[j])
            scp_l.append(scp); scs_l.append(scs)
        xp = xp + mp
        xs = xs + ms
        xp = xp + swiglu(rmsnorm(xp, norm_ffn[i]), ffn_w_gate[i], ffn_w_up[i], ffn_w_down[i])
        xs = xs + swiglu(rmsnorm(xs, norm_ffn[i]), ffn_w_gate[i], ffn_w_up[i], ffn_w_down[i])
    y_prompt = rmsnorm(xp, norm_final)
    y_sample = rmsnorm(xs, norm_final)
    new_k_prompt = jnp.stack(kp_l)
    new_v_prompt = jnp.stack(vp_l)
    new_k_sample = jnp.stack(ks_l)
    new_v_sample = jnp.stack(vs_l)
    new_h_prompt = jnp.stack(hp_l)
    new_h_sample = jnp.stack(hs_l)
    new_rconv_prompt = jnp.stack(rcp_l)
    new_rconv_sample = jnp.stack(rcs_l)
    new_sconv_prompt = jnp.stack(scp_l)
    new_sconv_sample = jnp.stack(scs_l)
    return (y_prompt, y_sample, new_k_prompt, new_v_prompt, new_k_sample, new_v_sample,
            new_h_prompt, new_h_sample, new_rconv_prompt, new_rconv_sample,
            new_sconv_prompt, new_sconv_sample)
```

```cpp
#include <hip/hip_runtime.h>
#include <hip/hip_cooperative_groups.h>
#include <cstdint>
#include <cstdio>
namespace cg = cooperative_groups;
#ifndef REP_MASK
#define REP_MASK 0
#endif
constexpr int NSPLIT_MIX = 4, NSPLIT_FFN = 8;
#ifndef EXTRA_SYNC
#define EXTRA_SYNC 0
#endif

#define LAS __attribute__((address_space(3)))
typedef unsigned short bf16_t;
typedef short bf16x8 __attribute__((ext_vector_type(8)));
typedef short s16x4 __attribute__((ext_vector_type(4)));
typedef float f32x4 __attribute__((ext_vector_type(4)));
typedef float f32x2 __attribute__((ext_vector_type(2)));
typedef float f32x16 __attribute__((ext_vector_type(16)));
typedef unsigned u32x4 __attribute__((ext_vector_type(4)));
typedef unsigned u32x2 __attribute__((ext_vector_type(2)));

constexpr int DM = 1024, MP = 16384, MS = 1024, M = MP + MS, SEQ = 4096, DFF = 2816, NQKV = 1280;
constexpr float EPS = 1e-6f, LOG2E = 1.4426950408889634f;
constexpr size_t MiB = 1u << 20;
constexpr size_t WS_ROPE = 1 * MiB;
constexpr size_t WS_SS = 5 * MiB;
constexpr size_t WS_ZB = 3 * MiB + 65536;
constexpr size_t WS_C8 = 3 * MiB;
constexpr size_t WS_WQKV = 8 * MiB;
constexpr size_t WS_WO = 13 * MiB;
constexpr size_t WS_WFU = 17 * MiB;
constexpr size_t WS_WFD = 61 * MiB;
constexpr size_t WS_WRG1 = 83 * MiB, WS_WRG2 = 87 * MiB, WS_WRG3 = 88 * MiB, WS_WSC1 = 90 * MiB, WS_WSC2 = 96 * MiB;
constexpr size_t WS_XN = 98 * MiB;
constexpr size_t SLOT = 34 * MiB;
constexpr size_t WS_S0 = 132 * MiB, WS_S1 = WS_S0 + SLOT, WS_S2 = WS_S1 + SLOT, WS_S3 = WS_S2 + SLOT;
constexpr size_t O_KP = 17825792, O_VP = 17956864, O_KS = 18087936, O_VS = 22282240, O_HP = 26476544, O_HS = 26480640,
                 O_RCP = 26611712, O_RCS = 26624000, O_SCP = 27017216, O_SCS = 27025408;

constexpr int LDS_BYTES = 131072 + 1024;

__device__ __forceinline__ unsigned cvt_pk_bf16(float lo, float hi) { unsigned r; asm volatile("v_cvt_pk_bf16_f32 %0, %1, %2" : "=v"(r) : "v"(lo), "v"(hi)); return r; }
__device__ __forceinline__ float bf2f(unsigned short v) { return __uint_as_float(((unsigned)v) << 16); }
__device__ __forceinline__ float bflo(unsigned w) { return __uint_as_float(w << 16); }
__device__ __forceinline__ float bfhi(unsigned w) { return __uint_as_float(w & 0xffff0000u); }
__device__ __forceinline__ float fast_sigmoid(float x) { return __builtin_amdgcn_rcpf(1.0f + __builtin_amdgcn_exp2f(-x * LOG2E)); }
__device__ __forceinline__ float wave_sum(float v) {
#pragma unroll
    for (int o = 1; o < 64; o <<= 1) v += __shfl_xor(v, o);
    return v;
}

namespace pg8 {
constexpr int BM = 256, BK = 64, HALF = 128, HTB = HALF * BK * 2, STAGE_BYTES = 8 * HTB;
__device__ __forceinline__ int lds_byte(int r, int c) { const int st = (r >> 4) * 2 + (c >> 5), rr = r & 15, cc = c & 31, ob = rr * 64 + cc * 2; return st * 1024 + (ob ^ (((ob >> 9) & 1) << 5)); }
__device__ __forceinline__ void stage_rc(int b, int& R, int& C) { const int st = b / 1024, sb = b % 1024, swz = sb ^ (((sb >> 9) & 1) << 5); R = (st >> 1) * 16 + swz / 64; C = (st & 1) * 32 + (swz % 64) / 2; }
__device__ __forceinline__ int perm32(int rho) { const int n = rho >> 4, i = rho & 15; return 8 * (i >> 2) + 4 * n + (i & 3); }

struct Unit { int pm, pn, nt, aux; const char* a; const char* b; };

struct GSched {
    const char* A; const char* Bt; int lda, ldb, nN, nt, mode, G, c, nsplit; unsigned* cnt;
    __device__ __forceinline__ bool next(int i, Unit& u) const {
        int L = i * G + c; const int nP = 64 * nN; int kt0 = 0; u.nt = nt; u.aux = 0;
        if (mode == 1) {
            const int nS = 4 * nsplit * nN;
            if (L < nS) {
                const int sl = L % nsplit; u.pn = (L / nsplit) % nN; u.pm = 64 + (L / nsplit) / nN; u.aux = 1 + sl;
                const int q = (nt / (2 * nsplit)) * 2, extra = (nt - nsplit * q) >> 1;
                u.nt = sl < extra ? q + 2 : q; kt0 = sl < extra ? sl * (q + 2) : extra * (q + 2) + (sl - extra) * q;
            } else {
                L -= nS; if (L >= nP) return false;
                const int g = L / (8 * nN), r = L - g * 8 * nN; u.pm = 8 * g + (r & 7); u.pn = r >> 3;
            }
        } else if (L < nP) { const int g = L / (8 * nN), r = L - g * 8 * nN; u.pm = 8 * g + (r & 7); u.pn = r >> 3; }
        else { L -= nP; if (L >= 4 * nN) return false; u.pm = 64 + (L & 3); u.pn = L >> 2; }
        u.a = A + ((size_t)u.pm * 256 * lda + (size_t)kt0 * 64 + (mode == 2 ? 256 * (u.pn >> 1) : 0)) * 2;
        u.b = Bt + ((size_t)u.pn * 256 * ldb + (size_t)kt0 * 64) * 2;
        return true;
    }
};

template <int LDA, int LDB, class Epi>
__device__ __forceinline__ void gemm_phase(LAS unsigned char* lds, const GSched& S, const Epi& E, const int tid) {
    const int wid = __builtin_amdgcn_readfirstlane(tid >> 6), lane = tid & 63, wr = wid >> 2, wc = wid & 3, fr = lane & 15, fq = lane >> 4;
    constexpr int lda = LDA, ldb = LDB;
    unsigned voffA[2], voffB[2];
#pragma unroll
    for (int i = 0; i < 2; ++i) { int R, C; stage_rc(tid * 16 + i * 8192, R, C); const int Rb = Epi::PERM ? ((R & ~31) + perm32(R & 31)) : R;
        voffA[i] = (unsigned)(R * lda + C) * 2u; voffB[i] = (unsigned)(Rb * ldb + C) * 2u; }
    const size_t kstep = (size_t)(BK * 2);
    const size_t hstepA = (size_t)HALF * lda * 2, hstepB = (size_t)HALF * ldb * 2;
    const unsigned ldsw = (unsigned)wid * 1024u;
    const int aoff = lds_byte(wr * 64 + fr, fq * 8), boff = lds_byte(wc * 32 + fr, fq * 8);
#define PG8_SA(b, h) (((b) * 2 + (h)) * HTB)
#define PG8_SB(b, h) ((4 + (b) * 2 + (h)) * HTB)
#define PG8_STAGE(bufoff, gbase, voff) do { _Pragma("unroll") for (int _i = 0; _i < 2; ++_i) \
        __builtin_amdgcn_global_load_lds((const unsigned*)((const char*)(gbase) + (voff)[_i]), (LAS unsigned*)(lds + (bufoff) + ldsw + _i * 8192), 16, 0, 0); } while (0)
#define PG8_LDA(dst, b, h) do { _Pragma("unroll") for (int m = 0; m < 4; ++m) _Pragma("unroll") for (int k = 0; k < 2; ++k) dst[m][k] = *(const LAS bf16x8*)(lds + PG8_SA(b, h) + aoff + m * 2048 + k * 1024); } while (0)
#define PG8_LDB(dst, b, h) do { _Pragma("unroll") for (int n = 0; n < 2; ++n) _Pragma("unroll") for (int k = 0; k < 2; ++k) dst[n][k] = *(const LAS bf16x8*)(lds + PG8_SB(b, h) + boff + n * 2048 + k * 1024); } while (0)
#define PG8_MMA(ai, bj, At, Bt) do { __builtin_amdgcn_s_setprio(1); _Pragma("unroll") for (int m = 0; m < 4; ++m) _Pragma("unroll") for (int n = 0; n < 2; ++n) _Pragma("unroll") for (int k = 0; k < 2; ++k) \
        acc[ai][bj][m][n] = __builtin_amdgcn_mfma_f32_16x16x32_bf16(Bt[n][k], At[m][k], acc[ai][bj][m][n], 0, 0, 0); __builtin_amdgcn_s_setprio(0); } while (0)
#define PG8_WAIT_V(n) asm volatile("s_waitcnt vmcnt(" #n ")" ::: "memory")
#define PG8_WAIT_L(n) asm volatile("s_waitcnt lgkmcnt(" #n ")" ::: "memory")
#define PG8_BAR __builtin_amdgcn_s_barrier()
#define PG8_SCHED __builtin_amdgcn_sched_barrier(0)
    Unit cur, nxt; int ui = 0;
    if (!S.next(0, cur)) return;
    f32x4 acc[2][2][4][2];
#pragma unroll
    for (int a = 0; a < 2; ++a)
#pragma unroll
        for (int b = 0; b < 2; ++b)
#pragma unroll
            for (int m = 0; m < 4; ++m)
#pragma unroll
                for (int n = 0; n < 2; ++n) acc[a][b][m][n] = (f32x4){0.f, 0.f, 0.f, 0.f};
    bf16x8 At[4][2], B0[2][2], B1[2][2];
    const char* cA = cur.a; const char* cB = cur.b;
    PG8_STAGE(PG8_SB(0, 0), cB, voffB); PG8_STAGE(PG8_SB(0, 1), cB + hstepB, voffB); PG8_STAGE(PG8_SA(0, 0), cA, voffA); PG8_STAGE(PG8_SA(0, 1), cA + hstepA, voffA);
    if (wr == 1) PG8_BAR;
    PG8_WAIT_V(2); PG8_BAR;
    PG8_STAGE(PG8_SB(1, 0), cB + kstep, voffB); PG8_STAGE(PG8_SA(1, 0), cA + kstep, voffA); PG8_STAGE(PG8_SB(1, 1), cB + hstepB + kstep, voffB);
    PG8_WAIT_V(6); PG8_BAR;
    for (;;) {
        const bool has_next = S.next(ui + 1, nxt);
        const char* nA = has_next ? nxt.a : cA; const char* nB = has_next ? nxt.b : cB;
        const int nt = cur.nt;
        for (int t = 0; t < nt; t += 2) {
            const bool last = (t == nt - 2);
            const char* a1 = cA + (size_t)(t + 1) * kstep;
            const char* a2 = last ? nA : cA + (size_t)(t + 2) * kstep; const char* b2 = last ? nB : cB + (size_t)(t + 2) * kstep;
            const char* a3 = a2 + kstep; const char* b3 = b2 + kstep;
            PG8_LDB(B0, 0, 0); PG8_LDB(B1, 0, 1); PG8_SCHED; PG8_LDA(At, 0, 0); PG8_STAGE(PG8_SA(1, 1), a1 + hstepA, voffA);
            PG8_WAIT_V(8); PG8_WAIT_L(0); PG8_BAR; PG8_MMA(0, 0, At, B0); PG8_MMA(0, 1, At, B1); PG8_BAR; PG8_SCHED;
            PG8_LDA(At, 0, 1); PG8_STAGE(PG8_SB(0, 0), b2, voffB); PG8_STAGE(PG8_SB(0, 1), b2 + hstepB, voffB); PG8_STAGE(PG8_SA(0, 0), a2, voffA);
            PG8_WAIT_V(8); PG8_WAIT_L(0); PG8_BAR; PG8_MMA(1, 0, At, B0); PG8_MMA(1, 1, At, B1); PG8_BAR; PG8_SCHED;
            PG8_LDB(B0, 1, 0); PG8_LDB(B1, 1, 1); PG8_SCHED; PG8_LDA(At, 1, 0); PG8_STAGE(PG8_SA(0, 1), a2 + hstepA, voffA);
            PG8_WAIT_V(8); PG8_WAIT_L(0); PG8_BAR; PG8_MMA(0, 0, At, B0); PG8_MMA(0, 1, At, B1); PG8_BAR; PG8_SCHED;
            PG8_LDA(At, 1, 1); PG8_STAGE(PG8_SB(1, 0), b3, voffB); PG8_STAGE(PG8_SB(1, 1), b3 + hstepB, voffB); PG8_STAGE(PG8_SA(1, 0), a3, voffA);
            PG8_WAIT_V(8); PG8_WAIT_L(0); PG8_BAR; PG8_MMA(1, 0, At, B0); PG8_MMA(1, 1, At, B1); PG8_BAR; PG8_SCHED;
        }
        if (wr == 0) PG8_BAR;
        E(acc, cur, wr, wc, fr, fq);
        if (cur.aux != 0 && S.cnt) {
            asm volatile("s_waitcnt vmcnt(0)" ::: "memory");
            if (lane == 0) __hip_atomic_fetch_add(S.cnt, 1u, __ATOMIC_RELAXED, __HIP_MEMORY_SCOPE_AGENT);
        }
        if (!has_next) break;
#pragma unroll
        for (int a = 0; a < 2; ++a)
#pragma unroll
            for (int b = 0; b < 2; ++b)
#pragma unroll
                for (int m = 0; m < 4; ++m)
#pragma unroll
                    for (int n = 0; n < 2; ++n) acc[a][b][m][n] = (f32x4){0.f, 0.f, 0.f, 0.f};
        cur = nxt; cA = nA; cB = nB; ++ui;
        if (wr == 1) PG8_BAR;
    }
    PG8_WAIT_V(0);
    PG8_BAR;
#undef PG8_SA
#undef PG8_SB
#undef PG8_STAGE
#undef PG8_LDA
#undef PG8_LDB
#undef PG8_MMA
#undef PG8_WAIT_V
#undef PG8_WAIT_L
#undef PG8_BAR
#undef PG8_SCHED
}

struct EpiQKV {
    static constexpr bool PERM = true;
    bf16_t* O; const float* bias; const float* rope; const float* rstd;
    __device__ __forceinline__ void operator()(const f32x4 (&acc)[2][2][4][2], const Unit& u, int wr, int wc, int fr, int fq) const {
        const int H = 4 * u.pn + wc, colb = H * 64 + 8 * fq;
        const f32x4 bl0 = *(const f32x4*)(bias + colb), bl1 = *(const f32x4*)(bias + colb + 4), bh0 = *(const f32x4*)(bias + colb + 32), bh1 = *(const f32x4*)(bias + colb + 36);
        const bool rot = H < 18;
        const int row0 = u.pm * 256 + wr * 64 + fr;
        float rs[8];
#pragma unroll
        for (int g = 0; g < 8; ++g) { const f32x4 sv = *(const f32x4*)(rstd + (size_t)(row0 + (g >> 2) * 128 + (g & 3) * 16) * 16 + 4 * fq);
            float s = (sv.x + sv.y) + (sv.z + sv.w); s += __shfl_xor(s, 16); s += __shfl_xor(s, 32); rs[g] = 1.0f / sqrtf(s * (1.f / DM) + EPS); }
        f32x4 cs[2][4];
#define QKV_LOADCS(g, b) do { const int row_ = row0 + ((g) >> 2) * 128 + ((g) & 3) * 16; const int pidx_ = row_ < MP ? (row_ & (SEQ - 1)) : SEQ + ((row_ - MP) & 7); \
            const float* rp_ = rope + (size_t)pidx_ * 64 + 8 * fq; cs[b][0] = *(const f32x4*)(rp_); cs[b][1] = *(const f32x4*)(rp_ + 4); cs[b][2] = *(const f32x4*)(rp_ + 32); cs[b][3] = *(const f32x4*)(rp_ + 36); } while (0)
        QKV_LOADCS(0, 0);
#pragma unroll
        for (int g = 0; g < 8; ++g) {
            const int ai = g >> 2, m = g & 3, b = g & 1;
            if (g + 1 < 8) QKV_LOADCS(g + 1, b ^ 1);
            const int row = row0 + ai * 128 + m * 16;
            f32x4 c0 = cs[b][0], c1 = cs[b][1], s0 = cs[b][2], s1 = cs[b][3];
            if (!rot) { c0 = (f32x4){1.f, 1.f, 1.f, 1.f}; c1 = c0; s0 = (f32x4){0.f, 0.f, 0.f, 0.f}; s1 = s0; }
            const float r = rs[g];
            const f32x4 l0 = acc[ai][0][m][0] * r + bl0, l1 = acc[ai][0][m][1] * r + bl1, h0 = acc[ai][1][m][0] * r + bh0, h1 = acc[ai][1][m][1] * r + bh1;
            const f32x4 ol0 = l0 * c0 - h0 * s0, ol1 = l1 * c1 - h1 * s1, oh0 = h0 * c0 + l0 * s0, oh1 = h1 * c1 + l1 * s1;
            bf16_t* op = O + (size_t)row * NQKV + colb;
            u32x4 w; w.x = cvt_pk_bf16(ol0[0], ol0[1]); w.y = cvt_pk_bf16(ol0[2], ol0[3]); w.z = cvt_pk_bf16(ol1[0], ol1[1]); w.w = cvt_pk_bf16(ol1[2], ol1[3]);
            *(u32x4*)op = w;
            w.x = cvt_pk_bf16(oh0[0], oh0[1]); w.y = cvt_pk_bf16(oh0[2], oh0[3]); w.z = cvt_pk_bf16(oh1[0], oh1[1]); w.w = cvt_pk_bf16(oh1[2], oh1[3]);
            *(u32x4*)(op + 32) = w;
        }
#undef QKV_LOADCS
    }
};
template <int MODE> struct EpiPair {
    static constexpr bool PERM = true;
    bf16_t* O0; bf16_t* O1; const float* rstd;
    __device__ __forceinline__ void operator()(const f32x4 (&acc)[2][2][4][2], const Unit& u, int wr, int wc, int fr, int fq) const {
        const int cc = 32 * wc + 8 * fq;
        float rsv[8];
#pragma unroll
        for (int g = 0; g < 8; ++g) { const f32x4 sv = *(const f32x4*)(rstd + (size_t)(u.pm * 256 + wr * 64 + fr + (g >> 2) * 128 + (g & 3) * 16) * 16 + 4 * fq);
            float s = (sv.x + sv.y) + (sv.z + sv.w); s += __shfl_xor(s, 16); s += __shfl_xor(s, 32); rsv[g] = 1.0f / sqrtf(s * (1.f / DM) + EPS); }
#pragma unroll
        for (int ai = 0; ai < 2; ++ai)
#pragma unroll
            for (int m = 0; m < 4; ++m) {
                const size_t row = (size_t)(u.pm * 256 + ai * 128 + wr * 64 + m * 16 + fr);
                const float rs = rsv[ai * 4 + m];
                f32x4 p0 = acc[ai][0][m][0] * rs, p1 = acc[ai][0][m][1] * rs, q0 = acc[ai][1][m][0] * rs, q1 = acc[ai][1][m][1] * rs;
                u32x4 w;
                if (MODE == 0) {
                    const float c1 = -rs * LOG2E, c2 = rs * rs;
                    const f32x4 a0 = acc[ai][0][m][0], a1 = acc[ai][0][m][1], b0 = acc[ai][1][m][0], b1 = acc[ai][1][m][1];
                    f32x4 t0 = a0 * c1, t1 = a1 * c1;
#pragma unroll
                    for (int j = 0; j < 4; ++j) { t0[j] = __builtin_amdgcn_exp2f(t0[j]); t1[j] = __builtin_amdgcn_exp2f(t1[j]); }
                    t0 = t0 + 1.0f; t1 = t1 + 1.0f;
#pragma unroll
                    for (int j = 0; j < 4; ++j) { t0[j] = __builtin_amdgcn_rcpf(t0[j]); t1[j] = __builtin_amdgcn_rcpf(t1[j]); }
                    p0 = (a0 * b0) * c2 * t0; p1 = (a1 * b1) * c2 * t1;
                    w.x = cvt_pk_bf16(p0[0], p0[1]); w.y = cvt_pk_bf16(p0[2], p0[3]); w.z = cvt_pk_bf16(p1[0], p1[1]); w.w = cvt_pk_bf16(p1[2], p1[3]);
                    *(u32x4*)(O0 + row * DFF + 128 * u.pn + cc) = w;
                } else if (MODE == 1) {
#pragma unroll
                    for (int j = 0; j < 4; ++j) { float x = p0[j]; p0[j] = x * fast_sigmoid(1.5957691216f * (x + 0.044715f * x * x * x)); x = p1[j]; p1[j] = x * fast_sigmoid(1.5957691216f * (x + 0.044715f * x * x * x)); }
                    w.x = cvt_pk_bf16(p0[0], p0[1]); w.y = cvt_pk_bf16(p0[2], p0[3]); w.z = cvt_pk_bf16(p1[0], p1[1]); w.w = cvt_pk_bf16(p1[2], p1[3]);
                    *(u32x4*)(O0 + row * DM + 128 * u.pn + cc) = w;
                    w.x = cvt_pk_bf16(q0[0], q0[1]); w.y = cvt_pk_bf16(q0[2], q0[3]); w.z = cvt_pk_bf16(q1[0], q1[1]); w.w = cvt_pk_bf16(q1[2], q1[3]);
                    *(u32x4*)(O1 + row * DM + 128 * u.pn + cc) = w;
                } else {
                    if (u.pn < 8) {
                        p0 = p0 * q0; p1 = p1 * q1;
                        w.x = cvt_pk_bf16(p0[0], p0[1]); w.y = cvt_pk_bf16(p0[2], p0[3]); w.z = cvt_pk_bf16(p1[0], p1[1]); w.w = cvt_pk_bf16(p1[2], p1[3]);
                        *(u32x4*)(O0 + row * DM + 128 * u.pn + cc) = w;
                    } else {
                        w.x = cvt_pk_bf16(p0[0], p0[1]); w.y = cvt_pk_bf16(p0[2], p0[3]); w.z = cvt_pk_bf16(p1[0], p1[1]); w.w = cvt_pk_bf16(p1[2], p1[3]);
                        *(u32x4*)(O1 + row * DM + 256 * (u.pn - 8) + cc) = w;
                        w.x = cvt_pk_bf16(q0[0], q0[1]); w.y = cvt_pk_bf16(q0[2], q0[3]); w.z = cvt_pk_bf16(q1[0], q1[1]); w.w = cvt_pk_bf16(q1[2], q1[3]);
                        *(u32x4*)(O1 + row * DM + 256 * (u.pn - 8) + 128 + cc) = w;
                    }
                }
            }
    }
};
struct EpiRgGates {
    static constexpr bool PERM = true;
    const bf16_t* U; bf16_t* LA; bf16_t* Bv; const float* ba; const float* bx; const float* c8;
    __device__ __forceinline__ void operator()(const f32x4 (&acc)[2][2][4][2], const Unit& u, int wr, int wc, int fr, int fq) const {
        const int ch = 128 * u.pn + 32 * wc + 8 * fq;
        f32x4 vba[2], vbx[2], vc8[2];
#pragma unroll
        for (int n = 0; n < 2; ++n) { vba[n] = *(const f32x4*)(ba + ch + 4 * n); vbx[n] = *(const f32x4*)(bx + ch + 4 * n); vc8[n] = *(const f32x4*)(c8 + ch + 4 * n); }
        u32x4 uws[8];
#pragma unroll
        for (int g = 0; g < 8; ++g) uws[g] = *(const u32x4*)(U + (size_t)(u.pm * 256 + (g >> 2) * 128 + wr * 64 + (g & 3) * 16 + fr) * DM + ch);
#pragma unroll
        for (int ai = 0; ai < 2; ++ai)
#pragma unroll
            for (int m = 0; m < 4; ++m) {
                const size_t off = (size_t)(u.pm * 256 + ai * 128 + wr * 64 + m * 16 + fr) * DM + ch;
                const u32x4 uw = uws[ai * 4 + m];
                float la[8], bb[8];
#pragma unroll
                for (int n = 0; n < 2; ++n)
#pragma unroll
                    for (int j = 0; j < 4; ++j) {
                        const float r = fast_sigmoid(acc[ai][0][m][n][j] + vba[n][j]), ig = fast_sigmoid(acc[ai][1][m][n][j] + vbx[n][j]);
                        const float l2 = vc8[n][j] * r; const float a2 = __builtin_amdgcn_exp2f(2.f * l2);
                        const unsigned uu = uw[n * 2 + (j >> 1)]; const float uv = (j & 1) ? bfhi(uu) : bflo(uu);
                        la[n * 4 + j] = l2; bb[n * 4 + j] = __builtin_sqrtf(fmaxf(1.f - a2, 0.f)) * ig * uv;
                    }
                u32x4 w; w.x = cvt_pk_bf16(la[0], la[1]); w.y = cvt_pk_bf16(la[2], la[3]); w.z = cvt_pk_bf16(la[4], la[5]); w.w = cvt_pk_bf16(la[6], la[7]);
                *(u32x4*)(LA + off) = w;
                w.x = cvt_pk_bf16(bb[0], bb[1]); w.y = cvt_pk_bf16(bb[2], bb[3]); w.z = cvt_pk_bf16(bb[4], bb[5]); w.w = cvt_pk_bf16(bb[6], bb[7]);
                *(u32x4*)(Bv + off) = w;
            }
    }
};
template <bool FIRST> struct EpiResid {
    static constexpr bool PERM = false;
    const float* Xin; float* PART; const float* bias; bf16_t* XB; float* SS;
    __device__ __forceinline__ void operator()(const f32x4 (&acc)[2][2][4][2], const Unit& u, int wr, int wc, int fr, int fq) const {
        const int col0 = u.pn * 256 + wc * 32 + 4 * fq;
        if (u.aux == 0) {
            f32x4 bv[2][2];
#pragma unroll
            for (int bj = 0; bj < 2; ++bj)
#pragma unroll
                for (int n = 0; n < 2; ++n) bv[bj][n] = *(const f32x4*)(bias + col0 + bj * 128 + n * 16);
            const size_t row0 = (size_t)(u.pm * 256 + wr * 64 + fr);
            f32x4 xin[2][4];
#define RES_LOAD(g, b) do { if (FIRST) { const float* xp_ = Xin + (row0 + ((g) >> 2) * 128 + ((g) & 3) * 16) * DM + col0; \
                    xin[b][0] = *(const f32x4*)(xp_); xin[b][1] = *(const f32x4*)(xp_ + 16); xin[b][2] = *(const f32x4*)(xp_ + 128); xin[b][3] = *(const f32x4*)(xp_ + 144); } \
                else { const bf16_t* xp_ = XB + (row0 + ((g) >> 2) * 128 + ((g) & 3) * 16) * DM + col0; \
                    _Pragma("unroll") for (int q_ = 0; q_ < 4; ++q_) { const u32x2 w_ = *(const u32x2*)(xp_ + (q_ >> 1) * 128 + (q_ & 1) * 16); xin[b][q_] = (f32x4){bflo(w_.x), bfhi(w_.x), bflo(w_.y), bfhi(w_.y)}; } } } while (0)
            RES_LOAD(0, 0);
#pragma unroll
            for (int g = 0; g < 8; ++g) {
                const int ai = g >> 2, m = g & 3, b = g & 1;
                if (g + 1 < 8) RES_LOAD(g + 1, b ^ 1);
                const size_t row = row0 + ai * 128 + m * 16;
                bf16_t* bp = XB + row * DM + col0;
                float ss = 0.f;
#pragma unroll
                for (int bj = 0; bj < 2; ++bj)
#pragma unroll
                    for (int n = 0; n < 2; ++n) {
                        const f32x4 v = xin[b][bj * 2 + n] + acc[ai][bj][m][n] + bv[bj][n];
                        u32x2 w; w.x = cvt_pk_bf16(v[0], v[1]); w.y = cvt_pk_bf16(v[2], v[3]); *(u32x2*)(bp + bj * 128 + n * 16) = w;
                        ss += (v[0] * v[0] + v[1] * v[1]) + (v[2] * v[2] + v[3] * v[3]);
                    }
                ss += __shfl_xor(ss, 16); ss += __shfl_xor(ss, 32);
                if (fq == 0) SS[row * 16 + u.pn * 4 + wc] = ss;
            }
#undef RES_LOAD
        } else {
            float* pp = PART + (size_t)(u.aux - 1) * MS * DM;
#pragma unroll
            for (int ai = 0; ai < 2; ++ai)
#pragma unroll
                for (int m = 0; m < 4; ++m) {
                    float* xp = pp + (size_t)(u.pm * 256 - MP + ai * 128 + wr * 64 + m * 16 + fr) * DM + col0;
#pragma unroll
                    for (int bj = 0; bj < 2; ++bj)
#pragma unroll
                        for (int n = 0; n < 2; ++n) {
                            const f32x4 v = acc[ai][bj][m][n]; const float* q = xp + bj * 128 + n * 16;
                            asm volatile("global_store_dwordx4 %0, %1, off sc1\n\ts_nop 1" :: "v"(q), "v"(v) : "memory");
                        }
                }
        }
    }
};
}

struct Params { const float* in[31]; float* out; unsigned char* ws; int ph_lo, ph_hi; };

__device__ __forceinline__ unsigned f2bf(float f) { unsigned u = __builtin_bit_cast(unsigned, f); return (u + 0x7fffu + ((u >> 16) & 1u)) >> 16; }
__device__ __forceinline__ unsigned pk2(float lo, float hi) { return f2bf(lo) | (f2bf(hi) << 16); }

struct TItem { const float* S; int Ns, K, n0, k0; bf16_t* WT; const float* gk; };
__device__ __forceinline__ void titem_load(const TItem& t, float (&tv)[32], int lane) {
#pragma unroll
    for (int i = 0; i < 32; ++i) tv[i] = t.S[(size_t)(t.k0 + 2 * i + (lane >> 5)) * t.Ns + (lane & 31)];
}
__device__ __forceinline__ void titem_finish(const TItem& t, const float (&tv)[32], LAS float* scr, int lane) {
    const int c = lane & 7;
    f32x4 g0 = (f32x4){1.f, 1.f, 1.f, 1.f}, g1 = g0;
    if (t.gk) { g0 = *(const f32x4*)(t.gk + t.k0 + 8 * c); g1 = *(const f32x4*)(t.gk + t.k0 + 8 * c + 4); }
#pragma unroll
    for (int i = 0; i < 32; ++i) scr[(2 * i + (lane >> 5)) * 33 + (lane & 31)] = tv[i];
    asm volatile("s_waitcnt lgkmcnt(0)" ::: "memory");
#pragma unroll
    for (int j = 0; j < 4; ++j) { const int n = (lane >> 3) + 8 * j; const LAS float* s = scr + (8 * c) * 33 + n;
        u32x4 o; o.x = pk2(s[0 * 33] * g0.x, s[1 * 33] * g0.y); o.y = pk2(s[2 * 33] * g0.z, s[3 * 33] * g0.w); o.z = pk2(s[4 * 33] * g1.x, s[5 * 33] * g1.y); o.w = pk2(s[6 * 33] * g1.z, s[7 * 33] * g1.w);
        *(u32x4*)(t.WT + (size_t)(t.n0 + n) * t.K + t.k0 + 8 * c) = o; }
    asm volatile("s_waitcnt lgkmcnt(0)" ::: "memory");
}

__device__ __forceinline__ bool titem_decode(const Params& p, unsigned char* ws, int it, TItem& t) {
    constexpr int I_QKV = 16 * 40, I_SQ = 16 * 32, I_FU = 16 * 176, I_FD = 44 * 32, I_RG1 = 16 * 64, I_RG2 = 4 * 64, I_SC1 = 16 * 96;
    constexpr int NITEMS = 2 * I_QKV + 2 * I_SQ + 4 * I_FU + 4 * I_FD + I_RG1 + I_RG2 + I_SQ + I_SC1 + I_SQ;
    if (it >= NITEMS) return false;
        int r = it;
        const float* S; int Ns, K, n0, k0; bf16_t* WT; const float* gk = nullptr;
        if (r < 2 * I_QKV) { const int j = r / I_QKV; r -= j * I_QKV; K = 1024; const int nb = r % 40, kb = r / 40; k0 = 64 * kb; n0 = 32 * nb;
            const int pn = nb >> 3, bj = (nb >> 2) & 1, hh = nb & 3; Ns = NQKV; S = p.in[10] + (size_t)j * 1024 * NQKV + (4 * pn + hh) * 64 + 32 * bj; WT = (bf16_t*)(ws + WS_WQKV) + (size_t)j * NQKV * 1024; gk = p.in[7] + 3 * j * DM; }
        else if ((r -= 2 * I_QKV) < 2 * I_SQ) { const int j = r / I_SQ; r -= j * I_SQ; K = 1024; const int nb = r % 32, kb = r / 32; k0 = 64 * kb; n0 = 32 * nb; Ns = 1024; S = p.in[12] + (size_t)j * 1024 * 1024 + n0; WT = (bf16_t*)(ws + WS_WO) + (size_t)j * 1024 * 1024; }
        else if ((r -= 2 * I_SQ) < 4 * I_FU) { const int i = r / I_FU; r -= i * I_FU; K = 1024; const int nb = r % 176, kb = r / 176; k0 = 64 * kb; n0 = 32 * nb;
            const int pn = nb >> 3, bj = (nb >> 2) & 1, c32 = nb & 3; Ns = DFF; S = (bj ? p.in[29] : p.in[28]) + (size_t)i * 1024 * DFF + 128 * pn + 32 * c32; WT = (bf16_t*)(ws + WS_WFU) + (size_t)i * 5632 * 1024; gk = p.in[8] + i * DM; }
        else if ((r -= 4 * I_FU) < 4 * I_FD) { const int i = r / I_FD; r -= i * I_FD; K = DFF; const int nb = r % 32, kb = r / 32; k0 = 64 * kb; n0 = 32 * nb; Ns = 1024; S = p.in[30] + (size_t)i * DFF * 1024 + n0; WT = (bf16_t*)(ws + WS_WFD) + (size_t)i * 1024 * DFF; }
        else if ((r -= 4 * I_FD) < I_RG1) { K = 1024; const int nb = r % 64, kb = r / 64; k0 = 64 * kb; n0 = 32 * nb;
            const int pn = nb >> 3, bj = (nb >> 2) & 1, c32 = nb & 3; Ns = 1024; S = (bj ? p.in[16] : p.in[15]) + 128 * pn + 32 * c32; WT = (bf16_t*)(ws + WS_WRG1); gk = p.in[7] + 1 * DM; }
        else if ((r -= I_RG1) < I_RG2) { K = 256; const int nb = r % 64, kb = r / 64; k0 = 64 * kb; n0 = 32 * nb;
            const int pn = nb >> 3, bj = (nb >> 2) & 1, c32 = nb & 3; Ns = 256; S = (bj ? p.in[21] : p.in[19]) + (size_t)(pn >> 1) * 65536 + 128 * (pn & 1) + 32 * c32; WT = (bf16_t*)(ws + WS_WRG2); }
        else if ((r -= I_RG2) < I_SQ) { K = 1024; const int nb = r % 32, kb = r / 32; k0 = 64 * kb; n0 = 32 * nb; Ns = 1024; S = p.in[24] + n0; WT = (bf16_t*)(ws + WS_WRG3); }
        else if ((r -= I_SQ) < I_SC1) { K = 1024; const int nb = r % 96, kb = r / 96; k0 = 64 * kb; n0 = 32 * nb;
            const int pn = nb >> 3, bj = (nb >> 2) & 1, c32 = nb & 3; Ns = 3072;
            const int col = pn < 8 ? (bj ? 2048 : 1024) + 128 * pn + 32 * c32 : 256 * (pn - 8) + 128 * bj + 32 * c32; S = p.in[25] + col; WT = (bf16_t*)(ws + WS_WSC1); gk = p.in[7] + 2 * DM; }
        else { r -= I_SC1; K = 1024; const int nb = r % 32, kb = r / 32; k0 = 64 * kb; n0 = 32 * nb; Ns = 1024; S = p.in[27] + n0; WT = (bf16_t*)(ws + WS_WSC2); }
        t.S = S; t.Ns = Ns; t.K = K; t.n0 = n0; t.k0 = k0; t.WT = WT; t.gk = gk;
    return true;
}

__device__ __forceinline__ int set_size(int s) { return s == 0 ? 640 : s == 1 ? 6528 : s == 2 ? 6272 : s == 3 ? 4224 : 5376; }
__device__ __forceinline__ int set_item(int s, int k) {
    if (s == 0) return k;
    if (s == 1) { if (k < 512) return 1280 + k; k -= 512; if (k < 2816) return 2304 + k; k -= 2816; if (k < 1408) return 13568 + k; k -= 1408; return 19200 + k; }
    if (s == 2) { if (k < 2816) return 5120 + k; k -= 2816; if (k < 1408) return 14976 + k; k -= 1408; return 20992 + k; }
    if (s == 3) { if (k < 2816) return 7936 + k; k -= 2816; return 16384 + k; }
    if (k < 640) return 640 + k; k -= 640; if (k < 512) return 1792 + k; k -= 512; if (k < 2816) return 10752 + k; k -= 2816; return 17792 + k;
}
__device__ __forceinline__ void convert_set(const Params& p, unsigned char* ws, LAS float* scr, int set, int widx, int nw, int lane) {
    const int n = set_size(set);
    TItem cur, nxt; float tv[32], tn[32];
    int k = widx;
    bool has = k < n;
    if (has) { titem_decode(p, ws, set_item(set, k), cur); titem_load(cur, tv, lane); }
    while (has) {
        k += nw;
        const bool hn = k < n;
        if (hn) { titem_decode(p, ws, set_item(set, k), nxt); titem_load(nxt, tn, lane); }
        titem_finish(cur, tv, scr, lane);
#pragma unroll
        for (int i = 0; i < 32; ++i) tv[i] = tn[i];
        cur = nxt; has = hn;
    }
}
__device__ __forceinline__ void convert_in_slack(const Params& p, unsigned char* ws, LAS unsigned char* lds, int set, int nU, int vcu, int G, const int tid) {
    const int first = nU % G, nidle = first == 0 ? G : G - first;
    const int k0 = first == 0 ? 0 : first;
    if (vcu < k0) return;
    const int lane = tid & 63, wave = __builtin_amdgcn_readfirstlane(tid >> 6);
    convert_set(p, ws, (LAS float*)(lds + wave * 16384), set, (vcu - k0) * 8 + wave, nidle * 8, lane);
}

__device__ __forceinline__ void prep_phase(const Params& p, LAS unsigned char* lds, int vcu, int G, const int tid) {
    const int lane = tid & 63, wave = __builtin_amdgcn_readfirstlane(tid >> 6);
    LAS float* scr = (LAS float*)(lds + wave * 16384);
    const int gw = vcu * 8 + wave, NGW = G * 8;
    unsigned char* ws = p.ws;
    convert_set(p, ws, scr, 0, gw, NGW, lane);
    {
        float* SSp = (float*)(ws + WS_SS);
        for (int m = gw; m < M; m += NGW) {
            const float* src = m < MP ? p.in[0] + (size_t)m * DM : p.in[1] + (size_t)(m - MP) * DM;
            f32x4 v[4]; float s = 0.f;
#pragma unroll
            for (int j = 0; j < 4; ++j) { v[j] = *((const f32x4*)src + lane + 64 * j); s += (v[j].x * v[j].x + v[j].y * v[j].y) + (v[j].z * v[j].z + v[j].w * v[j].w); }
            s = wave_sum(s);
            if (lane < 16) SSp[(size_t)m * 16 + lane] = lane == 0 ? s : 0.f;
            u32x2* no = (u32x2*)((bf16_t*)(ws + WS_XN) + (size_t)m * DM) + lane;
#pragma unroll
            for (int j = 0; j < 4; ++j) { u32x2 w; w.x = cvt_pk_bf16(v[j].x, v[j].y); w.y = cvt_pk_bf16(v[j].z, v[j].w); no[64 * j] = w; }
        }
    }
    {
        const int gt = vcu * 512 + tid, NGT = G * 512;
        float* rope = (float*)(ws + WS_ROPE);
        for (int e = gt; e < 4104 * 32; e += NGT) {
            const int pi = e >> 5, d = e & 31; const int pos = pi < SEQ ? pi : 8192 + (pi - SEQ);
            double inv = 1.0; for (int k = 0; k < d; ++k) inv *= 0.7498942093324559;
            const float ang = (float)pos * (float)inv;
            const double rev = (double)ang * 0.15915494309189535; const double fr = rev - __builtin_rint(rev);
            rope[(size_t)pi * 64 + d] = __builtin_amdgcn_cosf((float)fr); rope[(size_t)pi * 64 + 32 + d] = __builtin_amdgcn_sinf((float)fr);
        }
        float* c8 = (float*)(ws + WS_C8);
        for (int e = gt; e < 1024; e += NGT) { const float lam = p.in[23][e]; c8[e] = -8.0f * log1pf(__expf(-lam)) * LOG2E; ((float*)(ws + WS_ZB))[e] = 0.f; }
    }
}

__device__ __forceinline__ void norm_phase(float* X, const float* PART, int nsplit, const float* bias, const float* g, bf16_t* XN, bool final_, int vcu, int G, const int tid) {
    const int lane = tid & 63, wave = tid >> 6;
    const int gw = vcu * 8 + wave, NGW = G * 8;
    f32x4 gv[4];
#pragma unroll
    for (int j = 0; j < 4; ++j) gv[j] = *((const f32x4*)g + lane + 64 * j);
    for (int m = gw; m < M; m += NGW) {
        f32x4* xr = (f32x4*)(X + (size_t)m * DM) + lane;
        f32x4 v[4]; float s = 0.f;
        if (m >= MP) {
#pragma unroll
            for (int j = 0; j < 4; ++j) v[j] = xr[64 * j];
        } else {
            const u32x2* br = (const u32x2*)(XN + (size_t)m * DM) + lane;
#pragma unroll
            for (int j = 0; j < 4; ++j) { const u32x2 w = br[64 * j]; v[j] = (f32x4){bflo(w.x), bfhi(w.x), bflo(w.y), bfhi(w.y)}; }
        }
        if (m >= MP) {
#pragma unroll 4
            for (int sl = 0; sl < nsplit; ++sl) { const f32x4* pr = (const f32x4*)(PART + ((size_t)sl * MS + (m - MP)) * DM) + lane;
#pragma unroll
                for (int j = 0; j < 4; ++j) v[j] += pr[64 * j]; }
            if (bias) {
#pragma unroll
                for (int j = 0; j < 4; ++j) v[j] += *((const f32x4*)bias + lane + 64 * j); }
            if (!final_) {
#pragma unroll
                for (int j = 0; j < 4; ++j) xr[64 * j] = v[j]; }
        }
#pragma unroll
        for (int j = 0; j < 4; ++j) s += (v[j].x * v[j].x + v[j].y * v[j].y) + (v[j].z * v[j].z + v[j].w * v[j].w);
        const float rstd = 1.0f / sqrtf(wave_sum(s) * (1.f / DM) + EPS);
        if (final_) {
#pragma unroll
            for (int j = 0; j < 4; ++j) xr[64 * j] = v[j] * rstd * gv[j];
        } else {
            u32x2* no = (u32x2*)(XN + (size_t)m * DM) + lane;
#pragma unroll
            for (int j = 0; j < 4; ++j) { const f32x4 y = v[j] * rstd * gv[j]; u32x2 w; w.x = cvt_pk_bf16(y.x, y.y); w.y = cvt_pk_bf16(y.z, y.w); no[64 * j] = w; }
        }
    }
}

__device__ __forceinline__ void fin_slack(const float* Xin, float* X, const float* PART, int nsplit, const float* bias, bf16_t* XB, float* SS, unsigned* cnt, int nS, int vcu, int G, const int tid) {
    const int first = G > nS ? nS : 0;
    if (vcu < first) return;
    const int lane = tid & 63, wave = tid >> 6;
    if (lane == 0) { unsigned sp = 0; while (__hip_atomic_load(cnt, __ATOMIC_RELAXED, __HIP_MEMORY_SCOPE_AGENT) < (unsigned)(nS * 8) && ++sp < (1u << 20)) __builtin_amdgcn_s_sleep(2); }
    asm volatile("s_waitcnt vmcnt(0)" ::: "memory");
    const int gw = (vcu - first) * 8 + wave, NGW = (G - first) * 8;
    for (int r = gw; r < MS; r += NGW) {
        const int m = MP + r;
        f32x4* xr = (f32x4*)(X + (size_t)m * DM) + lane;
        const f32x4* xi = (const f32x4*)(Xin + (size_t)r * DM) + lane;
        f32x4 v[4]; float s = 0.f;
#pragma unroll
        for (int j = 0; j < 4; ++j) v[j] = xi[64 * j];
#pragma unroll 4
        for (int sl = 0; sl < nsplit; ++sl) { unsigned long long* pr = (unsigned long long*)(PART + ((size_t)sl * MS + r) * DM) + 2 * lane;
#pragma unroll
            for (int j = 0; j < 4; ++j) { const unsigned long long a = __hip_atomic_load(pr + 128 * j, __ATOMIC_RELAXED, __HIP_MEMORY_SCOPE_AGENT), b = __hip_atomic_load(pr + 128 * j + 1, __ATOMIC_RELAXED, __HIP_MEMORY_SCOPE_AGENT);
                v[j] += (f32x4){__uint_as_float((unsigned)a), __uint_as_float((unsigned)(a >> 32)), __uint_as_float((unsigned)b), __uint_as_float((unsigned)(b >> 32))}; } }
#pragma unroll
        for (int j = 0; j < 4; ++j) v[j] += *((const f32x4*)bias + lane + 64 * j);
        u32x2* no = (u32x2*)(XB + (size_t)m * DM) + lane;
#pragma unroll
        for (int j = 0; j < 4; ++j) { xr[64 * j] = v[j]; u32x2 w; w.x = cvt_pk_bf16(v[j].x, v[j].y); w.y = cvt_pk_bf16(v[j].z, v[j].w); no[64 * j] = w;
            s += (v[j].x * v[j].x + v[j].y * v[j].y) + (v[j].z * v[j].z + v[j].w * v[j].w); }
        s = wave_sum(s);
        if (lane < 16) SS[(size_t)m * 16 + lane] = lane == 0 ? s : 0.f;
    }
}

constexpr int KS_PITCH = 72, VT_PITCH = 260;
constexpr int ATT_KS = 0, ATT_VT = 256 * KS_PITCH * 2;
__device__ __forceinline__ void attn_phase(const Params& p, LAS unsigned char* lds, int j, int vcu, int G, const int tid) {
    const int lane = tid & 63, wave = __builtin_amdgcn_readfirstlane(tid >> 6), l31 = lane & 31, hi = lane >> 5;
    const bf16_t* QKV = (const bf16_t*)(p.ws + WS_S0);
    bf16_t* O = (bf16_t*)(p.ws + WS_S2);
    LAS bf16_t* Ks = (LAS bf16_t*)(lds + ATT_KS);
    LAS bf16_t* Vt = (LAS bf16_t*)(lds + ATT_VT);
    const float* ck = p.in[2] + (size_t)j * 128 * 128 * 128;
    const float* cv = p.in[3] + (size_t)j * 128 * 128 * 128;
    {
        const int gt = vcu * 512 + tid, NGT = G * 512;
        float* kp = p.out + O_KP + (size_t)j * 65536; float* vp = p.out + O_VP + (size_t)j * 65536;
        for (int e = gt; e < 65536; e += NGT) { const int d = e & 127, t = (e >> 7) & 127, b = e >> 14; const size_t src = (size_t)(b * SEQ + SEQ - 128 + t) * NQKV + 1024 + d;
            kp[e] = bf2f(QKV[src]); vp[e] = bf2f(QKV[src + 128]); }
        float* ksn = p.out + O_KS + (size_t)j * 2097152; float* vsn = p.out + O_VS + (size_t)j * 2097152;
        f32x4 kv4[4], vv4[4];
#pragma unroll
        for (int it = 0; it < 4; ++it) {
            const int e4 = gt + it * NGT;
            if (e4 < 524288) { const int e = e4 * 4, d = e & 127, c = (e >> 7) & 127, b = e >> 14;
                if (c < 120) { kv4[it] = *(const f32x4*)(ck + e + 8 * 128); vv4[it] = *(const f32x4*)(cv + e + 8 * 128); }
                else { const size_t src = (size_t)(MP + b * 8 + c - 120) * NQKV + 1024 + d; const u32x2 kw = *(const u32x2*)(QKV + src), vw = *(const u32x2*)(QKV + src + 128);
                    kv4[it] = (f32x4){bflo(kw.x), bfhi(kw.x), bflo(kw.y), bfhi(kw.y)}; vv4[it] = (f32x4){bflo(vw.x), bfhi(vw.x), bflo(vw.y), bfhi(vw.y)}; } }
        }
#pragma unroll
        for (int it = 0; it < 4; ++it) { const int e4 = gt + it * NGT; if (e4 < 524288) { *(f32x4*)(ksn + (size_t)e4 * 4) = kv4[it]; *(f32x4*)(vsn + (size_t)e4 * 4) = vv4[it]; } }
        for (int e4 = gt + 4 * NGT; e4 < 524288; e4 += NGT) {
            const int e = e4 * 4, d = e & 127, c = (e >> 7) & 127, b = e >> 14;
            if (c < 120) { *(f32x4*)(ksn + e) = *(const f32x4*)(ck + e + 8 * 128); *(f32x4*)(vsn + e) = *(const f32x4*)(cv + e + 8 * 128); }
            else { const size_t src = (size_t)(MP + b * 8 + c - 120) * NQKV + 1024 + d; const u32x2 kw = *(const u32x2*)(QKV + src), vw = *(const u32x2*)(QKV + src + 128);
                *(f32x4*)(ksn + e) = (f32x4){bflo(kw.x), bfhi(kw.x), bflo(kw.y), bfhi(kw.y)}; *(f32x4*)(vsn + e) = (f32x4){bflo(vw.x), bfhi(vw.x), bflo(vw.y), bfhi(vw.y)}; }
        }
    }
    for (int un = vcu; un < 512; un += G) {
        const bool prompt = un < 256;
        int b, kvh, nb = 0;
        if (prompt) { b = un >> 6; kvh = (un >> 5) & 1; nb = un & 31; } else { const int s = un - 256; b = s >> 1; kvh = s & 1; }
        const int nkeys = prompt ? 256 : 160;
        for (int id = tid; id < nkeys * 8; id += 512) {
            const int key = id >> 3, ch = id & 7;
            u32x4 w = (u32x4){0u, 0u, 0u, 0u};
            if (prompt) { if (!(nb == 0 && key < 128)) w = *(const u32x4*)(QKV + (size_t)(b * SEQ + 128 * (nb - 1) + key) * NQKV + 1024 + kvh * 64 + 8 * ch); }
            else if (key < 128) { const float* s = ck + ((size_t)(b * 128 + key) * 2 + kvh) * 64 + 8 * ch; const f32x4 a = *(const f32x4*)s, c = *(const f32x4*)(s + 4);
                w.x = cvt_pk_bf16(a.x, a.y); w.y = cvt_pk_bf16(a.z, a.w); w.z = cvt_pk_bf16(c.x, c.y); w.w = cvt_pk_bf16(c.z, c.w); }
            else if (key < 136) w = *(const u32x4*)(QKV + (size_t)(MP + b * 8 + key - 128) * NQKV + 1024 + kvh * 64 + 8 * ch);
            *(LAS u32x4*)(Ks + key * KS_PITCH + 8 * ch) = w;
        }
        for (int id = tid; id < nkeys * 8; id += 512) {
            const int key = id % nkeys, ch = id / nkeys;
            u32x4 w = (u32x4){0u, 0u, 0u, 0u};
            if (prompt) { if (!(nb == 0 && key < 128)) w = *(const u32x4*)(QKV + (size_t)(b * SEQ + 128 * (nb - 1) + key) * NQKV + 1152 + kvh * 64 + 8 * ch); }
            else if (key < 128) { const float* s = cv + ((size_t)(b * 128 + key) * 2 + kvh) * 64 + 8 * ch; const f32x4 a = *(const f32x4*)s, c = *(const f32x4*)(s + 4);
                w.x = cvt_pk_bf16(a.x, a.y); w.y = cvt_pk_bf16(a.z, a.w); w.z = cvt_pk_bf16(c.x, c.y); w.w = cvt_pk_bf16(c.z, c.w); }
            else if (key < 136) w = *(const u32x4*)(QKV + (size_t)(MP + b * 8 + key - 128) * NQKV + 1152 + kvh * 64 + 8 * ch);
            LAS bf16_t* vd = Vt + (8 * ch) * VT_PITCH + key;
            vd[0 * VT_PITCH] = (bf16_t)(w.x & 0xffff); vd[1 * VT_PITCH] = (bf16_t)(w.x >> 16); vd[2 * VT_PITCH] = (bf16_t)(w.y & 0xffff); vd[3 * VT_PITCH] = (bf16_t)(w.y >> 16);
            vd[4 * VT_PITCH] = (bf16_t)(w.z & 0xffff); vd[5 * VT_PITCH] = (bf16_t)(w.z >> 16); vd[6 * VT_PITCH] = (bf16_t)(w.w & 0xffff); vd[7 * VT_PITCH] = (bf16_t)(w.w >> 16);
        }
        __syncthreads();
        const int h = kvh * 8 + wave;
        const float sink8 = p.in[14][j * 16 + h] * 8.0f;
        const int nqs = prompt ? 4 : 1;
        for (int qs = 0; qs < nqs; ++qs) {
            const int qi = 32 * qs + l31;
            const bool qvalid = prompt || l31 < 8;
            const size_t qrow = prompt ? (size_t)(b * SEQ + 128 * nb + qi) : (size_t)(MP + b * 8 + (l31 < 8 ? l31 : 7));
            bf16x8 qf[4];
#pragma unroll
            for (int d0 = 0; d0 < 4; ++d0) qf[d0] = *(const bf16x8*)(QKV + qrow * NQKV + h * 64 + 16 * d0 + 8 * hi);
            constexpr float CS = 0.125f * LOG2E;
            float mrun = sink8, lrun = hi == 0 ? 1.f : 0.f;
            f32x16 o0 = {}, o1 = {};
            const int kt_lo = (prompt && nb == 0 && qs < 4) ? 4 : qs;
            for (int kt = kt_lo; kt < qs + 5; ++kt) {
                f32x16 s = {};
#pragma unroll
                for (int d0 = 0; d0 < 4; ++d0) { const bf16x8 kf = *(const LAS bf16x8*)(Ks + (32 * kt + l31) * KS_PITCH + 16 * d0 + 8 * hi); s = __builtin_amdgcn_mfma_f32_32x32x16_bf16(kf, qf[d0], s, 0, 0, 0); }
                if (kt == qs || kt == qs + 4) {
#pragma unroll
                    for (int r = 0; r < 16; ++r) { const int c = 32 * kt + (r & 3) + 8 * (r >> 2) + 4 * hi; const bool ok = (c > qi) && (c <= qi + 128); s[r] = ok ? s[r] : -1e30f; }
                }
                float mx = fmaxf(fmaxf(s[0], s[1]), fmaxf(s[2], s[3]));
#pragma unroll
                for (int r = 4; r < 16; r += 4) mx = fmaxf(mx, fmaxf(fmaxf(s[r], s[r + 1]), fmaxf(s[r + 2], s[r + 3])));
                mx = fmaxf(mx, __shfl_xor(mx, 32));
                if (__any(mx > mrun)) {
                    const float mnew = fmaxf(mrun, mx), alpha = __builtin_amdgcn_exp2f((mrun - mnew) * CS);
                    lrun *= alpha; mrun = mnew;
#pragma unroll
                    for (int r = 0; r < 16; ++r) { o0[r] *= alpha; o1[r] *= alpha; }
                }
                const float mc = -mrun * CS;
                float ps = 0.f;
#pragma unroll
                for (int r = 0; r < 16; ++r) { s[r] = __builtin_amdgcn_exp2f(__builtin_fmaf(s[r], CS, mc)); ps += s[r]; }
                lrun += ps;
#pragma unroll
                for (int ss = 0; ss < 2; ++ss) {
                    u32x4 pw; pw.x = cvt_pk_bf16(s[8 * ss + 0], s[8 * ss + 1]); pw.y = cvt_pk_bf16(s[8 * ss + 2], s[8 * ss + 3]); pw.z = cvt_pk_bf16(s[8 * ss + 4], s[8 * ss + 5]); pw.w = cvt_pk_bf16(s[8 * ss + 6], s[8 * ss + 7]);
                    const bf16x8 pb = __builtin_bit_cast(bf16x8, pw);
                    const LAS bf16_t* vb = Vt + l31 * VT_PITCH + 32 * kt + 16 * ss + 4 * hi;
                    const s16x4 a0 = *(const LAS s16x4*)(vb), a1 = *(const LAS s16x4*)(vb + 8);
                    const s16x4 c0 = *(const LAS s16x4*)(vb + 32 * VT_PITCH), c1 = *(const LAS s16x4*)(vb + 32 * VT_PITCH + 8);
                    const bf16x8 v0 = (bf16x8){a0[0], a0[1], a0[2], a0[3], a1[0], a1[1], a1[2], a1[3]};
                    const bf16x8 v1 = (bf16x8){c0[0], c0[1], c0[2], c0[3], c1[0], c1[1], c1[2], c1[3]};
                    o0 = __builtin_amdgcn_mfma_f32_32x32x16_bf16(v0, pb, o0, 0, 0, 0);
                    o1 = __builtin_amdgcn_mfma_f32_32x32x16_bf16(v1, pb, o1, 0, 0, 0);
                }
            }
            const float ltot = lrun + __shfl_xor(lrun, 32);
            const float inv = 1.0f / ltot;
            if (qvalid) {
                const size_t orow = prompt ? (size_t)(b * SEQ + 128 * nb + qi) : (size_t)(MP + b * 8 + l31);
                bf16_t* op = O + orow * DM + h * 64 + 4 * hi;
#pragma unroll
                for (int r4 = 0; r4 < 4; ++r4) {
                    u32x2 w; w.x = cvt_pk_bf16(o0[4 * r4] * inv, o0[4 * r4 + 1] * inv); w.y = cvt_pk_bf16(o0[4 * r4 + 2] * inv, o0[4 * r4 + 3] * inv); *(u32x2*)(op + 8 * r4) = w;
                    w.x = cvt_pk_bf16(o1[4 * r4] * inv, o1[4 * r4 + 1] * inv); w.y = cvt_pk_bf16(o1[4 * r4 + 2] * inv, o1[4 * r4 + 3] * inv); *(u32x2*)(op + 32 + 8 * r4) = w;
                }
            }
        }
        __syncthreads();
    }
}

__device__ __forceinline__ void rgconv_phase(const Params& p, int vcu, int G, const int tid) {
    const int gt = vcu * 512 + tid, NGT = G * 512;
    const bf16_t* __restrict__ V = (const bf16_t*)(p.ws + WS_S1); bf16_t* __restrict__ U = (bf16_t*)(p.ws + WS_S3);
    const float* __restrict__ cw = p.in[17]; const float* __restrict__ cb = p.in[18]; const float* __restrict__ buf = p.in[5];
#pragma unroll 2
    for (int e = gt; e < M * 128; e += NGT) {
        const int row = e >> 7, ch = (e & 127) * 8;
        int t, T; const float* sb = nullptr;
        if (row < MP) { t = row & (SEQ - 1); T = SEQ; } else { t = (row - MP) & 7; T = 8; sb = buf + (size_t)((row - MP) >> 3) * 3 * DM; }
        float accv[8];
        { const f32x4 b0 = *(const f32x4*)(cb + ch), b1 = *(const f32x4*)(cb + ch + 4);
#pragma unroll
          for (int k = 0; k < 4; ++k) { accv[k] = b0[k]; accv[4 + k] = b1[k]; } }
#pragma unroll
        for (int jj = 0; jj < 4; ++jj) {
            const int tt = t - 3 + jj;
            float xv[8];
            if (tt >= 0) { const u32x4 w = *(const u32x4*)(V + (size_t)(row - 3 + jj) * DM + ch);
                xv[0] = bflo(w.x); xv[1] = bfhi(w.x); xv[2] = bflo(w.y); xv[3] = bfhi(w.y); xv[4] = bflo(w.z); xv[5] = bfhi(w.z); xv[6] = bflo(w.w); xv[7] = bfhi(w.w); }
            else if (sb) { const f32x4 a = *(const f32x4*)(sb + (size_t)(tt + 3) * DM + ch), c = *(const f32x4*)(sb + (size_t)(tt + 3) * DM + ch + 4);
#pragma unroll
                for (int k = 0; k < 4; ++k) { xv[k] = a[k]; xv[4 + k] = c[k]; } }
            else {
#pragma unroll
                for (int k = 0; k < 8; ++k) xv[k] = 0.f; }
            const f32x4 w0 = *(const f32x4*)(cw + jj * DM + ch), w1 = *(const f32x4*)(cw + jj * DM + ch + 4);
#pragma unroll
            for (int k = 0; k < 4; ++k) { accv[k] += xv[k] * w0[k]; accv[4 + k] += xv[4 + k] * w1[k]; }
        }
        u32x4 w; w.x = cvt_pk_bf16(accv[0], accv[1]); w.y = cvt_pk_bf16(accv[2], accv[3]); w.z = cvt_pk_bf16(accv[4], accv[5]); w.w = cvt_pk_bf16(accv[6], accv[7]);
        *(u32x4*)(U + (size_t)row * DM + ch) = w;
        if (t >= T - 3) {
            const u32x4 vw = *(const u32x4*)(V + (size_t)row * DM + ch);
            float* dst = row < MP ? p.out + O_RCP + ((size_t)(row >> 12) * 3 + (t - (T - 3))) * DM + ch : p.out + O_RCS + ((size_t)((row - MP) >> 3) * 3 + (t - (T - 3))) * DM + ch;
            *(f32x4*)dst = (f32x4){bflo(vw.x), bfhi(vw.x), bflo(vw.y), bfhi(vw.y)}; *(f32x4*)(dst + 4) = (f32x4){bflo(vw.z), bfhi(vw.z), bflo(vw.w), bfhi(vw.w)};
        }
    }
}
__device__ __forceinline__ void rgscan_phase(const Params& p, LAS unsigned char* lds, int vcu, int G, const int tid) {
    const int lane = tid & 63, wave = tid >> 6;
    bf16_t* GATE = (bf16_t*)(p.ws + WS_S0); const bf16_t* LA = (const bf16_t*)(p.ws + WS_S1); const bf16_t* Bv = (const bf16_t*)(p.ws + WS_S2);
    LAS float* sm = (LAS float*)lds;
    for (int un = vcu; un < 256; un += G) {
        const int b = un >> 6, ch = (un & 63) * 16 + (lane & 15), chunk = wave * 4 + (lane >> 4);
        const size_t base = (size_t)(b * SEQ + chunk * 128) * DM + ch;
        float Ap = 0.f, Bp = 0.f;
        for (int t0 = 0; t0 < 128; t0 += 32) {
            unsigned short lv[32], bv_[32];
#pragma unroll
            for (int t = 0; t < 32; ++t) { lv[t] = LA[base + (size_t)(t0 + t) * DM]; bv_[t] = Bv[base + (size_t)(t0 + t) * DM]; }
#pragma unroll
            for (int t = 0; t < 32; ++t) { const float l2 = bf2f(lv[t]); Ap += l2; Bp = __builtin_amdgcn_exp2f(l2) * Bp + bf2f(bv_[t]); }
        }
        sm[(chunk * 16 + (lane & 15)) * 2] = __builtin_amdgcn_exp2f(Ap); sm[(chunk * 16 + (lane & 15)) * 2 + 1] = Bp;
        __syncthreads();
        float hcur = 0.f;
        for (int c = 0; c < chunk; ++c) hcur = sm[(c * 16 + (lane & 15)) * 2] * hcur + sm[(c * 16 + (lane & 15)) * 2 + 1];
        for (int t0 = 0; t0 < 128; t0 += 32) {
            unsigned short lv[32], bv_[32], gv_[32];
#pragma unroll
            for (int t = 0; t < 32; ++t) { lv[t] = LA[base + (size_t)(t0 + t) * DM]; bv_[t] = Bv[base + (size_t)(t0 + t) * DM]; gv_[t] = GATE[base + (size_t)(t0 + t) * DM]; }
#pragma unroll
            for (int t = 0; t < 32; ++t) { hcur = __builtin_amdgcn_exp2f(bf2f(lv[t])) * hcur + bf2f(bv_[t]); GATE[base + (size_t)(t0 + t) * DM] = (bf16_t)f2bf(hcur * bf2f(gv_[t])); }
        }
        if (chunk == 31) p.out[O_HP + (size_t)b * DM + ch] = hcur;
        __syncthreads();
    }
    const int gt = vcu * 512 + tid, NGT = G * 512;
    for (int e = gt; e < 128 * DM; e += NGT) {
        const int sq = e >> 10, ch = e & 1023; float hcur = p.in[4][e];
        const size_t base = (size_t)(MP + sq * 8) * DM + ch;
#pragma unroll
        for (int t = 0; t < 8; ++t) { const float l2 = bf2f(LA[base + (size_t)t * DM]); const float bb = bf2f(Bv[base + (size_t)t * DM]);
            hcur = __builtin_amdgcn_exp2f(l2) * hcur + bb; const float gt_ = bf2f(GATE[base + (size_t)t * DM]); GATE[base + (size_t)t * DM] = (bf16_t)f2bf(hcur * gt_); }
        p.out[O_HS + e] = hcur;
    }
}
__device__ __forceinline__ void scconv_phase(const Params& p, int vcu, int G, const int tid) {
    const int gt = vcu * 512 + tid, NGT = G * 512;
    const bf16_t* __restrict__ CX = (const bf16_t*)(p.ws + WS_S0); const bf16_t* __restrict__ BG = (const bf16_t*)(p.ws + WS_S1); bf16_t* __restrict__ YG = (bf16_t*)(p.ws + WS_S2);
    const float* __restrict__ cw = p.in[26]; const float* __restrict__ buf = p.in[6];
#pragma unroll 2
    for (int e = gt; e < M * 128; e += NGT) {
        const int row = e >> 7, ch = (e & 127) * 8;
        int t, T; const float* sb = nullptr;
        if (row < MP) { t = row & (SEQ - 1); T = SEQ; } else { t = (row - MP) & 7; T = 8; sb = buf + (size_t)((row - MP) >> 3) * 2 * DM; }
        float accv[8];
#pragma unroll
        for (int k = 0; k < 8; ++k) accv[k] = 0.f;
        u32x4 cur = (u32x4){0u, 0u, 0u, 0u};
#pragma unroll
        for (int jj = 0; jj < 3; ++jj) {
            const int tt = t - 2 + jj;
            float xv[8];
            if (tt >= 0) { const u32x4 w = *(const u32x4*)(CX + (size_t)(row - 2 + jj) * DM + ch); if (jj == 2) cur = w;
                xv[0] = bflo(w.x); xv[1] = bfhi(w.x); xv[2] = bflo(w.y); xv[3] = bfhi(w.y); xv[4] = bflo(w.z); xv[5] = bfhi(w.z); xv[6] = bflo(w.w); xv[7] = bfhi(w.w); }
            else if (sb) { const f32x4 a = *(const f32x4*)(sb + (size_t)(tt + 2) * DM + ch), c = *(const f32x4*)(sb + (size_t)(tt + 2) * DM + ch + 4);
#pragma unroll
                for (int k = 0; k < 4; ++k) { xv[k] = a[k]; xv[4 + k] = c[k]; } }
            else {
#pragma unroll
                for (int k = 0; k < 8; ++k) xv[k] = 0.f; }
            const f32x4 w0 = *(const f32x4*)(cw + jj * DM + ch), w1 = *(const f32x4*)(cw + jj * DM + ch + 4);
#pragma unroll
            for (int k = 0; k < 4; ++k) { accv[k] += xv[k] * w0[k]; accv[4 + k] += xv[4 + k] * w1[k]; }
        }
        const u32x4 g = *(const u32x4*)(BG + (size_t)row * DM + ch);
        u32x4 w; w.x = cvt_pk_bf16(accv[0] * bflo(g.x), accv[1] * bfhi(g.x)); w.y = cvt_pk_bf16(accv[2] * bflo(g.y), accv[3] * bfhi(g.y));
        w.z = cvt_pk_bf16(accv[4] * bflo(g.z), accv[5] * bfhi(g.z)); w.w = cvt_pk_bf16(accv[6] * bflo(g.w), accv[7] * bfhi(g.w));
        *(u32x4*)(YG + (size_t)row * DM + ch) = w;
        if (t >= T - 2) {
            float* dst = row < MP ? p.out + O_SCP + ((size_t)(row >> 12) * 2 + (t - (T - 2))) * DM + ch : p.out + O_SCS + ((size_t)((row - MP) >> 3) * 2 + (t - (T - 2))) * DM + ch;
            *(f32x4*)dst = (f32x4){bflo(cur.x), bfhi(cur.x), bflo(cur.y), bfhi(cur.y)}; *(f32x4*)(dst + 4) = (f32x4){bflo(cur.z), bfhi(cur.z), bflo(cur.w), bfhi(cur.w)};
        }
    }
}

#define XB_TMO      128
#define XB_XCNT(j)  (256  + 64 * (j))
#define XB_XSUB(j)  (1280 + 64 * (j))
#define XB_XGEN(j)  (2304 + 64 * (j))
#define XB_TOP      3328
#define XB_TOPGEN   3392
#define XCD_BAR_WORDS 3456
#define XB_SPIN_CAP (1u << 18)
__device__ __forceinline__ unsigned xb_ld(unsigned* p)              { return __hip_atomic_load(p, __ATOMIC_RELAXED, __HIP_MEMORY_SCOPE_AGENT); }
__device__ __forceinline__ unsigned xb_add(unsigned* p, unsigned v) { return __hip_atomic_fetch_add(p, v, __ATOMIC_RELAXED, __HIP_MEMORY_SCOPE_AGENT); }
__device__ __forceinline__ unsigned xb_xcc_id() { return (unsigned)__builtin_amdgcn_s_getreg((3 << 11) | 20) & 0xFu; }
#define XB_SPIN(cond, bar) do { unsigned _sp = 0; while (cond) { __builtin_amdgcn_s_sleep(1); \
    if ((++_sp & 255u) == 0u) { if (xb_ld(&(bar)[XB_TMO])) break; if (_sp > XB_SPIN_CAP) { atomicAdd(&(bar)[XB_TMO], 1u); break; } } } } while (0)
struct XcdBarrier { unsigned* bar; unsigned x; volatile LAS unsigned* st; };
__device__ __forceinline__ XcdBarrier xcd_barrier_post(unsigned* bar, volatile LAS unsigned* st) {
    XcdBarrier b; b.bar = bar; b.x = xb_xcc_id(); b.st = st;
    if (threadIdx.x == 0) (void)xb_add(&bar[XB_XCNT(b.x)], 1u);
    return b;
}
__device__ __forceinline__ void xcd_barrier_complete(unsigned* bar, unsigned x, unsigned& nloc, unsigned& nx) {
    const unsigned G = gridDim.x * gridDim.y * gridDim.z;
    unsigned sum, cnt, mine, sp = 0u;
    for (;;) {
        sum = 0u; cnt = 0u; mine = 0u;
#pragma unroll
        for (unsigned j = 0; j < 16; ++j) { const unsigned c = xb_ld(&bar[XB_XCNT(j)]); sum += c; cnt += (c > 0u) ? 1u : 0u; mine = (j == x) ? c : mine; }
        if (sum == G) break;
        __builtin_amdgcn_s_sleep(1);
        if ((++sp & 255u) == 0u) { if (xb_ld(&bar[XB_TMO])) break; if (sp > XB_SPIN_CAP) { atomicAdd(&bar[XB_TMO], 1u); break; } }
    }
    nloc = mine > 0u ? mine : 1u; nx = cnt > 0u ? cnt : 1u;
}
__device__ __forceinline__ void xcd_barrier(const XcdBarrier& b) {
    asm volatile("s_waitcnt vmcnt(0)" ::: "memory");
    __syncthreads();
    if (threadIdx.x == 0) {
        unsigned* bar = b.bar;
        __builtin_amdgcn_s_waitcnt(0);
        unsigned nloc = b.st[0], nx = b.st[1];
        if (nloc == 0u) { xcd_barrier_complete(bar, b.x, nloc, nx); b.st[0] = nloc; b.st[1] = nx; }
        const unsigned old = xb_add(&bar[XB_XSUB(b.x)], 1u);
        const unsigned gen = old / nloc;
        if (old + 1u == (gen + 1u) * nloc) {
            __builtin_amdgcn_fence(__ATOMIC_RELEASE, "agent");
            asm volatile("s_waitcnt vmcnt(0)" ::: "memory");
            const unsigned og = xb_add(&bar[XB_TOP], 1u);
            const unsigned tg = og / nx;
            if (og + 1u == (tg + 1u) * nx) xb_add(&bar[XB_TOPGEN], 1u);
            else XB_SPIN(xb_ld(&bar[XB_TOPGEN]) == tg, bar);
            __builtin_amdgcn_fence(__ATOMIC_ACQUIRE, "agent");
            xb_add(&bar[XB_XGEN(b.x)], 1u);
            asm volatile("s_waitcnt vmcnt(0)" ::: "memory");
        } else {
            XB_SPIN(xb_ld(&bar[XB_XGEN(b.x)]) == gen, bar);
            __builtin_amdgcn_fence(__ATOMIC_ACQUIRE, "agent");
            asm volatile("s_waitcnt vmcnt(0)" ::: "memory");
        }
    }
    __syncthreads();
}

enum Op { OP_PREP, OP_QKV, OP_ATTN, OP_RG1, OP_RGCONV, OP_RGGATES, OP_RGSCAN, OP_SC1, OP_SCCONV, OP_RESID_MIX, OP_FFNUP, OP_RESID_FFN, OP_NORM_FINAL };
constexpr int NSTEPS = 24;
constexpr int CW_CNT = 3584;

__global__ void __launch_bounds__(512, 2) mega_fwd(Params p) {
    extern __shared__ __attribute__((aligned(16))) unsigned char lds_raw[];
    LAS unsigned char* lds = (LAS unsigned char*)lds_raw;
    const int G0 = gridDim.x, bx = blockIdx.x;
    volatile LAS unsigned* MISC = (volatile LAS unsigned*)(lds + 131072);
    if (threadIdx.x < 32) MISC[threadIdx.x] = 0u;
    __syncthreads();
    XcdBarrier bar = xcd_barrier_post((unsigned*)p.ws, MISC + 8);
    const int vcu0 = (G0 % 8 == 0) ? (bx % 8) * (G0 / 8) + bx / 8 : bx;
#if REP_MASK
    for (int it_ = 2 * p.ph_lo; it_ < 2 * p.ph_hi; ++it_) { const int step = it_ >> 1;
#else
    for (int step = p.ph_lo; step < p.ph_hi; ++step) {
#endif
        int tid = threadIdx.x, G = G0, vcu = vcu0; unsigned char* ws = p.ws; float* X = p.out;
        asm volatile("" : "+v"(tid)); asm volatile("" : "+s"(G)); asm volatile("" : "+s"(vcu)); asm volatile("" : "+s"(ws)); asm volatile("" : "+s"(X));
        bf16_t* XN = (bf16_t*)(ws + WS_XN);
        float* PART = (float*)(ws + WS_S3);
        int op, layer = 0;
        if (step == 0) op = OP_PREP;
        else if (step == NSTEPS - 1) { op = OP_NORM_FINAL; layer = 3; }
        else {
            int s = step - 1, li;
            if (s < 5) { layer = 0; li = s; } else if (s < 12) { layer = 1; li = s - 5; } else if (s < 17) { layer = 2; li = s - 12; } else { layer = 3; li = s - 17; }
            const int kind = layer % 3, nmix = kind == 1 ? 4 : 2;
            if (li < nmix) op = kind == 0 ? (li == 0 ? OP_QKV : OP_ATTN) : kind == 1 ? (OP_RG1 + li) : (li == 0 ? OP_SC1 : OP_SCCONV);
            else op = OP_RESID_MIX + (li - nmix);
        }
        const int kind = layer % 3, j = layer / 3;
#if REP_MASK
        if ((it_ & 1) && !((REP_MASK >> op) & 1)) continue;
#endif
        pg8::GSched S; S.G = G; S.c = vcu; S.mode = 0; S.nsplit = NSPLIT_MIX; S.cnt = nullptr; S.lda = DM; S.ldb = DM; S.nt = 16; S.A = (const char*)XN;
        switch (op) {
        case OP_PREP: prep_phase(p, lds, vcu, G, tid); break;
        case OP_QKV: { S.Bt = (const char*)(ws + WS_WQKV + (size_t)j * NQKV * 1024 * 2); S.nN = 5;
            pg8::EpiQKV E{(bf16_t*)(ws + WS_S0), p.in[11] + j * NQKV, (const float*)(ws + WS_ROPE), (const float*)(ws + WS_SS)};
            pg8::gemm_phase<DM, DM>(lds, S, E, tid);
            if (layer == 0) convert_in_slack(p, ws, lds, 1, 68 * 5, vcu, G, tid); } break;
        case OP_ATTN: attn_phase(p, lds, j, vcu, G, tid); break;
        case OP_RG1: { S.Bt = (const char*)(ws + WS_WRG1); S.nN = 8;
            pg8::EpiPair<1> E{(bf16_t*)(ws + WS_S0), (bf16_t*)(ws + WS_S1), (const float*)(ws + WS_SS)};
            pg8::gemm_phase<DM, DM>(lds, S, E, tid);
            convert_in_slack(p, ws, lds, 2, 68 * 8, vcu, G, tid); } break;
        case OP_RGCONV: rgconv_phase(p, vcu, G, tid); break;
        case OP_RGGATES: { S.A = (const char*)(ws + WS_S3); S.Bt = (const char*)(ws + WS_WRG2); S.ldb = 256; S.nN = 8; S.nt = 4; S.mode = 2;
            pg8::EpiRgGates E{(const bf16_t*)(ws + WS_S3), (bf16_t*)(ws + WS_S1), (bf16_t*)(ws + WS_S2), p.in[20], p.in[22], (const float*)(ws + WS_C8)};
            pg8::gemm_phase<DM, 256>(lds, S, E, tid);
            convert_in_slack(p, ws, lds, 3, 68 * 8, vcu, G, tid); } break;
        case OP_RGSCAN: rgscan_phase(p, lds, vcu, G, tid); break;
        case OP_SC1: { S.Bt = (const char*)(ws + WS_WSC1); S.nN = 12;
            pg8::EpiPair<2> E{(bf16_t*)(ws + WS_S0), (bf16_t*)(ws + WS_S1), (const float*)(ws + WS_SS)};
            pg8::gemm_phase<DM, DM>(lds, S, E, tid);
            convert_in_slack(p, ws, lds, 4, 68 * 12, vcu, G, tid); } break;
        case OP_SCCONV: scconv_phase(p, vcu, G, tid); break;
        case OP_RESID_MIX: {
            const float* bias = (const float*)(ws + WS_ZB); S.nN = 4; S.mode = 1;
            if (kind == 0) { S.A = (const char*)(ws + WS_S2); S.Bt = (const char*)(ws + WS_WO + (size_t)j * 1024 * 1024 * 2); bias = p.in[13] + j * DM; }
            else if (kind == 1) { S.A = (const char*)(ws + WS_S0); S.Bt = (const char*)(ws + WS_WRG3); }
            else { S.A = (const char*)(ws + WS_S2); S.Bt = (const char*)(ws + WS_WSC2); }
            S.cnt = (unsigned*)ws + CW_CNT + 64 * (2 * layer);
            if (layer == 0) { pg8::EpiResid<true> E{p.in[0], PART, bias, XN, (float*)(ws + WS_SS)}; pg8::gemm_phase<DM, DM>(lds, S, E, tid); }
            else { pg8::EpiResid<false> E{nullptr, PART, bias, XN, (float*)(ws + WS_SS)}; pg8::gemm_phase<DM, DM>(lds, S, E, tid); }
            fin_slack(layer == 0 ? p.in[1] : X + (size_t)MP * DM, X, PART, NSPLIT_MIX, bias, XN, (float*)(ws + WS_SS), S.cnt, 16 * NSPLIT_MIX, vcu, G, tid);
            } break;
        case OP_RESID_FFN: {
            S.nN = 4; S.mode = 1; S.nsplit = NSPLIT_FFN; S.A = (const char*)(ws + WS_S0); S.lda = DFF; S.ldb = DFF; S.nt = 44; S.Bt = (const char*)(ws + WS_WFD + (size_t)layer * 1024 * DFF * 2);
            S.cnt = (unsigned*)ws + CW_CNT + 64 * (2 * layer + 1);
            pg8::EpiResid<false> E{nullptr, PART, (const float*)(ws + WS_ZB), XN, (float*)(ws + WS_SS)};
            pg8::gemm_phase<DFF, DFF>(lds, S, E, tid);
            fin_slack(X + (size_t)MP * DM, X, PART, NSPLIT_FFN, (const float*)(ws + WS_ZB), XN, (float*)(ws + WS_SS), S.cnt, 16 * NSPLIT_FFN, vcu, G, tid); } break;
        case OP_FFNUP: { S.Bt = (const char*)(ws + WS_WFU + (size_t)layer * 5632 * 1024 * 2); S.nN = 22;
            pg8::EpiPair<0> E{(bf16_t*)(ws + WS_S0), nullptr, (const float*)(ws + WS_SS)};
            pg8::gemm_phase<DM, DM>(lds, S, E, tid); } break;
        case OP_NORM_FINAL: norm_phase(X, PART, 0, nullptr, p.in[9], XN, true, vcu, G, tid); break;
        }
#if REP_MASK
        xcd_barrier(bar);
#else
        if (step + 1 < p.ph_hi) xcd_barrier(bar);
#endif
#if EXTRA_SYNC
        xcd_barrier(bar);
#endif
    }
}

#ifndef MK_N_LAUNCHES
#define MK_N_LAUNCHES 1
#endif
extern "C" void kernel_launch(void* const* d_in, const int* in_sizes, int n_in, void* d_out, int out_size, void* d_ws, size_t ws_size, hipStream_t stream) {
    static int grid = 0;
    if (grid == 0) {
        int dev = 0, cus = 0, per_cu = 0;
        hipGetDevice(&dev);
        hipDeviceGetAttribute(&cus, hipDeviceAttributeMultiprocessorCount, dev);
        hipFuncSetAttribute((const void*)mega_fwd, hipFuncAttributeMaxDynamicSharedMemorySize, LDS_BYTES);
        hipOccupancyMaxActiveBlocksPerMultiprocessor(&per_cu, (const void*)mega_fwd, 512, LDS_BYTES);
        if (per_cu < 1) { fprintf(stderr, "kernel_launch: occupancy query reports %d blocks per CU\n", per_cu); per_cu = 1; }
        if (per_cu > 1) per_cu = 1;
        grid = cus * per_cu;
        if (n_in != 31 || ws_size < 268 * MiB) fprintf(stderr, "kernel_launch: unexpected n_in %d / ws_size %zu\n", n_in, ws_size);
    }
    hipMemsetAsync(d_ws, 0, 16384, stream);
    Params p{};
    for (int i = 0; i < 31; ++i) p.in[i] = (const float*)d_in[i];
    p.out = (float*)d_out; p.ws = (unsigned char*)d_ws;
    const int nl = MK_N_LAUNCHES;
    for (int li = 0; li < nl; ++li) {
        p.ph_lo = (int)((long)NSTEPS * li / nl); p.ph_hi = (int)((long)NSTEPS * (li + 1) / nl);
        void* args[] = {&p};
        hipError_t e = hipLaunchCooperativeKernel((const void*)mega_fwd, dim3(grid), dim3(512), args, LDS_BYTES, stream);
        if (e != hipSuccess) fprintf(stderr, "cooperative launch failed: %s (grid %d)\n", hipGetErrorString(e), grid);
    }
}
```

```cpp
#include <hip/hip_runtime.h>
#include <hip/hip_cooperative_groups.h>
#include <cstdint>
#include <cstdio>
namespace cg = cooperative_groups;
#ifndef REP_MASK
#define REP_MASK 0
#endif
constexpr int NSPLIT_MIX = 4, NSPLIT_FFN = 8;
#ifndef EXTRA_SYNC
#define EXTRA_SYNC 0
#endif

#define LAS __attribute__((address_space(3)))
typedef unsigned short bf16_t;
typedef short bf16x8 __attribute__((ext_vector_type(8)));
typedef short s16x4 __attribute__((ext_vector_type(4)));
typedef float f32x4 __attribute__((ext_vector_type(4)));
typedef float f32x2 __attribute__((ext_vector_type(2)));
typedef float f32x16 __attribute__((ext_vector_type(16)));
typedef unsigned u32x4 __attribute__((ext_vector_type(4)));
typedef unsigned u32x2 __attribute__((ext_vector_type(2)));

constexpr int DM = 1024, MP = 16384, MS = 1024, M = MP + MS, SEQ = 4096, DFF = 2816, NQKV = 1280;
constexpr float EPS = 1e-6f, LOG2E = 1.4426950408889634f;
constexpr size_t MiB = 1u << 20;
constexpr size_t WS_ROPE = 1 * MiB;
constexpr size_t WS_RSTD = 4 * MiB;
constexpr size_t WS_SS = 5 * MiB;
constexpr size_t WS_ZB = 3 * MiB + 65536;
constexpr size_t WS_C8 = 3 * MiB;
constexpr size_t WS_WQKV = 8 * MiB;
constexpr size_t WS_WO = 13 * MiB;
constexpr size_t WS_WFU = 17 * MiB;
constexpr size_t WS_WFD = 61 * MiB;
constexpr size_t WS_WRG1 = 83 * MiB, WS_WRG2 = 87 * MiB, WS_WRG3 = 88 * MiB, WS_WSC1 = 90 * MiB, WS_WSC2 = 96 * MiB;
constexpr size_t WS_XN = 98 * MiB;
constexpr size_t SLOT = 34 * MiB;
constexpr size_t WS_S0 = 132 * MiB, WS_S1 = WS_S0 + SLOT, WS_S2 = WS_S1 + SLOT, WS_S3 = WS_S2 + SLOT;
constexpr size_t O_KP = 17825792, O_VP = 17956864, O_KS = 18087936, O_VS = 22282240, O_HP = 26476544, O_HS = 26480640,
                 O_RCP = 26611712, O_RCS = 26624000, O_SCP = 27017216, O_SCS = 27025408;

constexpr int LDS_BYTES = 131072 + 1024;

__device__ __forceinline__ unsigned cvt_pk_bf16(float lo, float hi) { unsigned r; asm volatile("v_cvt_pk_bf16_f32 %0, %1, %2" : "=v"(r) : "v"(lo), "v"(hi)); return r; }
__device__ __forceinline__ float bf2f(unsigned short v) { return __uint_as_float(((unsigned)v) << 16); }
__device__ __forceinline__ float bflo(unsigned w) { return __uint_as_float(w << 16); }
__device__ __forceinline__ float bfhi(unsigned w) { return __uint_as_float(w & 0xffff0000u); }
__device__ __forceinline__ float fast_sigmoid(float x) { return __builtin_amdgcn_rcpf(1.0f + __builtin_amdgcn_exp2f(-x * LOG2E)); }
__device__ __forceinline__ float wave_sum(float v) {
#pragma unroll
    for (int o = 1; o < 64; o <<= 1) v += __shfl_xor(v, o);
    return v;
}

namespace pg8 {
constexpr int BM = 256, BK = 64, HALF = 128, HTB = HALF * BK * 2, STAGE_BYTES = 8 * HTB;
__device__ __forceinline__ int lds_byte(int r, int c) { const int st = (r >> 4) * 2 + (c >> 5), rr = r & 15, cc = c & 31, ob = rr * 64 + cc * 2; return st * 1024 + (ob ^ (((ob >> 9) & 1) << 5)); }
__device__ __forceinline__ void stage_rc(int b, int& R, int& C) { const int st = b / 1024, sb = b % 1024, swz = sb ^ (((sb >> 9) & 1) << 5); R = (st >> 1) * 16 + swz / 64; C = (st & 1) * 32 + (swz % 64) / 2; }
__device__ __forceinline__ int perm32(int rho) { const int n = rho >> 4, i = rho & 15; return 8 * (i >> 2) + 4 * n + (i & 3); }

struct Unit { int pm, pn, nt, aux; const char* a; const char* b; };

struct GSched {
    const char* A; const char* Bt; int lda, ldb, nN, nt, mode, G, c, nsplit, c2;
    __device__ __forceinline__ bool next(int i, Unit& u) const {
        int L = i * G + c; const int nP = 64 * nN; int kt0 = 0; u.nt = nt; u.aux = 0;
        if (mode == 1) {
            const int nS = 4 * nsplit * nN;
            const bool hasS = (nS <= G) && (c2 < nS);
            if (nS <= G) {
                if (hasS && i == 0) L = c2; else L = nS + (i - (hasS ? 1 : 0)) * G + c;
            }
            if (L < nS) {
                const int sl = L % nsplit; u.pn = (L / nsplit) % nN; u.pm = 64 + (L / nsplit) / nN; u.aux = 1 + sl;
                const int q = (nt / (2 * nsplit)) * 2, extra = (nt - nsplit * q) >> 1;
                u.nt = sl < extra ? q + 2 : q; kt0 = sl < extra ? sl * (q + 2) : extra * (q + 2) + (sl - extra) * q;
            } else {
                L -= nS; if (L >= nP) return false;
                const int g = L / (8 * nN), r = L - g * 8 * nN; u.pm = 8 * g + (r & 7); u.pn = r >> 3;
            }
        } else if (L < nP) { const int g = L / (8 * nN), r = L - g * 8 * nN; u.pm = 8 * g + (r & 7); u.pn = r >> 3; }
        else { L -= nP; if (L >= 4 * nN) return false; u.pm = 64 + (L & 3); u.pn = L >> 2; }
        u.a = A + ((size_t)u.pm * 256 * lda + (size_t)kt0 * 64 + (mode == 2 ? 256 * (u.pn >> 1) : 0)) * 2;
        u.b = Bt + ((size_t)u.pn * 256 * ldb + (size_t)kt0 * 64) * 2;
        return true;
    }
};

template <int LDA, int LDB, class Epi>
__device__ __forceinline__ void gemm_phase(LAS unsigned char* lds, const GSched& S, const Epi& E, const int tid) {
    const int wid = __builtin_amdgcn_readfirstlane(tid >> 6), lane = tid & 63, wr = wid >> 2, wc = wid & 3, fr = lane & 15, fq = lane >> 4;
    constexpr int lda = LDA, ldb = LDB;
    unsigned voffA[2], voffB[2];
#pragma unroll
    for (int i = 0; i < 2; ++i) { int R, C; stage_rc(tid * 16 + i * 8192, R, C); const int Rb = Epi::PERM ? ((R & ~31) + perm32(R & 31)) : R;
        voffA[i] = (unsigned)(R * lda + C) * 2u; voffB[i] = (unsigned)(Rb * ldb + C) * 2u; }
    const size_t kstep = (size_t)(BK * 2);
    const size_t hstepA = (size_t)HALF * lda * 2, hstepB = (size_t)HALF * ldb * 2;
    const unsigned ldsw = (unsigned)wid * 1024u;
    const int aoff = lds_byte(wr * 64 + fr, fq * 8), boff = lds_byte(wc * 32 + fr, fq * 8);
#define PG8_SA(b, h) (((b) * 2 + (h)) * HTB)
#define PG8_SB(b, h) ((4 + (b) * 2 + (h)) * HTB)
#define PG8_STAGE(bufoff, gbase, voff) do { _Pragma("unroll") for (int _i = 0; _i < 2; ++_i) \
        __builtin_amdgcn_global_load_lds((const unsigned*)((const char*)(gbase) + (voff)[_i]), (LAS unsigned*)(lds + (bufoff) + ldsw + _i * 8192), 16, 0, 0); } while (0)
#define PG8_LDA(dst, b, h) do { _Pragma("unroll") for (int m = 0; m < 4; ++m) _Pragma("unroll") for (int k = 0; k < 2; ++k) dst[m][k] = *(const LAS bf16x8*)(lds + PG8_SA(b, h) + aoff + m * 2048 + k * 1024); } while (0)
#define PG8_LDB(dst, b, h) do { _Pragma("unroll") for (int n = 0; n < 2; ++n) _Pragma("unroll") for (int k = 0; k < 2; ++k) dst[n][k] = *(const LAS bf16x8*)(lds + PG8_SB(b, h) + boff + n * 2048 + k * 1024); } while (0)
#define PG8_MMA(ai, bj, At, Bt) do { __builtin_amdgcn_s_setprio(1); _Pragma("unroll") for (int m = 0; m < 4; ++m) _Pragma("unroll") for (int n = 0; n < 2; ++n) _Pragma("unroll") for (int k = 0; k < 2; ++k) \
        acc[ai][bj][m][n] = __builtin_amdgcn_mfma_f32_16x16x32_bf16(Bt[n][k], At[m][k], acc[ai][bj][m][n], 0, 0, 0); __builtin_amdgcn_s_setprio(0); } while (0)
#define PG8_WAIT_V(n) asm volatile("s_waitcnt vmcnt(" #n ")" ::: "memory")
#define PG8_WAIT_L(n) asm volatile("s_waitcnt lgkmcnt(" #n ")" ::: "memory")
#define PG8_BAR __builtin_amdgcn_s_barrier()
#define PG8_SCHED __builtin_amdgcn_sched_barrier(0)
    Unit cur, nxt; int ui = 0;
    if (!S.next(0, cur)) return;
    f32x4 acc[2][2][4][2];
#pragma unroll
    for (int a = 0; a < 2; ++a)
#pragma unroll
        for (int b = 0; b < 2; ++b)
#pragma unroll
            for (int m = 0; m < 4; ++m)
#pragma unroll
                for (int n = 0; n < 2; ++n) acc[a][b][m][n] = (f32x4){0.f, 0.f, 0.f, 0.f};
    bf16x8 At[4][2], B0[2][2], B1[2][2];
    const char* cA = cur.a; const char* cB = cur.b;
    PG8_STAGE(PG8_SB(0, 0), cB, voffB); PG8_STAGE(PG8_SB(0, 1), cB + hstepB, voffB); PG8_STAGE(PG8_SA(0, 0), cA, voffA); PG8_STAGE(PG8_SA(0, 1), cA + hstepA, voffA);
    if (wr == 1) PG8_BAR;
    PG8_WAIT_V(2); PG8_BAR;
    PG8_STAGE(PG8_SB(1, 0), cB + kstep, voffB); PG8_STAGE(PG8_SA(1, 0), cA + kstep, voffA); PG8_STAGE(PG8_SB(1, 1), cB + hstepB + kstep, voffB);
    PG8_WAIT_V(6); PG8_BAR;
    for (;;) {
        const bool has_next = S.next(ui + 1, nxt);
        const char* nA = has_next ? nxt.a : cA; const char* nB = has_next ? nxt.b : cB;
        const int nt = cur.nt;
        for (int t = 0; t < nt; t += 2) {
            const bool last = (t == nt - 2);
            const char* a1 = cA + (size_t)(t + 1) * kstep;
            const char* a2 = last ? nA : cA + (size_t)(t + 2) * kstep; const char* b2 = last ? nB : cB + (size_t)(t + 2) * kstep;
            const char* a3 = a2 + kstep; const char* b3 = b2 + kstep;
            PG8_LDB(B0, 0, 0); PG8_LDB(B1, 0, 1); PG8_SCHED; PG8_LDA(At, 0, 0); PG8_STAGE(PG8_SA(1, 1), a1 + hstepA, voffA);
            PG8_WAIT_V(8); PG8_WAIT_L(0); PG8_BAR; PG8_MMA(0, 0, At, B0); PG8_MMA(0, 1, At, B1); PG8_BAR; PG8_SCHED;
            PG8_LDA(At, 0, 1); PG8_STAGE(PG8_SB(0, 0), b2, voffB); PG8_STAGE(PG8_SB(0, 1), b2 + hstepB, voffB); PG8_STAGE(PG8_SA(0, 0), a2, voffA);
            PG8_WAIT_V(8); PG8_WAIT_L(0); PG8_BAR; PG8_MMA(1, 0, At, B0); PG8_MMA(1, 1, At, B1); PG8_BAR; PG8_SCHED;
            PG8_LDB(B0, 1, 0); PG8_LDB(B1, 1, 1); PG8_SCHED; PG8_LDA(At, 1, 0); PG8_STAGE(PG8_SA(0, 1), a2 + hstepA, voffA);
            PG8_WAIT_V(8); PG8_WAIT_L(0); PG8_BAR; PG8_MMA(0, 0, At, B0); PG8_MMA(0, 1, At, B1); PG8_BAR; PG8_SCHED;
            PG8_LDA(At, 1, 1); PG8_STAGE(PG8_SB(1, 0), b3, voffB); PG8_STAGE(PG8_SB(1, 1), b3 + hstepB, voffB); PG8_STAGE(PG8_SA(1, 0), a3, voffA);
            PG8_WAIT_V(8); PG8_WAIT_L(0); PG8_BAR; PG8_MMA(1, 0, At, B0); PG8_MMA(1, 1, At, B1); PG8_BAR; PG8_SCHED;
        }
        if (wr == 0) PG8_BAR;
        E(acc, cur, wr, wc, fr, fq);
        if (!has_next) break;
#pragma unroll
        for (int a = 0; a < 2; ++a)
#pragma unroll
            for (int b = 0; b < 2; ++b)
#pragma unroll
                for (int m = 0; m < 4; ++m)
#pragma unroll
                    for (int n = 0; n < 2; ++n) acc[a][b][m][n] = (f32x4){0.f, 0.f, 0.f, 0.f};
        cur = nxt; cA = nA; cB = nB; ++ui;
        if (wr == 1) PG8_BAR;
    }
    PG8_WAIT_V(0);
    PG8_BAR;
#undef PG8_SA
#undef PG8_SB
#undef PG8_STAGE
#undef PG8_LDA
#undef PG8_LDB
#undef PG8_MMA
#undef PG8_WAIT_V
#undef PG8_WAIT_L
#undef PG8_BAR
#undef PG8_SCHED
}

struct EpiQKV {
    static constexpr bool PERM = true;
    bf16_t* O; const float* bias; const float* rope; const float* rstd;
    __device__ __forceinline__ void operator()(const f32x4 (&acc)[2][2][4][2], const Unit& u, int wr, int wc, int fr, int fq) const {
        const int H = 4 * u.pn + wc, colb = H * 64 + 8 * fq;
        const f32x4 bl0 = *(const f32x4*)(bias + colb), bl1 = *(const f32x4*)(bias + colb + 4), bh0 = *(const f32x4*)(bias + colb + 32), bh1 = *(const f32x4*)(bias + colb + 36);
        const bool rot = H < 18;
        const int row0 = u.pm * 256 + wr * 64 + fr;
        float rs[8];
#pragma unroll
        for (int g = 0; g < 8; ++g) rs[g] = rstd[row0 + (g >> 2) * 128 + (g & 3) * 16];
        f32x4 cs[2][4];
#define QKV_LOADCS(g, b) do { const int row_ = row0 + ((g) >> 2) * 128 + ((g) & 3) * 16; const int pidx_ = row_ < MP ? (row_ & (SEQ - 1)) : SEQ + ((row_ - MP) & 7); \
            const float* rp_ = rope + (size_t)pidx_ * 64 + 8 * fq; cs[b][0] = *(const f32x4*)(rp_); cs[b][1] = *(const f32x4*)(rp_ + 4); cs[b][2] = *(const f32x4*)(rp_ + 32); cs[b][3] = *(const f32x4*)(rp_ + 36); } while (0)
        QKV_LOADCS(0, 0);
#pragma unroll
        for (int g = 0; g < 8; ++g) {
            const int ai = g >> 2, m = g & 3, b = g & 1;
            if (g + 1 < 8) QKV_LOADCS(g + 1, b ^ 1);
            const int row = row0 + ai * 128 + m * 16;
            f32x4 c0 = cs[b][0], c1 = cs[b][1], s0 = cs[b][2], s1 = cs[b][3];
            if (!rot) { c0 = (f32x4){1.f, 1.f, 1.f, 1.f}; c1 = c0; s0 = (f32x4){0.f, 0.f, 0.f, 0.f}; s1 = s0; }
            const float r = rs[g];
            const f32x4 l0 = acc[ai][0][m][0] * r + bl0, l1 = acc[ai][0][m][1] * r + bl1, h0 = acc[ai][1][m][0] * r + bh0, h1 = acc[ai][1][m][1] * r + bh1;
            const f32x4 ol0 = l0 * c0 - h0 * s0, ol1 = l1 * c1 - h1 * s1, oh0 = h0 * c0 + l0 * s0, oh1 = h1 * c1 + l1 * s1;
            bf16_t* op = O + (size_t)row * NQKV + colb;
            u32x4 w; w.x = cvt_pk_bf16(ol0[0], ol0[1]); w.y = cvt_pk_bf16(ol0[2], ol0[3]); w.z = cvt_pk_bf16(ol1[0], ol1[1]); w.w = cvt_pk_bf16(ol1[2], ol1[3]);
            *(u32x4*)op = w;
            w.x = cvt_pk_bf16(oh0[0], oh0[1]); w.y = cvt_pk_bf16(oh0[2], oh0[3]); w.z = cvt_pk_bf16(oh1[0], oh1[1]); w.w = cvt_pk_bf16(oh1[2], oh1[3]);
            *(u32x4*)(op + 32) = w;
        }
#undef QKV_LOADCS
    }
};
template <int MODE> struct EpiPair {
    static constexpr bool PERM = true;
    bf16_t* O0; bf16_t* O1; const float* rstd;
    __device__ __forceinline__ void operator()(const f32x4 (&acc)[2][2][4][2], const Unit& u, int wr, int wc, int fr, int fq) const {
        const int cc = 32 * wc + 8 * fq;
        float rsv[8];
#pragma unroll
        for (int g = 0; g < 8; ++g) rsv[g] = rstd[u.pm * 256 + wr * 64 + fr + (g >> 2) * 128 + (g & 3) * 16];
#pragma unroll
        for (int ai = 0; ai < 2; ++ai)
#pragma unroll
            for (int m = 0; m < 4; ++m) {
                const size_t row = (size_t)(u.pm * 256 + ai * 128 + wr * 64 + m * 16 + fr);
                const float rs = rsv[ai * 4 + m];
                f32x4 p0 = acc[ai][0][m][0] * rs, p1 = acc[ai][0][m][1] * rs, q0 = acc[ai][1][m][0] * rs, q1 = acc[ai][1][m][1] * rs;
                u32x4 w;
                if (MODE == 0) {
                    const float c1 = -rs * LOG2E, c2 = rs * rs;
                    const f32x4 a0 = acc[ai][0][m][0], a1 = acc[ai][0][m][1], b0 = acc[ai][1][m][0], b1 = acc[ai][1][m][1];
                    f32x4 t0 = a0 * c1, t1 = a1 * c1;
#pragma unroll
                    for (int j = 0; j < 4; ++j) { t0[j] = __builtin_amdgcn_exp2f(t0[j]); t1[j] = __builtin_amdgcn_exp2f(t1[j]); }
                    t0 = t0 + 1.0f; t1 = t1 + 1.0f;
#pragma unroll
                    for (int j = 0; j < 4; ++j) { t0[j] = __builtin_amdgcn_rcpf(t0[j]); t1[j] = __builtin_amdgcn_rcpf(t1[j]); }
                    p0 = (a0 * b0) * c2 * t0; p1 = (a1 * b1) * c2 * t1;
                    w.x = cvt_pk_bf16(p0[0], p0[1]); w.y = cvt_pk_bf16(p0[2], p0[3]); w.z = cvt_pk_bf16(p1[0], p1[1]); w.w = cvt_pk_bf16(p1[2], p1[3]);
                    *(u32x4*)(O0 + row * DFF + 128 * u.pn + cc) = w;
                } else if (MODE == 1) {
#pragma unroll
                    for (int j = 0; j < 4; ++j) { float x = p0[j]; p0[j] = x * fast_sigmoid(1.5957691216f * (x + 0.044715f * x * x * x)); x = p1[j]; p1[j] = x * fast_sigmoid(1.5957691216f * (x + 0.044715f * x * x * x)); }
                    w.x = cvt_pk_bf16(p0[0], p0[1]); w.y = cvt_pk_bf16(p0[2], p0[3]); w.z = cvt_pk_bf16(p1[0], p1[1]); w.w = cvt_pk_bf16(p1[2], p1[3]);
                    *(u32x4*)(O0 + row * DM + 128 * u.pn + cc) = w;
                    w.x = cvt_pk_bf16(q0[0], q0[1]); w.y = cvt_pk_bf16(q0[2], q0[3]); w.z = cvt_pk_bf16(q1[0], q1[1]); w.w = cvt_pk_bf16(q1[2], q1[3]);
                    *(u32x4*)(O1 + row * DM + 128 * u.pn + cc) = w;
                } else {
                    if (u.pn < 8) {
                        p0 = p0 * q0; p1 = p1 * q1;
                        w.x = cvt_pk_bf16(p0[0], p0[1]); w.y = cvt_pk_bf16(p0[2], p0[3]); w.z = cvt_pk_bf16(p1[0], p1[1]); w.w = cvt_pk_bf16(p1[2], p1[3]);
                        *(u32x4*)(O0 + row * DM + 128 * u.pn + cc) = w;
                    } else {
                        w.x = cvt_pk_bf16(p0[0], p0[1]); w.y = cvt_pk_bf16(p0[2], p0[3]); w.z = cvt_pk_bf16(p1[0], p1[1]); w.w = cvt_pk_bf16(p1[2], p1[3]);
                        *(u32x4*)(O1 + row * DM + 256 * (u.pn - 8) + cc) = w;
                        w.x = cvt_pk_bf16(q0[0], q0[1]); w.y = cvt_pk_bf16(q0[2], q0[3]); w.z = cvt_pk_bf16(q1[0], q1[1]); w.w = cvt_pk_bf16(q1[2], q1[3]);
                        *(u32x4*)(O1 + row * DM + 256 * (u.pn - 8) + 128 + cc) = w;
                    }
                }
            }
    }
};
struct EpiRgGates {
    static constexpr bool PERM = true;
    const bf16_t* U; bf16_t* LA; bf16_t* Bv; const float* ba; const float* bx; const float* c8;
    __device__ __forceinline__ void operator()(const f32x4 (&acc)[2][2][4][2], const Unit& u, int wr, int wc, int fr, int fq) const {
        const int ch = 128 * u.pn + 32 * wc + 8 * fq;
        f32x4 vba[2], vbx[2], vc8[2];
#pragma unroll
        for (int n = 0; n < 2; ++n) { vba[n] = *(const f32x4*)(ba + ch + 4 * n); vbx[n] = *(const f32x4*)(bx + ch + 4 * n); vc8[n] = *(const f32x4*)(c8 + ch + 4 * n); }
        u32x4 uws[8];
#pragma unroll
        for (int g = 0; g < 8; ++g) uws[g] = *(const u32x4*)(U + (size_t)(u.pm * 256 + (g >> 2) * 128 + wr * 64 + (g & 3) * 16 + fr) * DM + ch);
#pragma unroll
        for (int ai = 0; ai < 2; ++ai)
#pragma unroll
            for (int m = 0; m < 4; ++m) {
                const size_t off = (size_t)(u.pm * 256 + ai * 128 + wr * 64 + m * 16 + fr) * DM + ch;
                const u32x4 uw = uws[ai * 4 + m];
                float la[8], bb[8];
#pragma unroll
                for (int n = 0; n < 2; ++n)
#pragma unroll
                    for (int j = 0; j < 4; ++j) {
                        const float r = fast_sigmoid(acc[ai][0][m][n][j] + vba[n][j]), ig = fast_sigmoid(acc[ai][1][m][n][j] + vbx[n][j]);
                        const float l2 = vc8[n][j] * r; const float a2 = __builtin_amdgcn_exp2f(2.f * l2);
                        const unsigned uu = uw[n * 2 + (j >> 1)]; const float uv = (j & 1) ? bfhi(uu) : bflo(uu);
                        la[n * 4 + j] = l2; bb[n * 4 + j] = __builtin_sqrtf(fmaxf(1.f - a2, 0.f)) * ig * uv;
                    }
                u32x4 w; w.x = cvt_pk_bf16(la[0], la[1]); w.y = cvt_pk_bf16(la[2], la[3]); w.z = cvt_pk_bf16(la[4], la[5]); w.w = cvt_pk_bf16(la[6], la[7]);
                *(u32x4*)(LA + off) = w;
                w.x = cvt_pk_bf16(bb[0], bb[1]); w.y = cvt_pk_bf16(bb[2], bb[3]); w.z = cvt_pk_bf16(bb[4], bb[5]); w.w = cvt_pk_bf16(bb[6], bb[7]);
                *(u32x4*)(Bv + off) = w;
            }
    }
};
template <bool FIRST> struct EpiResid {
    static constexpr bool PERM = false;
    const float* Xin; float* PART; const float* bias; bf16_t* XB; float* SS;
    __device__ __forceinline__ void operator()(const f32x4 (&acc)[2][2][4][2], const Unit& u, int wr, int wc, int fr, int fq) const {
        const int col0 = u.pn * 256 + wc * 32 + 4 * fq;
        if (u.aux == 0) {
            f32x4 bv[2][2];
#pragma unroll
            for (int bj = 0; bj < 2; ++bj)
#pragma unroll
                for (int n = 0; n < 2; ++n) bv[bj][n] = *(const f32x4*)(bias + col0 + bj * 128 + n * 16);
            const size_t row0 = (size_t)(u.pm * 256 + wr * 64 + fr);
            f32x4 xin[2][4];
#define RES_LOAD(g, b) do { if (FIRST) { const float* xp_ = Xin + (row0 + ((g) >> 2) * 128 + ((g) & 3) * 16) * DM + col0; \
                    xin[b][0] = *(const f32x4*)(xp_); xin[b][1] = *(const f32x4*)(xp_ + 16); xin[b][2] = *(const f32x4*)(xp_ + 128); xin[b][3] = *(const f32x4*)(xp_ + 144); } \
                else { const bf16_t* xp_ = XB + (row0 + ((g) >> 2) * 128 + ((g) & 3) * 16) * DM + col0; \
                    _Pragma("unroll") for (int q_ = 0; q_ < 4; ++q_) { const u32x2 w_ = *(const u32x2*)(xp_ + (q_ >> 1) * 128 + (q_ & 1) * 16); xin[b][q_] = (f32x4){bflo(w_.x), bfhi(w_.x), bflo(w_.y), bfhi(w_.y)}; } } } while (0)
            RES_LOAD(0, 0);
#pragma unroll
            for (int g = 0; g < 8; ++g) {
                const int ai = g >> 2, m = g & 3, b = g & 1;
                if (g + 1 < 8) RES_LOAD(g + 1, b ^ 1);
                const size_t row = row0 + ai * 128 + m * 16;
                bf16_t* bp = XB + row * DM + col0;
                float ss = 0.f;
#pragma unroll
                for (int bj = 0; bj < 2; ++bj)
#pragma unroll
                    for (int n = 0; n < 2; ++n) {
                        const f32x4 v = xin[b][bj * 2 + n] + acc[ai][bj][m][n] + bv[bj][n];
                        u32x2 w; w.x = cvt_pk_bf16(v[0], v[1]); w.y = cvt_pk_bf16(v[2], v[3]); *(u32x2*)(bp + bj * 128 + n * 16) = w;
                        ss += (v[0] * v[0] + v[1] * v[1]) + (v[2] * v[2] + v[3] * v[3]);
                    }
                ss += __shfl_xor(ss, 16); ss += __shfl_xor(ss, 32);
                if (fq == 0) SS[row * 16 + u.pn * 4 + wc] = ss;
            }
#undef RES_LOAD
        } else {
            float* pp = PART + (size_t)(u.aux - 1) * MS * DM;
#pragma unroll
            for (int ai = 0; ai < 2; ++ai)
#pragma unroll
                for (int m = 0; m < 4; ++m) {
                    float* xp = pp + (size_t)(u.pm * 256 - MP + ai * 128 + wr * 64 + m * 16 + fr) * DM + col0;
#pragma unroll
                    for (int bj = 0; bj < 2; ++bj)
#pragma unroll
                        for (int n = 0; n < 2; ++n) *(f32x4*)(xp + bj * 128 + n * 16) = acc[ai][bj][m][n];
                }
        }
    }
};
}

struct Params { const float* in[31]; float* out; unsigned char* ws; int ph_lo, ph_hi; };

__device__ __forceinline__ unsigned f2bf(float f) { unsigned u = __builtin_bit_cast(unsigned, f); return (u + 0x7fffu + ((u >> 16) & 1u)) >> 16; }
__device__ __forceinline__ unsigned pk2(float lo, float hi) { return f2bf(lo) | (f2bf(hi) << 16); }

struct TItem { const float* S; int Ns, K, n0, k0; bf16_t* WT; const float* gk; };
__device__ __forceinline__ void titem_load(const TItem& t, float (&tv)[32], int lane) {
#pragma unroll
    for (int i = 0; i < 32; ++i) tv[i] = t.S[(size_t)(t.k0 + 2 * i + (lane >> 5)) * t.Ns + (lane & 31)];
}
__device__ __forceinline__ void titem_finish(const TItem& t, const float (&tv)[32], LAS float* scr, int lane) {
    const int c = lane & 7;
    f32x4 g0 = (f32x4){1.f, 1.f, 1.f, 1.f}, g1 = g0;
    if (t.gk) { g0 = *(const f32x4*)(t.gk + t.k0 + 8 * c); g1 = *(const f32x4*)(t.gk + t.k0 + 8 * c + 4); }
#pragma unroll
    for (int i = 0; i < 32; ++i) scr[(2 * i + (lane >> 5)) * 33 + (lane & 31)] = tv[i];
    asm volatile("s_waitcnt lgkmcnt(0)" ::: "memory");
#pragma unroll
    for (int j = 0; j < 4; ++j) { const int n = (lane >> 3) + 8 * j; const LAS float* s = scr + (8 * c) * 33 + n;
        u32x4 o; o.x = pk2(s[0 * 33] * g0.x, s[1 * 33] * g0.y); o.y = pk2(s[2 * 33] * g0.z, s[3 * 33] * g0.w); o.z = pk2(s[4 * 33] * g1.x, s[5 * 33] * g1.y); o.w = pk2(s[6 * 33] * g1.z, s[7 * 33] * g1.w);
        *(u32x4*)(t.WT + (size_t)(t.n0 + n) * t.K + t.k0 + 8 * c) = o; }
    asm volatile("s_waitcnt lgkmcnt(0)" ::: "memory");
}

__device__ __forceinline__ bool titem_decode(const Params& p, unsigned char* ws, int it, TItem& t) {
    constexpr int I_QKV = 16 * 40, I_SQ = 16 * 32, I_FU = 16 * 176, I_FD = 44 * 32, I_RG1 = 16 * 64, I_RG2 = 4 * 64, I_SC1 = 16 * 96;
    constexpr int NITEMS = 2 * I_QKV + 2 * I_SQ + 4 * I_FU + 4 * I_FD + I_RG1 + I_RG2 + I_SQ + I_SC1 + I_SQ;
    if (it >= NITEMS) return false;
        int r = it;
        const float* S; int Ns, K, n0, k0; bf16_t* WT; const float* gk = nullptr;
        if (r < 2 * I_QKV) { const int j = r / I_QKV; r -= j * I_QKV; K = 1024; const int nb = r % 40, kb = r / 40; k0 = 64 * kb; n0 = 32 * nb;
            const int pn = nb >> 3, bj = (nb >> 2) & 1, hh = nb & 3; Ns = NQKV; S = p.in[10] + (size_t)j * 1024 * NQKV + (4 * pn + hh) * 64 + 32 * bj; WT = (bf16_t*)(ws + WS_WQKV) + (size_t)j * NQKV * 1024; gk = p.in[7] + 3 * j * DM; }
        else if ((r -= 2 * I_QKV) < 2 * I_SQ) { const int j = r / I_SQ; r -= j * I_SQ; K = 1024; const int nb = r % 32, kb = r / 32; k0 = 64 * kb; n0 = 32 * nb; Ns = 1024; S = p.in[12] + (size_t)j * 1024 * 1024 + n0; WT = (bf16_t*)(ws + WS_WO) + (size_t)j * 1024 * 1024; }
        else if ((r -= 2 * I_SQ) < 4 * I_FU) { const int i = r / I_FU; r -= i * I_FU; K = 1024; const int nb = r % 176, kb = r / 176; k0 = 64 * kb; n0 = 32 * nb;
            const int pn = nb >> 3, bj = (nb >> 2) & 1, c32 = nb & 3; Ns = DFF; S = (bj ? p.in[29] : p.in[28]) + (size_t)i * 1024 * DFF + 128 * pn + 32 * c32; WT = (bf16_t*)(ws + WS_WFU) + (size_t)i * 5632 * 1024; gk = p.in[8] + i * DM; }
        else if ((r -= 4 * I_FU) < 4 * I_FD) { const int i = r / I_FD; r -= i * I_FD; K = DFF; const int nb = r % 32, kb = r / 32; k0 = 64 * kb; n0 = 32 * nb; Ns = 1024; S = p.in[30] + (size_t)i * DFF * 1024 + n0; WT = (bf16_t*)(ws + WS_WFD) + (size_t)i * 1024 * DFF; }
        else if ((r -= 4 * I_FD) < I_RG1) { K = 1024; const int nb = r % 64, kb = r / 64; k0 = 64 * kb; n0 = 32 * nb;
            const int pn = nb >> 3, bj = (nb >> 2) & 1, c32 = nb & 3; Ns = 1024; S = (bj ? p.in[16] : p.in[15]) + 128 * pn + 32 * c32; WT = (bf16_t*)(ws + WS_WRG1); gk = p.in[7] + 1 * DM; }
        else if ((r -= I_RG1) < I_RG2) { K = 256; const int nb = r % 64, kb = r / 64; k0 = 64 * kb; n0 = 32 * nb;
            const int pn = nb >> 3, bj = (nb >> 2) & 1, c32 = nb & 3; Ns = 256; S = (bj ? p.in[21] : p.in[19]) + (size_t)(pn >> 1) * 65536 + 128 * (pn & 1) + 32 * c32; WT = (bf16_t*)(ws + WS_WRG2); }
        else if ((r -= I_RG2) < I_SQ) { K = 1024; const int nb = r % 32, kb = r / 32; k0 = 64 * kb; n0 = 32 * nb; Ns = 1024; S = p.in[24] + n0; WT = (bf16_t*)(ws + WS_WRG3); }
        else if ((r -= I_SQ) < I_SC1) { K = 1024; const int nb = r % 96, kb = r / 96; k0 = 64 * kb; n0 = 32 * nb;
            const int pn = nb >> 3, bj = (nb >> 2) & 1, c32 = nb & 3; Ns = 3072;
            const int col = pn < 8 ? (bj ? 2048 : 1024) + 128 * pn + 32 * c32 : 256 * (pn - 8) + 128 * bj + 32 * c32; S = p.in[25] + col; WT = (bf16_t*)(ws + WS_WSC1); gk = p.in[7] + 2 * DM; }
        else { r -= I_SC1; K = 1024; const int nb = r % 32, kb = r / 32; k0 = 64 * kb; n0 = 32 * nb; Ns = 1024; S = p.in[27] + n0; WT = (bf16_t*)(ws + WS_WSC2); }
        t.S = S; t.Ns = Ns; t.K = K; t.n0 = n0; t.k0 = k0; t.WT = WT; t.gk = gk;
    return true;
}

__device__ __forceinline__ int set_size(int s) { return s == 0 ? 640 : s == 1 ? 6528 : s == 2 ? 6272 : s == 3 ? 4224 : 5376; }
__device__ __forceinline__ int set_item(int s, int k) {
    if (s == 0) return k;
    if (s == 1) { if (k < 512) return 1280 + k; k -= 512; if (k < 2816) return 2304 + k; k -= 2816; if (k < 1408) return 13568 + k; k -= 1408; return 19200 + k; }
    if (s == 2) { if (k < 2816) return 5120 + k; k -= 2816; if (k < 1408) return 14976 + k; k -= 1408; return 20992 + k; }
    if (s == 3) { if (k < 2816) return 7936 + k; k -= 2816; return 16384 + k; }
    if (k < 640) return 640 + k; k -= 640; if (k < 512) return 1792 + k; k -= 512; if (k < 2816) return 10752 + k; k -= 2816; return 17792 + k;
}
__device__ __forceinline__ void convert_set(const Params& p, unsigned char* ws, LAS float* scr, int set, int widx, int nw, int lane) {
    const int n = set_size(set);
    TItem cur, nxt; float tv[32], tn[32];
    int k = widx;
    bool has = k < n;
    if (has) { titem_decode(p, ws, set_item(set, k), cur); titem_load(cur, tv, lane); }
    while (has) {
        k += nw;
        const bool hn = k < n;
        if (hn) { titem_decode(p, ws, set_item(set, k), nxt); titem_load(nxt, tn, lane); }
        titem_finish(cur, tv, scr, lane);
#pragma unroll
        for (int i = 0; i < 32; ++i) tv[i] = tn[i];
        cur = nxt; has = hn;
    }
}
__device__ __forceinline__ void convert_in_slack(const Params& p, unsigned char* ws, LAS unsigned char* lds, int set, int nU, int vcu, int G, const int tid) {
    const int first = nU % G, nidle = first == 0 ? G : G - first;
    const int k0 = first == 0 ? 0 : first;
    if (vcu < k0) return;
    const int lane = tid & 63, wave = __builtin_amdgcn_readfirstlane(tid >> 6);
    convert_set(p, ws, (LAS float*)(lds + wave * 16384), set, (vcu - k0) * 8 + wave, nidle * 8, lane);
}

__device__ __forceinline__ void prep_phase(const Params& p, LAS unsigned char* lds, int vcu, int G, const int tid) {
    const int lane = tid & 63, wave = __builtin_amdgcn_readfirstlane(tid >> 6);
    LAS float* scr = (LAS float*)(lds + wave * 16384);
    const int gw = vcu * 8 + wave, NGW = G * 8;
    unsigned char* ws = p.ws;
    convert_set(p, ws, scr, 0, gw, NGW, lane);
    {
        float* rstd = (float*)(ws + WS_RSTD);
        for (int m = gw; m < M; m += NGW) {
            const float* src = m < MP ? p.in[0] + (size_t)m * DM : p.in[1] + (size_t)(m - MP) * DM;
            f32x4 v[4]; float s = 0.f;
#pragma unroll
            for (int j = 0; j < 4; ++j) { v[j] = *((const f32x4*)src + lane + 64 * j); s += (v[j].x * v[j].x + v[j].y * v[j].y) + (v[j].z * v[j].z + v[j].w * v[j].w); }
            s = wave_sum(s);
            if (lane == 0) rstd[m] = 1.0f / sqrtf(s * (1.f / DM) + EPS);
            u32x2* no = (u32x2*)((bf16_t*)(ws + WS_XN) + (size_t)m * DM) + lane;
#pragma unroll
            for (int j = 0; j < 4; ++j) { u32x2 w; w.x = cvt_pk_bf16(v[j].x, v[j].y); w.y = cvt_pk_bf16(v[j].z, v[j].w); no[64 * j] = w; }
        }
    }
    {
        const int gt = vcu * 512 + tid, NGT = G * 512;
        float* rope = (float*)(ws + WS_ROPE);
        for (int e = gt; e < 4104 * 32; e += NGT) {
            const int pi = e >> 5, d = e & 31; const int pos = pi < SEQ ? pi : 8192 + (pi - SEQ);
            double inv = 1.0; for (int k = 0; k < d; ++k) inv *= 0.7498942093324559;
            const float ang = (float)pos * (float)inv;
            const double rev = (double)ang * 0.15915494309189535; const double fr = rev - __builtin_rint(rev);
            rope[(size_t)pi * 64 + d] = __builtin_amdgcn_cosf((float)fr); rope[(size_t)pi * 64 + 32 + d] = __builtin_amdgcn_sinf((float)fr);
        }
        float* c8 = (float*)(ws + WS_C8);
        for (int e = gt; e < 1024; e += NGT) { const float lam = p.in[23][e]; c8[e] = -8.0f * log1pf(__expf(-lam)) * LOG2E; ((float*)(ws + WS_ZB))[e] = 0.f; }
    }
}

__device__ __forceinline__ void norm_phase(float* X, const float* PART, int nsplit, const float* bias, const float* g, bf16_t* XN, bool final_, int vcu, int G, const int tid) {
    const int lane = tid & 63, wave = tid >> 6;
    const int gw = vcu * 8 + wave, NGW = G * 8;
    f32x4 gv[4];
#pragma unroll
    for (int j = 0; j < 4; ++j) gv[j] = *((const f32x4*)g + lane + 64 * j);
    for (int m = gw; m < M; m += NGW) {
        f32x4* xr = (f32x4*)(X + (size_t)m * DM) + lane;
        f32x4 v[4]; float s = 0.f;
        if (m >= MP) {
#pragma unroll
            for (int j = 0; j < 4; ++j) v[j] = xr[64 * j];
        } else {
            const u32x2* br = (const u32x2*)(XN + (size_t)m * DM) + lane;
#pragma unroll
            for (int j = 0; j < 4; ++j) { const u32x2 w = br[64 * j]; v[j] = (f32x4){bflo(w.x), bfhi(w.x), bflo(w.y), bfhi(w.y)}; }
        }
        if (m >= MP) {
#pragma unroll 4
            for (int sl = 0; sl < nsplit; ++sl) { const f32x4* pr = (const f32x4*)(PART + ((size_t)sl * MS + (m - MP)) * DM) + lane;
#pragma unroll
                for (int j = 0; j < 4; ++j) v[j] += pr[64 * j]; }
            if (bias) {
#pragma unroll
                for (int j = 0; j < 4; ++j) v[j] += *((const f32x4*)bias + lane + 64 * j); }
            if (!final_) {
#pragma unroll
                for (int j = 0; j < 4; ++j) xr[64 * j] = v[j]; }
        }
#pragma unroll
        for (int j = 0; j < 4; ++j) s += (v[j].x * v[j].x + v[j].y * v[j].y) + (v[j].z * v[j].z + v[j].w * v[j].w);
        const float rstd = 1.0f / sqrtf(wave_sum(s) * (1.f / DM) + EPS);
        if (final_) {
#pragma unroll
            for (int j = 0; j < 4; ++j) xr[64 * j] = v[j] * rstd * gv[j];
        } else {
            u32x2* no = (u32x2*)(XN + (size_t)m * DM) + lane;
#pragma unroll
            for (int j = 0; j < 4; ++j) { const f32x4 y = v[j] * rstd * gv[j]; u32x2 w; w.x = cvt_pk_bf16(y.x, y.y); w.y = cvt_pk_bf16(y.z, y.w); no[64 * j] = w; }
        }
    }
}

__device__ __forceinline__ void fin_phase(const float* Xin, float* X, const float* PART, int nsplit, const float* bias, bf16_t* XB, const float* SS, float* rstd, int vcu, int G, const int tid) {
    const int lane = tid & 63, wave = tid >> 6;
    const int gw = vcu * 8 + wave, NGW = G * 8;
    for (int r = gw; r < MS; r += NGW) {
        const int m = MP + r;
        f32x4* xr = (f32x4*)(X + (size_t)m * DM) + lane;
        const f32x4* xi = (const f32x4*)(Xin + (size_t)r * DM) + lane;
        f32x4 v[4]; float s = 0.f;
#pragma unroll
        for (int j = 0; j < 4; ++j) v[j] = xi[64 * j];
#pragma unroll 4
        for (int sl = 0; sl < nsplit; ++sl) { const f32x4* pr = (const f32x4*)(PART + ((size_t)sl * MS + r) * DM) + lane;
#pragma unroll
            for (int j = 0; j < 4; ++j) v[j] += pr[64 * j]; }
        if (bias) {
#pragma unroll
            for (int j = 0; j < 4; ++j) v[j] += *((const f32x4*)bias + lane + 64 * j); }
        u32x2* no = (u32x2*)(XB + (size_t)m * DM) + lane;
#pragma unroll
        for (int j = 0; j < 4; ++j) { xr[64 * j] = v[j]; u32x2 w; w.x = cvt_pk_bf16(v[j].x, v[j].y); w.y = cvt_pk_bf16(v[j].z, v[j].w); no[64 * j] = w;
            s += (v[j].x * v[j].x + v[j].y * v[j].y) + (v[j].z * v[j].z + v[j].w * v[j].w); }
        s = wave_sum(s);
        if (lane == 0) rstd[m] = 1.0f / sqrtf(s * (1.f / DM) + EPS);
    }
    const int gt = vcu * 512 + tid, NGT = G * 512;
    for (int m = NGT - 1 - gt; m < MP; m += NGT) {
        const f32x4* sp = (const f32x4*)(SS + (size_t)m * 16);
        const f32x4 a = sp[0], b = sp[1], c = sp[2], d = sp[3];
        const float s = ((a.x + a.y) + (a.z + a.w)) + ((b.x + b.y) + (b.z + b.w)) + ((c.x + c.y) + (c.z + c.w)) + ((d.x + d.y) + (d.z + d.w));
        rstd[m] = 1.0f / sqrtf(s * (1.f / DM) + EPS);
    }
}

constexpr int KS_PITCH = 72, VT_PITCH = 260;
constexpr int ATT_KS = 0, ATT_VT = 256 * KS_PITCH * 2;
__device__ __forceinline__ void attn_phase(const Params& p, LAS unsigned char* lds, int j, int vcu, int G, const int tid) {
    const int lane = tid & 63, wave = __builtin_amdgcn_readfirstlane(tid >> 6), l31 = lane & 31, hi = lane >> 5;
    const bf16_t* QKV = (const bf16_t*)(p.ws + WS_S0);
    bf16_t* O = (bf16_t*)(p.ws + WS_S2);
    LAS bf16_t* Ks = (LAS bf16_t*)(lds + ATT_KS);
    LAS bf16_t* Vt = (LAS bf16_t*)(lds + ATT_VT);
    const float* ck = p.in[2] + (size_t)j * 128 * 128 * 128;
    const float* cv = p.in[3] + (size_t)j * 128 * 128 * 128;
    {
        const int gt = vcu * 512 + tid, NGT = G * 512;
        float* kp = p.out + O_KP + (size_t)j * 65536; float* vp = p.out + O_VP + (size_t)j * 65536;
        for (int e = gt; e < 65536; e += NGT) { const int d = e & 127, t = (e >> 7) & 127, b = e >> 14; const size_t src = (size_t)(b * SEQ + SEQ - 128 + t) * NQKV + 1024 + d;
            kp[e] = bf2f(QKV[src]); vp[e] = bf2f(QKV[src + 128]); }
        float* ksn = p.out + O_KS + (size_t)j * 2097152; float* vsn = p.out + O_VS + (size_t)j * 2097152;
        f32x4 kv4[4], vv4[4];
#pragma unroll
        for (int it = 0; it < 4; ++it) {
            const int e4 = gt + it * NGT;
            if (e4 < 524288) { const int e = e4 * 4, d = e & 127, c = (e >> 7) & 127, b = e >> 14;
                if (c < 120) { kv4[it] = *(const f32x4*)(ck + e + 8 * 128); vv4[it] = *(const f32x4*)(cv + e + 8 * 128); }
                else { const size_t src = (size_t)(MP + b * 8 + c - 120) * NQKV + 1024 + d; const u32x2 kw = *(const u32x2*)(QKV + src), vw = *(const u32x2*)(QKV + src + 128);
                    kv4[it] = (f32x4){bflo(kw.x), bfhi(kw.x), bflo(kw.y), bfhi(kw.y)}; vv4[it] = (f32x4){bflo(vw.x), bfhi(vw.x), bflo(vw.y), bfhi(vw.y)}; } }
        }
#pragma unroll
        for (int it = 0; it < 4; ++it) { const int e4 = gt + it * NGT; if (e4 < 524288) { *(f32x4*)(ksn + (size_t)e4 * 4) = kv4[it]; *(f32x4*)(vsn + (size_t)e4 * 4) = vv4[it]; } }
        for (int e4 = gt + 4 * NGT; e4 < 524288; e4 += NGT) {
            const int e = e4 * 4, d = e & 127, c = (e >> 7) & 127, b = e >> 14;
            if (c < 120) { *(f32x4*)(ksn + e) = *(const f32x4*)(ck + e + 8 * 128); *(f32x4*)(vsn + e) = *(const f32x4*)(cv + e + 8 * 128); }
            else { const size_t src = (size_t)(MP + b * 8 + c - 120) * NQKV + 1024 + d; const u32x2 kw = *(const u32x2*)(QKV + src), vw = *(const u32x2*)(QKV + src + 128);
                *(f32x4*)(ksn + e) = (f32x4){bflo(kw.x), bfhi(kw.x), bflo(kw.y), bfhi(kw.y)}; *(f32x4*)(vsn + e) = (f32x4){bflo(vw.x), bfhi(vw.x), bflo(vw.y), bfhi(vw.y)}; }
        }
    }
    for (int un = vcu; un < 512; un += G) {
        const bool prompt = un < 256;
        int b, kvh, nb = 0;
        if (prompt) { b = un >> 6; kvh = (un >> 5) & 1; nb = un & 31; } else { const int s = un - 256; b = s >> 1; kvh = s & 1; }
        const int nkeys = prompt ? 256 : 160;
        for (int id = tid; id < nkeys * 8; id += 512) {
            const int key = id >> 3, ch = id & 7;
            u32x4 w = (u32x4){0u, 0u, 0u, 0u};
            if (prompt) { if (!(nb == 0 && key < 128)) w = *(const u32x4*)(QKV + (size_t)(b * SEQ + 128 * (nb - 1) + key) * NQKV + 1024 + kvh * 64 + 8 * ch); }
            else if (key < 128) { const float* s = ck + ((size_t)(b * 128 + key) * 2 + kvh) * 64 + 8 * ch; const f32x4 a = *(const f32x4*)s, c = *(const f32x4*)(s + 4);
                w.x = cvt_pk_bf16(a.x, a.y); w.y = cvt_pk_bf16(a.z, a.w); w.z = cvt_pk_bf16(c.x, c.y); w.w = cvt_pk_bf16(c.z, c.w); }
            else if (key < 136) w = *(const u32x4*)(QKV + (size_t)(MP + b * 8 + key - 128) * NQKV + 1024 + kvh * 64 + 8 * ch);
            *(LAS u32x4*)(Ks + key * KS_PITCH + 8 * ch) = w;
        }
        for (int id = tid; id < nkeys * 8; id += 512) {
            const int key = id % nkeys, ch = id / nkeys;
            u32x4 w = (u32x4){0u, 0u, 0u, 0u};
            if (prompt) { if (!(nb == 0 && key < 128)) w = *(const u32x4*)(QKV + (size_t)(b * SEQ + 128 * (nb - 1) + key) * NQKV + 1152 + kvh * 64 + 8 * ch); }
            else if (key < 128) { const float* s = cv + ((size_t)(b * 128 + key) * 2 + kvh) * 64 + 8 * ch; const f32x4 a = *(const f32x4*)s, c = *(const f32x4*)(s + 4);
                w.x = cvt_pk_bf16(a.x, a.y); w.y = cvt_pk_bf16(a.z, a.w); w.z = cvt_pk_bf16(c.x, c.y); w.w = cvt_pk_bf16(c.z, c.w); }
            else if (key < 136) w = *(const u32x4*)(QKV + (size_t)(MP + b * 8 + key - 128) * NQKV + 1152 + kvh * 64 + 8 * ch);
            LAS bf16_t* vd = Vt + (8 * ch) * VT_PITCH + key;
            vd[0 * VT_PITCH] = (bf16_t)(w.x & 0xffff); vd[1 * VT_PITCH] = (bf16_t)(w.x >> 16); vd[2 * VT_PITCH] = (bf16_t)(w.y & 0xffff); vd[3 * VT_PITCH] = (bf16_t)(w.y >> 16);
            vd[4 * VT_PITCH] = (bf16_t)(w.z & 0xffff); vd[5 * VT_PITCH] = (bf16_t)(w.z >> 16); vd[6 * VT_PITCH] = (bf16_t)(w.w & 0xffff); vd[7 * VT_PITCH] = (bf16_t)(w.w >> 16);
        }
        __syncthreads();
        const int h = kvh * 8 + wave;
        const float sink8 = p.in[14][j * 16 + h] * 8.0f;
        const int nqs = prompt ? 4 : 1;
        for (int qs = 0; qs < nqs; ++qs) {
            const int qi = 32 * qs + l31;
            const bool qvalid = prompt || l31 < 8;
            const size_t qrow = prompt ? (size_t)(b * SEQ + 128 * nb + qi) : (size_t)(MP + b * 8 + (l31 < 8 ? l31 : 7));
            bf16x8 qf[4];
#pragma unroll
            for (int d0 = 0; d0 < 4; ++d0) qf[d0] = *(const bf16x8*)(QKV + qrow * NQKV + h * 64 + 16 * d0 + 8 * hi);
            constexpr float CS = 0.125f * LOG2E;
            float mrun = sink8, lrun = hi == 0 ? 1.f : 0.f;
            f32x16 o0 = {}, o1 = {};
            const int kt_lo = (prompt && nb == 0 && qs < 4) ? 4 : qs;
            for (int kt = kt_lo; kt < qs + 5; ++kt) {
                f32x16 s = {};
#pragma unroll
                for (int d0 = 0; d0 < 4; ++d0) { const bf16x8 kf = *(const LAS bf16x8*)(Ks + (32 * kt + l31) * KS_PITCH + 16 * d0 + 8 * hi); s = __builtin_amdgcn_mfma_f32_32x32x16_bf16(kf, qf[d0], s, 0, 0, 0); }
                if (kt == qs || kt == qs + 4) {
#pragma unroll
                    for (int r = 0; r < 16; ++r) { const int c = 32 * kt + (r & 3) + 8 * (r >> 2) + 4 * hi; const bool ok = (c > qi) && (c <= qi + 128); s[r] = ok ? s[r] : -1e30f; }
                }
                float mx = fmaxf(fmaxf(s[0], s[1]), fmaxf(s[2], s[3]));
#pragma unroll
                for (int r = 4; r < 16; r += 4) mx = fmaxf(mx, fmaxf(fmaxf(s[r], s[r + 1]), fmaxf(s[r + 2], s[r + 3])));
                mx = fmaxf(mx, __shfl_xor(mx, 32));
                if (__any(mx > mrun)) {
                    const float mnew = fmaxf(mrun, mx), alpha = __builtin_amdgcn_exp2f((mrun - mnew) * CS);
                    lrun *= alpha; mrun = mnew;
#pragma unroll
                    for (int r = 0; r < 16; ++r) { o0[r] *= alpha; o1[r] *= alpha; }
                }
                const float mc = -mrun * CS;
                float ps = 0.f;
#pragma unroll
                for (int r = 0; r < 16; ++r) { s[r] = __builtin_amdgcn_exp2f(__builtin_fmaf(s[r], CS, mc)); ps += s[r]; }
                lrun += ps;
#pragma unroll
                for (int ss = 0; ss < 2; ++ss) {
                    u32x4 pw; pw.x = cvt_pk_bf16(s[8 * ss + 0], s[8 * ss + 1]); pw.y = cvt_pk_bf16(s[8 * ss + 2], s[8 * ss + 3]); pw.z = cvt_pk_bf16(s[8 * ss + 4], s[8 * ss + 5]); pw.w = cvt_pk_bf16(s[8 * ss + 6], s[8 * ss + 7]);
                    const bf16x8 pb = __builtin_bit_cast(bf16x8, pw);
                    const LAS bf16_t* vb = Vt + l31 * VT_PITCH + 32 * kt + 16 * ss + 4 * hi;
                    const s16x4 a0 = *(const LAS s16x4*)(vb), a1 = *(const LAS s16x4*)(vb + 8);
                    const s16x4 c0 = *(const LAS s16x4*)(vb + 32 * VT_PITCH), c1 = *(const LAS s16x4*)(vb + 32 * VT_PITCH + 8);
                    const bf16x8 v0 = (bf16x8){a0[0], a0[1], a0[2], a0[3], a1[0], a1[1], a1[2], a1[3]};
                    const bf16x8 v1 = (bf16x8){c0[0], c0[1], c0[2], c0[3], c1[0], c1[1], c1[2], c1[3]};
                    o0 = __builtin_amdgcn_mfma_f32_32x32x16_bf16(v0, pb, o0, 0, 0, 0);
                    o1 = __builtin_amdgcn_mfma_f32_32x32x16_bf16(v1, pb, o1, 0, 0, 0);
                }
            }
            const float ltot = lrun + __shfl_xor(lrun, 32);
            const float inv = 1.0f / ltot;
            if (qvalid) {
                const size_t orow = prompt ? (size_t)(b * SEQ + 128 * nb + qi) : (size_t)(MP + b * 8 + l31);
                bf16_t* op = O + orow * DM + h * 64 + 4 * hi;
#pragma unroll
                for (int r4 = 0; r4 < 4; ++r4) {
                    u32x2 w; w.x = cvt_pk_bf16(o0[4 * r4] * inv, o0[4 * r4 + 1] * inv); w.y = cvt_pk_bf16(o0[4 * r4 + 2] * inv, o0[4 * r4 + 3] * inv); *(u32x2*)(op + 8 * r4) = w;
                    w.x = cvt_pk_bf16(o1[4 * r4] * inv, o1[4 * r4 + 1] * inv); w.y = cvt_pk_bf16(o1[4 * r4 + 2] * inv, o1[4 * r4 + 3] * inv); *(u32x2*)(op + 32 + 8 * r4) = w;
                }
            }
        }
        __syncthreads();
    }
}

__device__ __forceinline__ void rgconv_phase(const Params& p, int vcu, int G, const int tid) {
    const int gt = vcu * 512 + tid, NGT = G * 512;
    const bf16_t* __restrict__ V = (const bf16_t*)(p.ws + WS_S1); bf16_t* __restrict__ U = (bf16_t*)(p.ws + WS_S3);
    const float* __restrict__ cw = p.in[17]; const float* __restrict__ cb = p.in[18]; const float* __restrict__ buf = p.in[5];
#pragma unroll 2
    for (int e = gt; e < M * 128; e += NGT) {
        const int row = e >> 7, ch = (e & 127) * 8;
        int t, T; const float* sb = nullptr;
        if (row < MP) { t = row & (SEQ - 1); T = SEQ; } else { t = (row - MP) & 7; T = 8; sb = buf + (size_t)((row - MP) >> 3) * 3 * DM; }
        float accv[8];
        { const f32x4 b0 = *(const f32x4*)(cb + ch), b1 = *(const f32x4*)(cb + ch + 4);
#pragma unroll
          for (int k = 0; k < 4; ++k) { accv[k] = b0[k]; accv[4 + k] = b1[k]; } }
#pragma unroll
        for (int jj = 0; jj < 4; ++jj) {
            const int tt = t - 3 + jj;
            float xv[8];
            if (tt >= 0) { const u32x4 w = *(const u32x4*)(V + (size_t)(row - 3 + jj) * DM + ch);
                xv[0] = bflo(w.x); xv[1] = bfhi(w.x); xv[2] = bflo(w.y); xv[3] = bfhi(w.y); xv[4] = bflo(w.z); xv[5] = bfhi(w.z); xv[6] = bflo(w.w); xv[7] = bfhi(w.w); }
            else if (sb) { const f32x4 a = *(const f32x4*)(sb + (size_t)(tt + 3) * DM + ch), c = *(const f32x4*)(sb + (size_t)(tt + 3) * DM + ch + 4);
#pragma unroll
                for (int k = 0; k < 4; ++k) { xv[k] = a[k]; xv[4 + k] = c[k]; } }
            else {
#pragma unroll
                for (int k = 0; k < 8; ++k) xv[k] = 0.f; }
            const f32x4 w0 = *(const f32x4*)(cw + jj * DM + ch), w1 = *(const f32x4*)(cw + jj * DM + ch + 4);
#pragma unroll
            for (int k = 0; k < 4; ++k) { accv[k] += xv[k] * w0[k]; accv[4 + k] += xv[4 + k] * w1[k]; }
        }
        u32x4 w; w.x = cvt_pk_bf16(accv[0], accv[1]); w.y = cvt_pk_bf16(accv[2], accv[3]); w.z = cvt_pk_bf16(accv[4], accv[5]); w.w = cvt_pk_bf16(accv[6], accv[7]);
        *(u32x4*)(U + (size_t)row * DM + ch) = w;
        if (t >= T - 3) {
            const u32x4 vw = *(const u32x4*)(V + (size_t)row * DM + ch);
            float* dst = row < MP ? p.out + O_RCP + ((size_t)(row >> 12) * 3 + (t - (T - 3))) * DM + ch : p.out + O_RCS + ((size_t)((row - MP) >> 3) * 3 + (t - (T - 3))) * DM + ch;
            *(f32x4*)dst = (f32x4){bflo(vw.x), bfhi(vw.x), bflo(vw.y), bfhi(vw.y)}; *(f32x4*)(dst + 4) = (f32x4){bflo(vw.z), bfhi(vw.z), bflo(vw.w), bfhi(vw.w)};
        }
    }
}
__device__ __forceinline__ void rgscan_phase(const Params& p, LAS unsigned char* lds, int vcu, int G, const int tid) {
    const int lane = tid & 63, wave = tid >> 6;
    bf16_t* GATE = (bf16_t*)(p.ws + WS_S0); const bf16_t* LA = (const bf16_t*)(p.ws + WS_S1); const bf16_t* Bv = (const bf16_t*)(p.ws + WS_S2);
    LAS float* sm = (LAS float*)lds;
    for (int un = vcu; un < 256; un += G) {
        const int b = un >> 6, ch = (un & 63) * 16 + (lane & 15), chunk = wave * 4 + (lane >> 4);
        const size_t base = (size_t)(b * SEQ + chunk * 128) * DM + ch;
        float Ap = 0.f, Bp = 0.f;
        for (int t0 = 0; t0 < 128; t0 += 32) {
            unsigned short lv[32], bv_[32];
#pragma unroll
            for (int t = 0; t < 32; ++t) { lv[t] = LA[base + (size_t)(t0 + t) * DM]; bv_[t] = Bv[base + (size_t)(t0 + t) * DM]; }
#pragma unroll
            for (int t = 0; t < 32; ++t) { const float l2 = bf2f(lv[t]); Ap += l2; Bp = __builtin_amdgcn_exp2f(l2) * Bp + bf2f(bv_[t]); }
        }
        sm[(chunk * 16 + (lane & 15)) * 2] = __builtin_amdgcn_exp2f(Ap); sm[(chunk * 16 + (lane & 15)) * 2 + 1] = Bp;
        __syncthreads();
        float hcur = 0.f;
        for (int c = 0; c < chunk; ++c) hcur = sm[(c * 16 + (lane & 15)) * 2] * hcur + sm[(c * 16 + (lane & 15)) * 2 + 1];
        for (int t0 = 0; t0 < 128; t0 += 32) {
            unsigned short lv[32], bv_[32], gv_[32];
#pragma unroll
            for (int t = 0; t < 32; ++t) { lv[t] = LA[base + (size_t)(t0 + t) * DM]; bv_[t] = Bv[base + (size_t)(t0 + t) * DM]; gv_[t] = GATE[base + (size_t)(t0 + t) * DM]; }
#pragma unroll
            for (int t = 0; t < 32; ++t) { hcur = __builtin_amdgcn_exp2f(bf2f(lv[t])) * hcur + bf2f(bv_[t]); GATE[base + (size_t)(t0 + t) * DM] = (bf16_t)f2bf(hcur * bf2f(gv_[t])); }
        }
        if (chunk == 31) p.out[O_HP + (size_t)b * DM + ch] = hcur;
        __syncthreads();
    }
    const int gt = vcu * 512 + tid, NGT = G * 512;
    for (int e = gt; e < 128 * DM; e += NGT) {
        const int sq = e >> 10, ch = e & 1023; float hcur = p.in[4][e];
        const size_t base = (size_t)(MP + sq * 8) * DM + ch;
#pragma unroll
        for (int t = 0; t < 8; ++t) { const float l2 = bf2f(LA[base + (size_t)t * DM]); const float bb = bf2f(Bv[base + (size_t)t * DM]);
            hcur = __builtin_amdgcn_exp2f(l2) * hcur + bb; const float gt_ = bf2f(GATE[base + (size_t)t * DM]); GATE[base + (size_t)t * DM] = (bf16_t)f2bf(hcur * gt_); }
        p.out[O_HS + e] = hcur;
    }
}
__device__ __forceinline__ void scconv_phase(const Params& p, int vcu, int G, const int tid) {
    const int gt = vcu * 512 + tid, NGT = G * 512;
    const bf16_t* __restrict__ CX = (const bf16_t*)(p.ws + WS_S0); const bf16_t* __restrict__ BG = (const bf16_t*)(p.ws + WS_S1); bf16_t* __restrict__ YG = (bf16_t*)(p.ws + WS_S2);
    const float* __restrict__ cw = p.in[26]; const float* __restrict__ buf = p.in[6];
#pragma unroll 2
    for (int e = gt; e < M * 128; e += NGT) {
        const int row = e >> 7, ch = (e & 127) * 8;
        int t, T; const float* sb = nullptr;
        if (row < MP) { t = row & (SEQ - 1); T = SEQ; } else { t = (row - MP) & 7; T = 8; sb = buf + (size_t)((row - MP) >> 3) * 2 * DM; }
        float accv[8];
#pragma unroll
        for (int k = 0; k < 8; ++k) accv[k] = 0.f;
        u32x4 cur = (u32x4){0u, 0u, 0u, 0u};
#pragma unroll
        for (int jj = 0; jj < 3; ++jj) {
            const int tt = t - 2 + jj;
            float xv[8];
            if (tt >= 0) { const u32x4 w = *(const u32x4*)(CX + (size_t)(row - 2 + jj) * DM + ch); if (jj == 2) cur = w;
                xv[0] = bflo(w.x); xv[1] = bfhi(w.x); xv[2] = bflo(w.y); xv[3] = bfhi(w.y); xv[4] = bflo(w.z); xv[5] = bfhi(w.z); xv[6] = bflo(w.w); xv[7] = bfhi(w.w); }
            else if (sb) { const f32x4 a = *(const f32x4*)(sb + (size_t)(tt + 2) * DM + ch), c = *(const f32x4*)(sb + (size_t)(tt + 2) * DM + ch + 4);
#pragma unroll
                for (int k = 0; k < 4; ++k) { xv[k] = a[k]; xv[4 + k] = c[k]; } }
            else {
#pragma unroll
                for (int k = 0; k < 8; ++k) xv[k] = 0.f; }
            const f32x4 w0 = *(const f32x4*)(cw + jj * DM + ch), w1 = *(const f32x4*)(cw + jj * DM + ch + 4);
#pragma unroll
            for (int k = 0; k < 4; ++k) { accv[k] += xv[k] * w0[k]; accv[4 + k] += xv[4 + k] * w1[k]; }
        }
        const u32x4 g = *(const u32x4*)(BG + (size_t)row * DM + ch);
        u32x4 w; w.x = cvt_pk_bf16(accv[0] * bflo(g.x), accv[1] * bfhi(g.x)); w.y = cvt_pk_bf16(accv[2] * bflo(g.y), accv[3] * bfhi(g.y));
        w.z = cvt_pk_bf16(accv[4] * bflo(g.z), accv[5] * bfhi(g.z)); w.w = cvt_pk_bf16(accv[6] * bflo(g.w), accv[7] * bfhi(g.w));
        *(u32x4*)(YG + (size_t)row * DM + ch) = w;
        if (t >= T - 2) {
            float* dst = row < MP ? p.out + O_SCP + ((size_t)(row >> 12) * 2 + (t - (T - 2))) * DM + ch : p.out + O_SCS + ((size_t)((row - MP) >> 3) * 2 + (t - (T - 2))) * DM + ch;
            *(f32x4*)dst = (f32x4){bflo(cur.x), bfhi(cur.x), bflo(cur.y), bfhi(cur.y)}; *(f32x4*)(dst + 4) = (f32x4){bflo(cur.z), bfhi(cur.z), bflo(cur.w), bfhi(cur.w)};
        }
    }
}

#define XB_TMO      128
#define XB_XCNT(j)  (256  + 64 * (j))
#define XB_XSUB(j)  (1280 + 64 * (j))
#define XB_XGEN(j)  (2304 + 64 * (j))
#define XB_TOP      3328
#define XB_TOPGEN   3392
#define XCD_BAR_WORDS 3456
#define XB_SPIN_CAP (1u << 18)
__device__ __forceinline__ unsigned xb_ld(unsigned* p)              { return __hip_atomic_load(p, __ATOMIC_RELAXED, __HIP_MEMORY_SCOPE_AGENT); }
__device__ __forceinline__ unsigned xb_add(unsigned* p, unsigned v) { return __hip_atomic_fetch_add(p, v, __ATOMIC_RELAXED, __HIP_MEMORY_SCOPE_AGENT); }
__device__ __forceinline__ unsigned xb_xcc_id() { return (unsigned)__builtin_amdgcn_s_getreg((3 << 11) | 20) & 0xFu; }
#define XB_SPIN(cond, bar) do { unsigned _sp = 0; while (cond) { __builtin_amdgcn_s_sleep(1); \
    if ((++_sp & 255u) == 0u) { if (xb_ld(&(bar)[XB_TMO])) break; if (_sp > XB_SPIN_CAP) { atomicAdd(&(bar)[XB_TMO], 1u); break; } } } } while (0)
struct XcdBarrier { unsigned* bar; unsigned x; volatile LAS unsigned* st; };
__device__ __forceinline__ XcdBarrier xcd_barrier_post(unsigned* bar, volatile LAS unsigned* st) {
    XcdBarrier b; b.bar = bar; b.x = xb_xcc_id(); b.st = st;
    if (threadIdx.x == 0) (void)xb_add(&bar[XB_XCNT(b.x)], 1u);
    return b;
}
__device__ __forceinline__ void xcd_barrier_complete(unsigned* bar, unsigned x, unsigned& nloc, unsigned& nx) {
    const unsigned G = gridDim.x * gridDim.y * gridDim.z;
    unsigned sum, cnt, mine, sp = 0u;
    for (;;) {
        sum = 0u; cnt = 0u; mine = 0u;
#pragma unroll
        for (unsigned j = 0; j < 16; ++j) { const unsigned c = xb_ld(&bar[XB_XCNT(j)]); sum += c; cnt += (c > 0u) ? 1u : 0u; mine = (j == x) ? c : mine; }
        if (sum == G) break;
        __builtin_amdgcn_s_sleep(1);
        if ((++sp & 255u) == 0u) { if (xb_ld(&bar[XB_TMO])) break; if (sp > XB_SPIN_CAP) { atomicAdd(&bar[XB_TMO], 1u); break; } }
    }
    nloc = mine > 0u ? mine : 1u; nx = cnt > 0u ? cnt : 1u;
}
__device__ __forceinline__ void xcd_barrier(const XcdBarrier& b) {
    asm volatile("s_waitcnt vmcnt(0)" ::: "memory");
    __syncthreads();
    if (threadIdx.x == 0) {
        unsigned* bar = b.bar;
        __builtin_amdgcn_s_waitcnt(0);
        unsigned nloc = b.st[0], nx = b.st[1];
        if (nloc == 0u) { xcd_barrier_complete(bar, b.x, nloc, nx); b.st[0] = nloc; b.st[1] = nx; }
        const unsigned old = xb_add(&bar[XB_XSUB(b.x)], 1u);
        const unsigned gen = old / nloc;
        if (old + 1u == (gen + 1u) * nloc) {
            __builtin_amdgcn_fence(__ATOMIC_RELEASE, "agent");
            asm volatile("s_waitcnt vmcnt(0)" ::: "memory");
            const unsigned og = xb_add(&bar[XB_TOP], 1u);
            const unsigned tg = og / nx;
            if (og + 1u == (tg + 1u) * nx) xb_add(&bar[XB_TOPGEN], 1u);
            else XB_SPIN(xb_ld(&bar[XB_TOPGEN]) == tg, bar);
            __builtin_amdgcn_fence(__ATOMIC_ACQUIRE, "agent");
            xb_add(&bar[XB_XGEN(b.x)], 1u);
            asm volatile("s_waitcnt vmcnt(0)" ::: "memory");
        } else {
            XB_SPIN(xb_ld(&bar[XB_XGEN(b.x)]) == gen, bar);
            __builtin_amdgcn_fence(__ATOMIC_ACQUIRE, "agent");
            asm volatile("s_waitcnt vmcnt(0)" ::: "memory");
        }
    }
    __syncthreads();
}

enum Op { OP_PREP, OP_QKV, OP_ATTN, OP_RG1, OP_RGCONV, OP_RGGATES, OP_RGSCAN, OP_SC1, OP_SCCONV, OP_RESID_MIX, OP_NORM_F, OP_FFNUP, OP_RESID_FFN, OP_NORM_M };
constexpr int NSTEPS = 31;

__global__ void __launch_bounds__(512, 2) mega_fwd(Params p) {
    extern __shared__ __attribute__((aligned(16))) unsigned char lds_raw[];
    LAS unsigned char* lds = (LAS unsigned char*)lds_raw;
    const int G0 = gridDim.x, bx = blockIdx.x;
    volatile LAS unsigned* MISC = (volatile LAS unsigned*)(lds + 131072);
    if (threadIdx.x < 32) MISC[threadIdx.x] = 0u;
    __syncthreads();
    XcdBarrier bar = xcd_barrier_post((unsigned*)p.ws, MISC + 8);
    const int vcu0 = (G0 % 8 == 0) ? (bx % 8) * (G0 / 8) + bx / 8 : bx;
#if REP_MASK
    for (int it_ = 2 * p.ph_lo; it_ < 2 * p.ph_hi; ++it_) { const int step = it_ >> 1;
#else
    for (int step = p.ph_lo; step < p.ph_hi; ++step) {
#endif
        int tid = threadIdx.x, G = G0, vcu = vcu0; unsigned char* ws = p.ws; float* X = p.out;
        asm volatile("" : "+v"(tid)); asm volatile("" : "+s"(G)); asm volatile("" : "+s"(vcu)); asm volatile("" : "+s"(ws)); asm volatile("" : "+s"(X));
        bf16_t* XN = (bf16_t*)(ws + WS_XN);
        float* PART = (float*)(ws + WS_S3);
        int op, layer = 0;
        if (step == 0) op = OP_PREP;
        else {
            int s = step - 1, li;
            if (s < 7) { layer = 0; li = s; } else if (s < 16) { layer = 1; li = s - 7; } else if (s < 23) { layer = 2; li = s - 16; } else { layer = 3; li = s - 23; }
            const int kind = layer % 3, nmix = kind == 1 ? 4 : 2;
            if (li < nmix) op = kind == 0 ? (li == 0 ? OP_QKV : OP_ATTN) : kind == 1 ? (OP_RG1 + li) : (li == 0 ? OP_SC1 : OP_SCCONV);
            else op = OP_RESID_MIX + (li - nmix);
        }
        const int kind = layer % 3, j = layer / 3;
#if REP_MASK
        if ((it_ & 1) && !((REP_MASK >> op) & 1)) continue;
#endif
        pg8::GSched S; S.G = G; S.c = vcu; S.c2 = (int)blockIdx.x; S.mode = 0; S.nsplit = NSPLIT_MIX; S.lda = DM; S.ldb = DM; S.nt = 16; S.A = (const char*)XN;
        switch (op) {
        case OP_PREP: prep_phase(p, lds, vcu, G, tid); break;
        case OP_QKV: { S.Bt = (const char*)(ws + WS_WQKV + (size_t)j * NQKV * 1024 * 2); S.nN = 5;
            pg8::EpiQKV E{(bf16_t*)(ws + WS_S0), p.in[11] + j * NQKV, (const float*)(ws + WS_ROPE), (const float*)(ws + WS_RSTD)};
            pg8::gemm_phase<DM, DM>(lds, S, E, tid);
            if (layer == 0) convert_in_slack(p, ws, lds, 1, 68 * 5, vcu, G, tid); } break;
        case OP_ATTN: attn_phase(p, lds, j, vcu, G, tid); break;
        case OP_RG1: { S.Bt = (const char*)(ws + WS_WRG1); S.nN = 8;
            pg8::EpiPair<1> E{(bf16_t*)(ws + WS_S0), (bf16_t*)(ws + WS_S1), (const float*)(ws + WS_RSTD)};
            pg8::gemm_phase<DM, DM>(lds, S, E, tid);
            convert_in_slack(p, ws, lds, 2, 68 * 8, vcu, G, tid); } break;
        case OP_RGCONV: rgconv_phase(p, vcu, G, tid); break;
        case OP_RGGATES: { S.A = (const char*)(ws + WS_S3); S.Bt = (const char*)(ws + WS_WRG2); S.ldb = 256; S.nN = 8; S.nt = 4; S.mode = 2;
            pg8::EpiRgGates E{(const bf16_t*)(ws + WS_S3), (bf16_t*)(ws + WS_S1), (bf16_t*)(ws + WS_S2), p.in[20], p.in[22], (const float*)(ws + WS_C8)};
            pg8::gemm_phase<DM, 256>(lds, S, E, tid);
            convert_in_slack(p, ws, lds, 3, 68 * 8, vcu, G, tid); } break;
        case OP_RGSCAN: rgscan_phase(p, lds, vcu, G, tid); break;
        case OP_SC1: { S.Bt = (const char*)(ws + WS_WSC1); S.nN = 12;
            pg8::EpiPair<2> E{(bf16_t*)(ws + WS_S0), (bf16_t*)(ws + WS_S1), (const float*)(ws + WS_RSTD)};
            pg8::gemm_phase<DM, DM>(lds, S, E, tid);
            convert_in_slack(p, ws, lds, 4, 68 * 12, vcu, G, tid); } break;
        case OP_SCCONV: scconv_phase(p, vcu, G, tid); break;
        case OP_RESID_MIX: {
            const float* bias = (const float*)(ws + WS_ZB); S.nN = 4; S.mode = 1;
            if (kind == 0) { S.A = (const char*)(ws + WS_S2); S.Bt = (const char*)(ws + WS_WO + (size_t)j * 1024 * 1024 * 2); bias = p.in[13] + j * DM; }
            else if (kind == 1) { S.A = (const char*)(ws + WS_S0); S.Bt = (const char*)(ws + WS_WRG3); }
            else { S.A = (const char*)(ws + WS_S2); S.Bt = (const char*)(ws + WS_WSC2); }
            if (layer == 0) { pg8::EpiResid<true> E{p.in[0], PART, bias, XN, (float*)(ws + WS_SS)}; pg8::gemm_phase<DM, DM>(lds, S, E, tid); }
            else { pg8::EpiResid<false> E{nullptr, PART, bias, XN, (float*)(ws + WS_SS)}; pg8::gemm_phase<DM, DM>(lds, S, E, tid); }
            } break;
        case OP_RESID_FFN: {
            S.nN = 4; S.mode = 1; S.nsplit = NSPLIT_FFN; S.A = (const char*)(ws + WS_S0); S.lda = DFF; S.ldb = DFF; S.nt = 44; S.Bt = (const char*)(ws + WS_WFD + (size_t)layer * 1024 * DFF * 2);
            pg8::EpiResid<false> E{nullptr, PART, (const float*)(ws + WS_ZB), XN, (float*)(ws + WS_SS)};
            pg8::gemm_phase<DFF, DFF>(lds, S, E, tid); } break;
        case OP_NORM_F: fin_phase(layer == 0 ? p.in[1] : X + (size_t)MP * DM, X, PART, NSPLIT_MIX, kind == 0 ? p.in[13] + j * DM : nullptr, XN, (const float*)(ws + WS_SS), (float*)(ws + WS_RSTD), vcu, G, tid); break;
        case OP_FFNUP: { S.Bt = (const char*)(ws + WS_WFU + (size_t)layer * 5632 * 1024 * 2); S.nN = 22;
            pg8::EpiPair<0> E{(bf16_t*)(ws + WS_S0), nullptr, (const float*)(ws + WS_RSTD)};
            pg8::gemm_phase<DM, DM>(lds, S, E, tid); } break;
        case OP_NORM_M: if (layer == 3) norm_phase(X, PART, NSPLIT_FFN, nullptr, p.in[9], XN, true, vcu, G, tid);
                        else fin_phase(X + (size_t)MP * DM, X, PART, NSPLIT_FFN, nullptr, XN, (const float*)(ws + WS_SS), (float*)(ws + WS_RSTD), vcu, G, tid);
                        break;
        }
#if REP_MASK
        xcd_barrier(bar);
#else
        if (step + 1 < p.ph_hi) xcd_barrier(bar);
#endif
#if EXTRA_SYNC
        xcd_barrier(bar);
#endif
    }
}

#ifndef MK_N_LAUNCHES
#define MK_N_LAUNCHES 1
#endif
extern "C" void kernel_launch(void* const* d_in, const int* in_sizes, int n_in, void* d_out, int out_size, void* d_ws, size_t ws_size, hipStream_t stream) {
    static int grid = 0;
    if (grid == 0) {
        int dev = 0, cus = 0, per_cu = 0;
        hipGetDevice(&dev);
        hipDeviceGetAttribute(&cus, hipDeviceAttributeMultiprocessorCount, dev);
        hipFuncSetAttribute((const void*)mega_fwd, hipFuncAttributeMaxDynamicSharedMemorySize, LDS_BYTES);
        hipOccupancyMaxActiveBlocksPerMultiprocessor(&per_cu, (const void*)mega_fwd, 512, LDS_BYTES);
        if (per_cu < 1) { fprintf(stderr, "kernel_launch: occupancy query reports %d blocks per CU\n", per_cu); per_cu = 1; }
        if (per_cu > 1) per_cu = 1;
        grid = cus * per_cu;
        if (n_in != 31 || ws_size < 268 * MiB) fprintf(stderr, "kernel_launch: unexpected n_in %d / ws_size %zu\n", n_in, ws_size);
    }
    hipMemsetAsync(d_ws, 0, 16384, stream);
    Params p{};
    for (int i = 0; i < 31; ++i) p.in[i] = (const float*)d_in[i];
    p.out = (float*)d_out; p.ws = (unsigned char*)d_ws;
    const int nl = MK_N_LAUNCHES;
    for (int li = 0; li < nl; ++li) {
        p.ph_lo = (int)((long)NSTEPS * li / nl); p.ph_hi = (int)((long)NSTEPS * (li + 1) / nl);
        void* args[] = {&p};
        hipError_t e = hipLaunchCooperativeKernel((const void*)mega_fwd, dim3(grid), dim3(512), args, LDS_BYTES, stream);
        if (e != hipSuccess) fprintf(stderr, "cooperative launch failed: %s (grid %d)\n", hipGetErrorString(e), grid);
    }
}
```

```cpp
#include <hip/hip_runtime.h>
#include <hip/hip_cooperative_groups.h>
#include <cstdint>
#include <cstdio>
namespace cg = cooperative_groups;
#ifndef REP_MASK
#define REP_MASK 0
#endif
constexpr int NSPLIT_MIX = 4, NSPLIT_FFN = 8;
#ifndef EXTRA_SYNC
#define EXTRA_SYNC 0
#endif

#define LAS __attribute__((address_space(3)))
typedef unsigned short bf16_t;
typedef short bf16x8 __attribute__((ext_vector_type(8)));
typedef short s16x4 __attribute__((ext_vector_type(4)));
typedef float f32x4 __attribute__((ext_vector_type(4)));
typedef float f32x2 __attribute__((ext_vector_type(2)));
typedef float f32x16 __attribute__((ext_vector_type(16)));
typedef unsigned u32x4 __attribute__((ext_vector_type(4)));
typedef unsigned u32x2 __attribute__((ext_vector_type(2)));

constexpr int DM = 1024, MP = 16384, MS = 1024, M = MP + MS, SEQ = 4096, DFF = 2816, NQKV = 1280;
constexpr float EPS = 1e-6f, LOG2E = 1.4426950408889634f;
constexpr size_t MiB = 1u << 20;
constexpr size_t WS_ROPE = 1 * MiB;
constexpr size_t WS_RSTD = 4 * MiB;
constexpr size_t WS_SS = 5 * MiB;
constexpr size_t WS_ZB = 3 * MiB + 65536;
constexpr size_t WS_C8 = 3 * MiB;
constexpr size_t WS_WQKV = 8 * MiB;
constexpr size_t WS_WO = 13 * MiB;
constexpr size_t WS_WFU = 17 * MiB;
constexpr size_t WS_WFD = 61 * MiB;
constexpr size_t WS_WRG1 = 83 * MiB, WS_WRG2 = 87 * MiB, WS_WRG3 = 88 * MiB, WS_WSC1 = 90 * MiB, WS_WSC2 = 96 * MiB;
constexpr size_t WS_XN = 98 * MiB;
constexpr size_t SLOT = 34 * MiB;
constexpr size_t WS_S0 = 132 * MiB, WS_S1 = WS_S0 + SLOT, WS_S2 = WS_S1 + SLOT, WS_S3 = WS_S2 + SLOT;
constexpr size_t O_KP = 17825792, O_VP = 17956864, O_KS = 18087936, O_VS = 22282240, O_HP = 26476544, O_HS = 26480640,
                 O_RCP = 26611712, O_RCS = 26624000, O_SCP = 27017216, O_SCS = 27025408;

constexpr int LDS_BYTES = 131072 + 1024;

__device__ __forceinline__ unsigned cvt_pk_bf16(float lo, float hi) { unsigned r; asm volatile("v_cvt_pk_bf16_f32 %0, %1, %2" : "=v"(r) : "v"(lo), "v"(hi)); return r; }
__device__ __forceinline__ float bf2f(unsigned short v) { return __uint_as_float(((unsigned)v) << 16); }
__device__ __forceinline__ float bflo(unsigned w) { return __uint_as_float(w << 16); }
__device__ __forceinline__ float bfhi(unsigned w) { return __uint_as_float(w & 0xffff0000u); }
__device__ __forceinline__ float fast_sigmoid(float x) { return __builtin_amdgcn_rcpf(1.0f + __builtin_amdgcn_exp2f(-x * LOG2E)); }
__device__ __forceinline__ float wave_sum(float v) {
#pragma unroll
    for (int o = 1; o < 64; o <<= 1) v += __shfl_xor(v, o);
    return v;
}

namespace pg8 {
constexpr int BM = 256, BK = 64, HALF = 128, HTB = HALF * BK * 2, STAGE_BYTES = 8 * HTB;
__device__ __forceinline__ int lds_byte(int r, int c) { const int st = (r >> 4) * 2 + (c >> 5), rr = r & 15, cc = c & 31, ob = rr * 64 + cc * 2; return st * 1024 + (ob ^ (((ob >> 9) & 1) << 5)); }
__device__ __forceinline__ void stage_rc(int b, int& R, int& C) { const int st = b / 1024, sb = b % 1024, swz = sb ^ (((sb >> 9) & 1) << 5); R = (st >> 1) * 16 + swz / 64; C = (st & 1) * 32 + (swz % 64) / 2; }
__device__ __forceinline__ int perm32(int rho) { const int n = rho >> 4, i = rho & 15; return 8 * (i >> 2) + 4 * n + (i & 3); }

struct Unit { int pm, pn, nt, aux; const char* a; const char* b; };

struct GSched {
    const char* A; const char* Bt; int lda, ldb, nN, nt, mode, G, c, nsplit, c2;
    __device__ __forceinline__ bool next(int i, Unit& u) const {
        int L = i * G + c; const int nP = 64 * nN; int kt0 = 0; u.nt = nt; u.aux = 0;
        if (mode == 1) {
            const int nS = 4 * nsplit * nN;
            const bool hasS = (nS <= G) && (c2 < nS);
            if (nS <= G) {
                if (hasS && i == 0) L = c2; else L = nS + (i - (hasS ? 1 : 0)) * G + c;
            }
            if (L < nS) {
                const int sl = L % nsplit; u.pn = (L / nsplit) % nN; u.pm = 64 + (L / nsplit) / nN; u.aux = 1 + sl;
                const int q = (nt / (2 * nsplit)) * 2, extra = (nt - nsplit * q) >> 1;
                u.nt = sl < extra ? q + 2 : q; kt0 = sl < extra ? sl * (q + 2) : extra * (q + 2) + (sl - extra) * q;
            } else {
                L -= nS; if (L >= nP) return false;
                const int g = L / (8 * nN), r = L - g * 8 * nN; u.pm = 8 * g + (r & 7); u.pn = r >> 3;
            }
        } else if (L < nP) { const int g = L / (8 * nN), r = L - g * 8 * nN; u.pm = 8 * g + (r & 7); u.pn = r >> 3; }
        else { L -= nP; if (L >= 4 * nN) return false; u.pm = 64 + (L & 3); u.pn = L >> 2; }
        u.a = A + ((size_t)u.pm * 256 * lda + (size_t)kt0 * 64 + (mode == 2 ? 256 * (u.pn >> 1) : 0)) * 2;
        u.b = Bt + ((size_t)u.pn * 256 * ldb + (size_t)kt0 * 64) * 2;
        return true;
    }
};

template <int LDA, int LDB, class Epi>
__device__ __forceinline__ void gemm_phase(LAS unsigned char* lds, const GSched& S, const Epi& E, const int tid) {
    const int wid = __builtin_amdgcn_readfirstlane(tid >> 6), lane = tid & 63, wr = wid >> 2, wc = wid & 3, fr = lane & 15, fq = lane >> 4;
    constexpr int lda = LDA, ldb = LDB;
    unsigned voffA[2], voffB[2];
#pragma unroll
    for (int i = 0; i < 2; ++i) { int R, C; stage_rc(tid * 16 + i * 8192, R, C); const int Rb = Epi::PERM ? ((R & ~31) + perm32(R & 31)) : R;
        voffA[i] = (unsigned)(R * lda + C) * 2u; voffB[i] = (unsigned)(Rb * ldb + C) * 2u; }
    const size_t kstep = (size_t)(BK * 2);
    const size_t hstepA = (size_t)HALF * lda * 2, hstepB = (size_t)HALF * ldb * 2;
    const unsigned ldsw = (unsigned)wid * 1024u;
    const int aoff = lds_byte(wr * 64 + fr, fq * 8), boff = lds_byte(wc * 32 + fr, fq * 8);
#define PG8_SA(b, h) (((b) * 2 + (h)) * HTB)
#define PG8_SB(b, h) ((4 + (b) * 2 + (h)) * HTB)
#define PG8_STAGE(bufoff, gbase, voff) do { _Pragma("unroll") for (int _i = 0; _i < 2; ++_i) \
        __builtin_amdgcn_global_load_lds((const unsigned*)((const char*)(gbase) + (voff)[_i]), (LAS unsigned*)(lds + (bufoff) + ldsw + _i * 8192), 16, 0, 0); } while (0)
#define PG8_LDA(dst, b, h) do { _Pragma("unroll") for (int m = 0; m < 4; ++m) _Pragma("unroll") for (int k = 0; k < 2; ++k) dst[m][k] = *(const LAS bf16x8*)(lds + PG8_SA(b, h) + aoff + m * 2048 + k * 1024); } while (0)
#define PG8_LDB(dst, b, h) do { _Pragma("unroll") for (int n = 0; n < 2; ++n) _Pragma("unroll") for (int k = 0; k < 2; ++k) dst[n][k] = *(const LAS bf16x8*)(lds + PG8_SB(b, h) + boff + n * 2048 + k * 1024); } while (0)
#define PG8_MMA(ai, bj, At, Bt) do { __builtin_amdgcn_s_setprio(1); _Pragma("unroll") for (int m = 0; m < 4; ++m) _Pragma("unroll") for (int n = 0; n < 2; ++n) _Pragma("unroll") for (int k = 0; k < 2; ++k) \
        acc[ai][bj][m][n] = __builtin_amdgcn_mfma_f32_16x16x32_bf16(Bt[n][k], At[m][k], acc[ai][bj][m][n], 0, 0, 0); __builtin_amdgcn_s_setprio(0); } while (0)
#define PG8_WAIT_V(n) asm volatile("s_waitcnt vmcnt(" #n ")" ::: "memory")
#define PG8_WAIT_L(n) asm volatile("s_waitcnt lgkmcnt(" #n ")" ::: "memory")
#define PG8_BAR __builtin_amdgcn_s_barrier()
#define PG8_SCHED __builtin_amdgcn_sched_barrier(0)
    Unit cur, nxt; int ui = 0;
    if (!S.next(0, cur)) return;
    f32x4 acc[2][2][4][2];
#pragma unroll
    for (int a = 0; a < 2; ++a)
#pragma unroll
        for (int b = 0; b < 2; ++b)
#pragma unroll
            for (int m = 0; m < 4; ++m)
#pragma unroll
                for (int n = 0; n < 2; ++n) acc[a][b][m][n] = (f32x4){0.f, 0.f, 0.f, 0.f};
    bf16x8 At[4][2], B0[2][2], B1[2][2];
    const char* cA = cur.a; const char* cB = cur.b;
    PG8_STAGE(PG8_SB(0, 0), cB, voffB); PG8_STAGE(PG8_SB(0, 1), cB + hstepB, voffB); PG8_STAGE(PG8_SA(0, 0), cA, voffA); PG8_STAGE(PG8_SA(0, 1), cA + hstepA, voffA);
    if (wr == 1) PG8_BAR;
    PG8_WAIT_V(2); PG8_BAR;
    PG8_STAGE(PG8_SB(1, 0), cB + kstep, voffB); PG8_STAGE(PG8_SA(1, 0), cA + kstep, voffA); PG8_STAGE(PG8_SB(1, 1), cB + hstepB + kstep, voffB);
    PG8_WAIT_V(6); PG8_BAR;
    for (;;) {
        const bool has_next = S.next(ui + 1, nxt);
        const char* nA = has_next ? nxt.a : cA; const char* nB = has_next ? nxt.b : cB;
        const int nt = cur.nt;
        for (int t = 0; t < nt; t += 2) {
            const bool last = (t == nt - 2);
            const char* a1 = cA + (size_t)(t + 1) * kstep;
            const char* a2 = last ? nA : cA + (size_t)(t + 2) * kstep; const char* b2 = last ? nB : cB + (size_t)(t + 2) * kstep;
            const char* a3 = a2 + kstep; const char* b3 = b2 + kstep;
            PG8_LDB(B0, 0, 0); PG8_LDB(B1, 0, 1); PG8_SCHED; PG8_LDA(At, 0, 0); PG8_STAGE(PG8_SA(1, 1), a1 + hstepA, voffA);
            PG8_WAIT_V(8); PG8_WAIT_L(0); PG8_BAR; PG8_MMA(0, 0, At, B0); PG8_MMA(0, 1, At, B1); PG8_BAR; PG8_SCHED;
            PG8_LDA(At, 0, 1); PG8_STAGE(PG8_SB(0, 0), b2, voffB); PG8_STAGE(PG8_SB(0, 1), b2 + hstepB, voffB); PG8_STAGE(PG8_SA(0, 0), a2, voffA);
            PG8_WAIT_V(8); PG8_WAIT_L(0); PG8_BAR; PG8_MMA(1, 0, At, B0); PG8_MMA(1, 1, At, B1); PG8_BAR; PG8_SCHED;
            PG8_LDB(B0, 1, 0); PG8_LDB(B1, 1, 1); PG8_SCHED; PG8_LDA(At, 1, 0); PG8_STAGE(PG8_SA(0, 1), a2 + hstepA, voffA);
            PG8_WAIT_V(8); PG8_WAIT_L(0); PG8_BAR; PG8_MMA(0, 0, At, B0); PG8_MMA(0, 1, At, B1); PG8_BAR; PG8_SCHED;
            PG8_LDA(At, 1, 1); PG8_STAGE(PG8_SB(1, 0), b3, voffB); PG8_STAGE(PG8_SB(1, 1), b3 + hstepB, voffB); PG8_STAGE(PG8_SA(1, 0), a3, voffA);
            PG8_WAIT_V(8); PG8_WAIT_L(0); PG8_BAR; PG8_MMA(1, 0, At, B0); PG8_MMA(1, 1, At, B1); PG8_BAR; PG8_SCHED;
        }
        if (wr == 0) PG8_BAR;
        E(acc, cur, wr, wc, fr, fq);
        if (!has_next) break;
#pragma unroll
        for (int a = 0; a < 2; ++a)
#pragma unroll
            for (int b = 0; b < 2; ++b)
#pragma unroll
                for (int m = 0; m < 4; ++m)
#pragma unroll
                    for (int n = 0; n < 2; ++n) acc[a][b][m][n] = (f32x4){0.f, 0.f, 0.f, 0.f};
        cur = nxt; cA = nA; cB = nB; ++ui;
        if (wr == 1) PG8_BAR;
    }
    PG8_WAIT_V(0);
    PG8_BAR;
#undef PG8_SA
#undef PG8_SB
#undef PG8_STAGE
#undef PG8_LDA
#undef PG8_LDB
#undef PG8_MMA
#undef PG8_WAIT_V
#undef PG8_WAIT_L
#undef PG8_BAR
#undef PG8_SCHED
}

struct EpiQKV {
    static constexpr bool PERM = true;
    bf16_t* O; const float* bias; const float* rope; const float* rstd;
    __device__ __forceinline__ void operator()(const f32x4 (&acc)[2][2][4][2], const Unit& u, int wr, int wc, int fr, int fq) const {
        const int H = 4 * u.pn + wc, colb = H * 64 + 8 * fq;
        const f32x4 bl0 = *(const f32x4*)(bias + colb), bl1 = *(const f32x4*)(bias + colb + 4), bh0 = *(const f32x4*)(bias + colb + 32), bh1 = *(const f32x4*)(bias + colb + 36);
        const bool rot = H < 18;
        const int row0 = u.pm * 256 + wr * 64 + fr;
        float rs[8];
#pragma unroll
        for (int g = 0; g < 8; ++g) rs[g] = rstd[row0 + (g >> 2) * 128 + (g & 3) * 16];
        f32x4 cs[2][4];
#define QKV_LOADCS(g, b) do { const int row_ = row0 + ((g) >> 2) * 128 + ((g) & 3) * 16; const int pidx_ = row_ < MP ? (row_ & (SEQ - 1)) : SEQ + ((row_ - MP) & 7); \
            const float* rp_ = rope + (size_t)pidx_ * 64 + 8 * fq; cs[b][0] = *(const f32x4*)(rp_); cs[b][1] = *(const f32x4*)(rp_ + 4); cs[b][2] = *(const f32x4*)(rp_ + 32); cs[b][3] = *(const f32x4*)(rp_ + 36); } while (0)
        QKV_LOADCS(0, 0);
#pragma unroll
        for (int g = 0; g < 8; ++g) {
            const int ai = g >> 2, m = g & 3, b = g & 1;
            if (g + 1 < 8) QKV_LOADCS(g + 1, b ^ 1);
            const int row = row0 + ai * 128 + m * 16;
            f32x4 c0 = cs[b][0], c1 = cs[b][1], s0 = cs[b][2], s1 = cs[b][3];
            if (!rot) { c0 = (f32x4){1.f, 1.f, 1.f, 1.f}; c1 = c0; s0 = (f32x4){0.f, 0.f, 0.f, 0.f}; s1 = s0; }
            const float r = rs[g];
            const f32x4 l0 = acc[ai][0][m][0] * r + bl0, l1 = acc[ai][0][m][1] * r + bl1, h0 = acc[ai][1][m][0] * r + bh0, h1 = acc[ai][1][m][1] * r + bh1;
            const f32x4 ol0 = l0 * c0 - h0 * s0, ol1 = l1 * c1 - h1 * s1, oh0 = h0 * c0 + l0 * s0, oh1 = h1 * c1 + l1 * s1;
            bf16_t* op = O + (size_t)row * NQKV + colb;
            u32x4 w; w.x = cvt_pk_bf16(ol0[0], ol0[1]); w.y = cvt_pk_bf16(ol0[2], ol0[3]); w.z = cvt_pk_bf16(ol1[0], ol1[1]); w.w = cvt_pk_bf16(ol1[2], ol1[3]);
            *(u32x4*)op = w;
            w.x = cvt_pk_bf16(oh0[0], oh0[1]); w.y = cvt_pk_bf16(oh0[2], oh0[3]); w.z = cvt_pk_bf16(oh1[0], oh1[1]); w.w = cvt_pk_bf16(oh1[2], oh1[3]);
            *(u32x4*)(op + 32) = w;
        }
#undef QKV_LOADCS
    }
};
template <int MODE> struct EpiPair {
    static constexpr bool PERM = true;
    bf16_t* O0; bf16_t* O1; const float* rstd;
    __device__ __forceinline__ void operator()(const f32x4 (&acc)[2][2][4][2], const Unit& u, int wr, int wc, int fr, int fq) const {
        const int cc = 32 * wc + 8 * fq;
        float rsv[8];
#pragma unroll
        for (int g = 0; g < 8; ++g) rsv[g] = rstd[u.pm * 256 + wr * 64 + fr + (g >> 2) * 128 + (g & 3) * 16];
#pragma unroll
        for (int ai = 0; ai < 2; ++ai)
#pragma unroll
            for (int m = 0; m < 4; ++m) {
                const size_t row = (size_t)(u.pm * 256 + ai * 128 + wr * 64 + m * 16 + fr);
                const float rs = rsv[ai * 4 + m];
                f32x4 p0 = acc[ai][0][m][0] * rs, p1 = acc[ai][0][m][1] * rs, q0 = acc[ai][1][m][0] * rs, q1 = acc[ai][1][m][1] * rs;
                u32x4 w;
                if (MODE == 0) {
                    const float c1 = -rs * LOG2E, c2 = rs * rs;
                    const f32x4 a0 = acc[ai][0][m][0], a1 = acc[ai][0][m][1], b0 = acc[ai][1][m][0], b1 = acc[ai][1][m][1];
                    f32x4 t0 = a0 * c1, t1 = a1 * c1;
#pragma unroll
                    for (int j = 0; j < 4; ++j) { t0[j] = __builtin_amdgcn_exp2f(t0[j]); t1[j] = __builtin_amdgcn_exp2f(t1[j]); }
                    t0 = t0 + 1.0f; t1 = t1 + 1.0f;
#pragma unroll
                    for (int j = 0; j < 4; ++j) { t0[j] = __builtin_amdgcn_rcpf(t0[j]); t1[j] = __builtin_amdgcn_rcpf(t1[j]); }
                    p0 = (a0 * b0) * c2 * t0; p1 = (a1 * b1) * c2 * t1;
                    w.x = cvt_pk_bf16(p0[0], p0[1]); w.y = cvt_pk_bf16(p0[2], p0[3]); w.z = cvt_pk_bf16(p1[0], p1[1]); w.w = cvt_pk_bf16(p1[2], p1[3]);
                    *(u32x4*)(O0 + row * DFF + 128 * u.pn + cc) = w;
                } else if (MODE == 1) {
#pragma unroll
                    for (int j = 0; j < 4; ++j) { float x = p0[j]; p0[j] = x * fast_sigmoid(1.5957691216f * (x + 0.044715f * x * x * x)); x = p1[j]; p1[j] = x * fast_sigmoid(1.5957691216f * (x + 0.044715f * x * x * x)); }
                    w.x = cvt_pk_bf16(p0[0], p0[1]); w.y = cvt_pk_bf16(p0[2], p0[3]); w.z = cvt_pk_bf16(p1[0], p1[1]); w.w = cvt_pk_bf16(p1[2], p1[3]);
                    *(u32x4*)(O0 + row * DM + 128 * u.pn + cc) = w;
                    w.x = cvt_pk_bf16(q0[0], q0[1]); w.y = cvt_pk_bf16(q0[2], q0[3]); w.z = cvt_pk_bf16(q1[0], q1[1]); w.w = cvt_pk_bf16(q1[2], q1[3]);
                    *(u32x4*)(O1 + row * DM + 128 * u.pn + cc) = w;
                } else {
                    if (u.pn < 8) {
                        p0 = p0 * q0; p1 = p1 * q1;
                        w.x = cvt_pk_bf16(p0[0], p0[1]); w.y = cvt_pk_bf16(p0[2], p0[3]); w.z = cvt_pk_bf16(p1[0], p1[1]); w.w = cvt_pk_bf16(p1[2], p1[3]);
                        *(u32x4*)(O0 + row * DM + 128 * u.pn + cc) = w;
                    } else {
                        w.x = cvt_pk_bf16(p0[0], p0[1]); w.y = cvt_pk_bf16(p0[2], p0[3]); w.z = cvt_pk_bf16(p1[0], p1[1]); w.w = cvt_pk_bf16(p1[2], p1[3]);
                        *(u32x4*)(O1 + row * DM + 256 * (u.pn - 8) + cc) = w;
                        w.x = cvt_pk_bf16(q0[0], q0[1]); w.y = cvt_pk_bf16(q0[2], q0[3]); w.z = cvt_pk_bf16(q1[0], q1[1]); w.w = cvt_pk_bf16(q1[2], q1[3]);
                        *(u32x4*)(O1 + row * DM + 256 * (u.pn - 8) + 128 + cc) = w;
                    }
                }
            }
    }
};
struct EpiRgGates {
    static constexpr bool PERM = true;
    const bf16_t* U; bf16_t* LA; bf16_t* Bv; const float* ba; const float* bx; const float* c8;
    __device__ __forceinline__ void operator()(const f32x4 (&acc)[2][2][4][2], const Unit& u, int wr, int wc, int fr, int fq) const {
        const int ch = 128 * u.pn + 32 * wc + 8 * fq;
        f32x4 vba[2], vbx[2], vc8[2];
#pragma unroll
        for (int n = 0; n < 2; ++n) { vba[n] = *(const f32x4*)(ba + ch + 4 * n); vbx[n] = *(const f32x4*)(bx + ch + 4 * n); vc8[n] = *(const f32x4*)(c8 + ch + 4 * n); }
        u32x4 uws[8];
#pragma unroll
        for (int g = 0; g < 8; ++g) uws[g] = *(const u32x4*)(U + (size_t)(u.pm * 256 + (g >> 2) * 128 + wr * 64 + (g & 3) * 16 + fr) * DM + ch);
#pragma unroll
        for (int ai = 0; ai < 2; ++ai)
#pragma unroll
            for (int m = 0; m < 4; ++m) {
                const size_t off = (size_t)(u.pm * 256 + ai * 128 + wr * 64 + m * 16 + fr) * DM + ch;
                const u32x4 uw = uws[ai * 4 + m];
                float la[8], bb[8];
#pragma unroll
                for (int n = 0; n < 2; ++n)
#pragma unroll
                    for (int j = 0; j < 4; ++j) {
                        const float r = fast_sigmoid(acc[ai][0][m][n][j] + vba[n][j]), ig = fast_sigmoid(acc[ai][1][m][n][j] + vbx[n][j]);
                        const float l2 = vc8[n][j] * r; const float a2 = __builtin_amdgcn_exp2f(2.f * l2);
                        const unsigned uu = uw[n * 2 + (j >> 1)]; const float uv = (j & 1) ? bfhi(uu) : bflo(uu);
                        la[n * 4 + j] = l2; bb[n * 4 + j] = __builtin_sqrtf(fmaxf(1.f - a2, 0.f)) * ig * uv;
                    }
                u32x4 w; w.x = cvt_pk_bf16(la[0], la[1]); w.y = cvt_pk_bf16(la[2], la[3]); w.z = cvt_pk_bf16(la[4], la[5]); w.w = cvt_pk_bf16(la[6], la[7]);
                *(u32x4*)(LA + off) = w;
                w.x = cvt_pk_bf16(bb[0], bb[1]); w.y = cvt_pk_bf16(bb[2], bb[3]); w.z = cvt_pk_bf16(bb[4], bb[5]); w.w = cvt_pk_bf16(bb[6], bb[7]);
                *(u32x4*)(Bv + off) = w;
            }
    }
};
template <bool FIRST> struct EpiResid {
    static constexpr bool PERM = false;
    const float* Xin; float* PART; const float* bias; bf16_t* XB; float* SS;
    __device__ __forceinline__ void operator()(const f32x4 (&acc)[2][2][4][2], const Unit& u, int wr, int wc, int fr, int fq) const {
        const int col0 = u.pn * 256 + wc * 32 + 4 * fq;
        if (u.aux == 0) {
            f32x4 bv[2][2];
#pragma unroll
            for (int bj = 0; bj < 2; ++bj)
#pragma unroll
                for (int n = 0; n < 2; ++n) bv[bj][n] = *(const f32x4*)(bias + col0 + bj * 128 + n * 16);
            const size_t row0 = (size_t)(u.pm * 256 + wr * 64 + fr);
            f32x4 xin[2][4];
#define RES_LOAD(g, b) do { if (FIRST) { const float* xp_ = Xin + (row0 + ((g) >> 2) * 128 + ((g) & 3) * 16) * DM + col0; \
                    xin[b][0] = __builtin_nontemporal_load((const f32x4*)(xp_)); xin[b][1] = __builtin_nontemporal_load((const f32x4*)(xp_ + 16)); xin[b][2] = __builtin_nontemporal_load((const f32x4*)(xp_ + 128)); xin[b][3] = __builtin_nontemporal_load((const f32x4*)(xp_ + 144)); } \
                else { const bf16_t* xp_ = XB + (row0 + ((g) >> 2) * 128 + ((g) & 3) * 16) * DM + col0; \
                    _Pragma("unroll") for (int q_ = 0; q_ < 4; ++q_) { const u32x2 w_ = *(const u32x2*)(xp_ + (q_ >> 1) * 128 + (q_ & 1) * 16); xin[b][q_] = (f32x4){bflo(w_.x), bfhi(w_.x), bflo(w_.y), bfhi(w_.y)}; } } } while (0)
            RES_LOAD(0, 0);
#pragma unroll
            for (int g = 0; g < 8; ++g) {
                const int ai = g >> 2, m = g & 3, b = g & 1;
                if (g + 1 < 8) RES_LOAD(g + 1, b ^ 1);
                const size_t row = row0 + ai * 128 + m * 16;
                bf16_t* bp = XB + row * DM + col0;
                float ss = 0.f;
#pragma unroll
                for (int bj = 0; bj < 2; ++bj)
#pragma unroll
                    for (int n = 0; n < 2; ++n) {
                        const f32x4 v = xin[b][bj * 2 + n] + acc[ai][bj][m][n] + bv[bj][n];
                        u32x2 w; w.x = cvt_pk_bf16(v[0], v[1]); w.y = cvt_pk_bf16(v[2], v[3]); *(u32x2*)(bp + bj * 128 + n * 16) = w;
                        ss += (v[0] * v[0] + v[1] * v[1]) + (v[2] * v[2] + v[3] * v[3]);
                    }
                ss += __shfl_xor(ss, 16); ss += __shfl_xor(ss, 32);
                if (fq == 0) SS[row * 16 + u.pn * 4 + wc] = ss;
            }
#undef RES_LOAD
        } else {
            float* pp = PART + (size_t)(u.aux - 1) * MS * DM;
#pragma unroll
            for (int ai = 0; ai < 2; ++ai)
#pragma unroll
                for (int m = 0; m < 4; ++m) {
                    float* xp = pp + (size_t)(u.pm * 256 - MP + ai * 128 + wr * 64 + m * 16 + fr) * DM + col0;
#pragma unroll
                    for (int bj = 0; bj < 2; ++bj)
#pragma unroll
                        for (int n = 0; n < 2; ++n) *(f32x4*)(xp + bj * 128 + n * 16) = acc[ai][bj][m][n];
                }
        }
    }
};
}

struct Params { const float* in[31]; float* out; unsigned char* ws; int ph_lo, ph_hi; };

__device__ __forceinline__ unsigned f2bf(float f) { unsigned u = __builtin_bit_cast(unsigned, f); return (u + 0x7fffu + ((u >> 16) & 1u)) >> 16; }
__device__ __forceinline__ unsigned pk2(float lo, float hi) { return f2bf(lo) | (f2bf(hi) << 16); }

struct TItem { const float* S; int Ns, K, n0, k0; bf16_t* WT; const float* gk; };
__device__ __forceinline__ void titem_load(const TItem& t, float (&tv)[32], int lane) {
#pragma unroll
    for (int i = 0; i < 32; ++i) tv[i] = __builtin_nontemporal_load(t.S + (size_t)(t.k0 + 2 * i + (lane >> 5)) * t.Ns + (lane & 31));
}
__device__ __forceinline__ void titem_finish(const TItem& t, const float (&tv)[32], LAS float* scr, int lane) {
    const int c = lane & 7;
    f32x4 g0 = (f32x4){1.f, 1.f, 1.f, 1.f}, g1 = g0;
    if (t.gk) { g0 = *(const f32x4*)(t.gk + t.k0 + 8 * c); g1 = *(const f32x4*)(t.gk + t.k0 + 8 * c + 4); }
#pragma unroll
    for (int i = 0; i < 32; ++i) scr[(2 * i + (lane >> 5)) * 33 + (lane & 31)] = tv[i];
    asm volatile("s_waitcnt lgkmcnt(0)" ::: "memory");
#pragma unroll
    for (int j = 0; j < 4; ++j) { const int n = (lane >> 3) + 8 * j; const LAS float* s = scr + (8 * c) * 33 + n;
        u32x4 o; o.x = pk2(s[0 * 33] * g0.x, s[1 * 33] * g0.y); o.y = pk2(s[2 * 33] * g0.z, s[3 * 33] * g0.w); o.z = pk2(s[4 * 33] * g1.x, s[5 * 33] * g1.y); o.w = pk2(s[6 * 33] * g1.z, s[7 * 33] * g1.w);
        *(u32x4*)(t.WT + (size_t)(t.n0 + n) * t.K + t.k0 + 8 * c) = o; }
    asm volatile("s_waitcnt lgkmcnt(0)" ::: "memory");
}

__device__ __forceinline__ bool titem_decode(const Params& p, unsigned char* ws, int it, TItem& t) {
    constexpr int I_QKV = 16 * 40, I_SQ = 16 * 32, I_FU = 16 * 176, I_FD = 44 * 32, I_RG1 = 16 * 64, I_RG2 = 4 * 64, I_SC1 = 16 * 96;
    constexpr int NITEMS = 2 * I_QKV + 2 * I_SQ + 4 * I_FU + 4 * I_FD + I_RG1 + I_RG2 + I_SQ + I_SC1 + I_SQ;
    if (it >= NITEMS) return false;
        int r = it;
        const float* S; int Ns, K, n0, k0; bf16_t* WT; const float* gk = nullptr;
        if (r < 2 * I_QKV) { const int j = r / I_QKV; r -= j * I_QKV; K = 1024; const int nb = r % 40, kb = r / 40; k0 = 64 * kb; n0 = 32 * nb;
            const int pn = nb >> 3, bj = (nb >> 2) & 1, hh = nb & 3; Ns = NQKV; S = p.in[10] + (size_t)j * 1024 * NQKV + (4 * pn + hh) * 64 + 32 * bj; WT = (bf16_t*)(ws + WS_WQKV) + (size_t)j * NQKV * 1024; gk = p.in[7] + 3 * j * DM; }
        else if ((r -= 2 * I_QKV) < 2 * I_SQ) { const int j = r / I_SQ; r -= j * I_SQ; K = 1024; const int nb = r % 32, kb = r / 32; k0 = 64 * kb; n0 = 32 * nb; Ns = 1024; S = p.in[12] + (size_t)j * 1024 * 1024 + n0; WT = (bf16_t*)(ws + WS_WO) + (size_t)j * 1024 * 1024; }
        else if ((r -= 2 * I_SQ) < 4 * I_FU) { const int i = r / I_FU; r -= i * I_FU; K = 1024; const int nb = r % 176, kb = r / 176; k0 = 64 * kb; n0 = 32 * nb;
            const int pn = nb >> 3, bj = (nb >> 2) & 1, c32 = nb & 3; Ns = DFF; S = (bj ? p.in[29] : p.in[28]) + (size_t)i * 1024 * DFF + 128 * pn + 32 * c32; WT = (bf16_t*)(ws + WS_WFU) + (size_t)i * 5632 * 1024; gk = p.in[8] + i * DM; }
        else if ((r -= 4 * I_FU) < 4 * I_FD) { const int i = r / I_FD; r -= i * I_FD; K = DFF; const int nb = r % 32, kb = r / 32; k0 = 64 * kb; n0 = 32 * nb; Ns = 1024; S = p.in[30] + (size_t)i * DFF * 1024 + n0; WT = (bf16_t*)(ws + WS_WFD) + (size_t)i * 1024 * DFF; }
        else if ((r -= 4 * I_FD) < I_RG1) { K = 1024; const int nb = r % 64, kb = r / 64; k0 = 64 * kb; n0 = 32 * nb;
            const int pn = nb >> 3, bj = (nb >> 2) & 1, c32 = nb & 3; Ns = 1024; S = (bj ? p.in[16] : p.in[15]) + 128 * pn + 32 * c32; WT = (bf16_t*)(ws + WS_WRG1); gk = p.in[7] + 1 * DM; }
        else if ((r -= I_RG1) < I_RG2) { K = 256; const int nb = r % 64, kb = r / 64; k0 = 64 * kb; n0 = 32 * nb;
            const int pn = nb >> 3, bj = (nb >> 2) & 1, c32 = nb & 3; Ns = 256; S = (bj ? p.in[21] : p.in[19]) + (size_t)(pn >> 1) * 65536 + 128 * (pn & 1) + 32 * c32; WT = (bf16_t*)(ws + WS_WRG2); }
        else if ((r -= I_RG2) < I_SQ) { K = 1024; const int nb = r % 32, kb = r / 32; k0 = 64 * kb; n0 = 32 * nb; Ns = 1024; S = p.in[24] + n0; WT = (bf16_t*)(ws + WS_WRG3); }
        else if ((r -= I_SQ) < I_SC1) { K = 1024; const int nb = r % 96, kb = r / 96; k0 = 64 * kb; n0 = 32 * nb;
            const int pn = nb >> 3, bj = (nb >> 2) & 1, c32 = nb & 3; Ns = 3072;
            const int col = pn < 8 ? (bj ? 2048 : 1024) + 128 * pn + 32 * c32 : 256 * (pn - 8) + 128 * bj + 32 * c32; S = p.in[25] + col; WT = (bf16_t*)(ws + WS_WSC1); gk = p.in[7] + 2 * DM; }
        else { r -= I_SC1; K = 1024; const int nb = r % 32, kb = r / 32; k0 = 64 * kb; n0 = 32 * nb; Ns = 1024; S = p.in[27] + n0; WT = (bf16_t*)(ws + WS_WSC2); }
        t.S = S; t.Ns = Ns; t.K = K; t.n0 = n0; t.k0 = k0; t.WT = WT; t.gk = gk;
    return true;
}

__device__ __forceinline__ int set_size(int s) { return s == 0 ? 640 : s == 1 ? 6528 : s == 2 ? 6272 : s == 3 ? 4224 : 5376; }
__device__ __forceinline__ int set_item(int s, int k) {
    if (s == 0) return k;
    if (s == 1) { if (k < 512) return 1280 + k; k -= 512; if (k < 2816) return 2304 + k; k -= 2816; if (k < 1408) return 13568 + k; k -= 1408; return 19200 + k; }
    if (s == 2) { if (k < 2816) return 5120 + k; k -= 2816; if (k < 1408) return 14976 + k; k -= 1408; return 20992 + k; }
    if (s == 3) { if (k < 2816) return 7936 + k; k -= 2816; return 16384 + k; }
    if (k < 640) return 640 + k; k -= 640; if (k < 512) return 1792 + k; k -= 512; if (k < 2816) return 10752 + k; k -= 2816; return 17792 + k;
}
__device__ __forceinline__ void convert_set(const Params& p, unsigned char* ws, LAS float* scr, int set, int widx, int nw, int lane) {
    const int n = set_size(set);
    TItem cur, nxt; float tv[32], tn[32];
    int k = widx;
    bool has = k < n;
    if (has) { titem_decode(p, ws, set_item(set, k), cur); titem_load(cur, tv, lane); }
    while (has) {
        k += nw;
        const bool hn = k < n;
        if (hn) { titem_decode(p, ws, set_item(set, k), nxt); titem_load(nxt, tn, lane); }
        titem_finish(cur, tv, scr, lane);
#pragma unroll
        for (int i = 0; i < 32; ++i) tv[i] = tn[i];
        cur = nxt; has = hn;
    }
}
__device__ __forceinline__ void convert_in_slack(const Params& p, unsigned char* ws, LAS unsigned char* lds, int set, int nU, int vcu, int G, const int tid) {
    const int first = nU % G, nidle = first == 0 ? G : G - first;
    const int k0 = first == 0 ? 0 : first;
    if (vcu < k0) return;
    const int lane = tid & 63, wave = __builtin_amdgcn_readfirstlane(tid >> 6);
    convert_set(p, ws, (LAS float*)(lds + wave * 16384), set, (vcu - k0) * 8 + wave, nidle * 8, lane);
}

__device__ __forceinline__ void prep_phase(const Params& p, LAS unsigned char* lds, int vcu, int G, const int tid) {
    const int lane = tid & 63, wave = __builtin_amdgcn_readfirstlane(tid >> 6);
    LAS float* scr = (LAS float*)(lds + wave * 16384);
    const int gw = vcu * 8 + wave, NGW = G * 8;
    unsigned char* ws = p.ws;
    convert_set(p, ws, scr, 0, gw, NGW, lane);
    {
        float* rstd = (float*)(ws + WS_RSTD);
        for (int m = gw; m < M; m += NGW) {
            const float* src = m < MP ? p.in[0] + (size_t)m * DM : p.in[1] + (size_t)(m - MP) * DM;
            f32x4 v[4]; float s = 0.f;
#pragma unroll
            for (int j = 0; j < 4; ++j) { v[j] = __builtin_nontemporal_load((const f32x4*)src + lane + 64 * j); s += (v[j].x * v[j].x + v[j].y * v[j].y) + (v[j].z * v[j].z + v[j].w * v[j].w); }
            s = wave_sum(s);
            if (lane == 0) rstd[m] = 1.0f / sqrtf(s * (1.f / DM) + EPS);
            u32x2* no = (u32x2*)((bf16_t*)(ws + WS_XN) + (size_t)m * DM) + lane;
#pragma unroll
            for (int j = 0; j < 4; ++j) { u32x2 w; w.x = cvt_pk_bf16(v[j].x, v[j].y); w.y = cvt_pk_bf16(v[j].z, v[j].w); no[64 * j] = w; }
        }
    }
    {
        const int gt = vcu * 512 + tid, NGT = G * 512;
        float* rope = (float*)(ws + WS_ROPE);
        for (int e = gt; e < 4104 * 32; e += NGT) {
            const int pi = e >> 5, d = e & 31; const int pos = pi < SEQ ? pi : 8192 + (pi - SEQ);
            double inv = 1.0; for (int k = 0; k < d; ++k) inv *= 0.7498942093324559;
            const float ang = (float)pos * (float)inv;
            const double rev = (double)ang * 0.15915494309189535; const double fr = rev - __builtin_rint(rev);
            rope[(size_t)pi * 64 + d] = __builtin_amdgcn_cosf((float)fr); rope[(size_t)pi * 64 + 32 + d] = __builtin_amdgcn_sinf((float)fr);
        }
        float* c8 = (float*)(ws + WS_C8);
        for (int e = gt; e < 1024; e += NGT) { const float lam = p.in[23][e]; c8[e] = -8.0f * log1pf(__expf(-lam)) * LOG2E; ((float*)(ws + WS_ZB))[e] = 0.f; }
    }
}

__device__ __forceinline__ void norm_phase(float* X, const float* PART, int nsplit, const float* bias, const float* g, bf16_t* XN, bool final_, int vcu, int G, const int tid) {
    const int lane = tid & 63, wave = tid >> 6;
    const int gw = vcu * 8 + wave, NGW = G * 8;
    f32x4 gv[4];
#pragma unroll
    for (int j = 0; j < 4; ++j) gv[j] = *((const f32x4*)g + lane + 64 * j);
    for (int m = gw; m < M; m += NGW) {
        f32x4* xr = (f32x4*)(X + (size_t)m * DM) + lane;
        f32x4 v[4]; float s = 0.f;
        if (m >= MP) {
#pragma unroll
            for (int j = 0; j < 4; ++j) v[j] = xr[64 * j];
        } else {
            const u32x2* br = (const u32x2*)(XN + (size_t)m * DM) + lane;
#pragma unroll
            for (int j = 0; j < 4; ++j) { const u32x2 w = __builtin_nontemporal_load(br + 64 * j); v[j] = (f32x4){bflo(w.x), bfhi(w.x), bflo(w.y), bfhi(w.y)}; }
        }
        if (m >= MP) {
#pragma unroll 4
            for (int sl = 0; sl < nsplit; ++sl) { const f32x4* pr = (const f32x4*)(PART + ((size_t)sl * MS + (m - MP)) * DM) + lane;
#pragma unroll
                for (int j = 0; j < 4; ++j) v[j] += pr[64 * j]; }
            if (bias) {
#pragma unroll
                for (int j = 0; j < 4; ++j) v[j] += *((const f32x4*)bias + lane + 64 * j); }
            if (!final_) {
#pragma unroll
                for (int j = 0; j < 4; ++j) xr[64 * j] = v[j]; }
        }
#pragma unroll
        for (int j = 0; j < 4; ++j) s += (v[j].x * v[j].x + v[j].y * v[j].y) + (v[j].z * v[j].z + v[j].w * v[j].w);
        const float rstd = 1.0f / sqrtf(wave_sum(s) * (1.f / DM) + EPS);
        if (final_) {
#pragma unroll
            for (int j = 0; j < 4; ++j) __builtin_nontemporal_store(v[j] * rstd * gv[j], xr + 64 * j);
        } else {
            u32x2* no = (u32x2*)(XN + (size_t)m * DM) + lane;
#pragma unroll
            for (int j = 0; j < 4; ++j) { const f32x4 y = v[j] * rstd * gv[j]; u32x2 w; w.x = cvt_pk_bf16(y.x, y.y); w.y = cvt_pk_bf16(y.z, y.w); no[64 * j] = w; }
        }
    }
}

__device__ __forceinline__ void fin_phase(const float* Xin, float* X, const float* PART, int nsplit, const float* bias, bf16_t* XB, const float* SS, float* rstd, int vcu, int G, const int tid) {
    const int lane = tid & 63, wave = tid >> 6;
    const int gw = vcu * 8 + wave, NGW = G * 8;
    for (int r = gw; r < MS; r += NGW) {
        const int m = MP + r;
        f32x4* xr = (f32x4*)(X + (size_t)m * DM) + lane;
        const f32x4* xi = (const f32x4*)(Xin + (size_t)r * DM) + lane;
        f32x4 v[4]; float s = 0.f;
#pragma unroll
        for (int j = 0; j < 4; ++j) v[j] = xi[64 * j];
#pragma unroll 4
        for (int sl = 0; sl < nsplit; ++sl) { const f32x4* pr = (const f32x4*)(PART + ((size_t)sl * MS + r) * DM) + lane;
#pragma unroll
            for (int j = 0; j < 4; ++j) v[j] += pr[64 * j]; }
        if (bias) {
#pragma unroll
            for (int j = 0; j < 4; ++j) v[j] += *((const f32x4*)bias + lane + 64 * j); }
        u32x2* no = (u32x2*)(XB + (size_t)m * DM) + lane;
#pragma unroll
        for (int j = 0; j < 4; ++j) { xr[64 * j] = v[j]; u32x2 w; w.x = cvt_pk_bf16(v[j].x, v[j].y); w.y = cvt_pk_bf16(v[j].z, v[j].w); no[64 * j] = w;
            s += (v[j].x * v[j].x + v[j].y * v[j].y) + (v[j].z * v[j].z + v[j].w * v[j].w); }
        s = wave_sum(s);
        if (lane == 0) rstd[m] = 1.0f / sqrtf(s * (1.f / DM) + EPS);
    }
    const int gt = vcu * 512 + tid, NGT = G * 512;
    for (int m = NGT - 1 - gt; m < MP; m += NGT) {
        const f32x4* sp = (const f32x4*)(SS + (size_t)m * 16);
        const f32x4 a = sp[0], b = sp[1], c = sp[2], d = sp[3];
        const float s = ((a.x + a.y) + (a.z + a.w)) + ((b.x + b.y) + (b.z + b.w)) + ((c.x + c.y) + (c.z + c.w)) + ((d.x + d.y) + (d.z + d.w));
        rstd[m] = 1.0f / sqrtf(s * (1.f / DM) + EPS);
    }
}

constexpr int KS_PITCH = 72, VT_PITCH = 260;
constexpr int ATT_KS = 0, ATT_VT = 256 * KS_PITCH * 2;
__device__ __forceinline__ void attn_phase(const Params& p, LAS unsigned char* lds, int j, int vcu, int G, const int tid) {
    const int lane = tid & 63, wave = __builtin_amdgcn_readfirstlane(tid >> 6), l31 = lane & 31, hi = lane >> 5;
    const bf16_t* QKV = (const bf16_t*)(p.ws + WS_S0);
    bf16_t* O = (bf16_t*)(p.ws + WS_S2);
    LAS bf16_t* Ks = (LAS bf16_t*)(lds + ATT_KS);
    LAS bf16_t* Vt = (LAS bf16_t*)(lds + ATT_VT);
    const float* ck = p.in[2] + (size_t)j * 128 * 128 * 128;
    const float* cv = p.in[3] + (size_t)j * 128 * 128 * 128;
    {
        const int gt = vcu * 512 + tid, NGT = G * 512;
        float* kp = p.out + O_KP + (size_t)j * 65536; float* vp = p.out + O_VP + (size_t)j * 65536;
        for (int e = gt; e < 65536; e += NGT) { const int d = e & 127, t = (e >> 7) & 127, b = e >> 14; const size_t src = (size_t)(b * SEQ + SEQ - 128 + t) * NQKV + 1024 + d;
            kp[e] = bf2f(QKV[src]); vp[e] = bf2f(QKV[src + 128]); }
        float* ksn = p.out + O_KS + (size_t)j * 2097152; float* vsn = p.out + O_VS + (size_t)j * 2097152;
        f32x4 kv4[4], vv4[4];
#pragma unroll
        for (int it = 0; it < 4; ++it) {
            const int e4 = gt + it * NGT;
            if (e4 < 524288) { const int e = e4 * 4, d = e & 127, c = (e >> 7) & 127, b = e >> 14;
                if (c < 120) { kv4[it] = __builtin_nontemporal_load((const f32x4*)(ck + e + 8 * 128)); vv4[it] = __builtin_nontemporal_load((const f32x4*)(cv + e + 8 * 128)); }
                else { const size_t src = (size_t)(MP + b * 8 + c - 120) * NQKV + 1024 + d; const u32x2 kw = *(const u32x2*)(QKV + src), vw = *(const u32x2*)(QKV + src + 128);
                    kv4[it] = (f32x4){bflo(kw.x), bfhi(kw.x), bflo(kw.y), bfhi(kw.y)}; vv4[it] = (f32x4){bflo(vw.x), bfhi(vw.x), bflo(vw.y), bfhi(vw.y)}; } }
        }
#pragma unroll
        for (int it = 0; it < 4; ++it) { const int e4 = gt + it * NGT; if (e4 < 524288) { __builtin_nontemporal_store(kv4[it], (f32x4*)(ksn + (size_t)e4 * 4)); __builtin_nontemporal_store(vv4[it], (f32x4*)(vsn + (size_t)e4 * 4)); } }
        for (int e4 = gt + 4 * NGT; e4 < 524288; e4 += NGT) {
            const int e = e4 * 4, d = e & 127, c = (e >> 7) & 127, b = e >> 14;
            if (c < 120) { *(f32x4*)(ksn + e) = *(const f32x4*)(ck + e + 8 * 128); *(f32x4*)(vsn + e) = *(const f32x4*)(cv + e + 8 * 128); }
            else { const size_t src = (size_t)(MP + b * 8 + c - 120) * NQKV + 1024 + d; const u32x2 kw = *(const u32x2*)(QKV + src), vw = *(const u32x2*)(QKV + src + 128);
                *(f32x4*)(ksn + e) = (f32x4){bflo(kw.x), bfhi(kw.x), bflo(kw.y), bfhi(kw.y)}; *(f32x4*)(vsn + e) = (f32x4){bflo(vw.x), bfhi(vw.x), bflo(vw.y), bfhi(vw.y)}; }
        }
    }
    for (int un = vcu; un < 512; un += G) {
        const bool prompt = un < 256;
        int b, kvh, nb = 0;
        if (prompt) { b = un >> 6; kvh = (un >> 5) & 1; nb = un & 31; } else { const int s = un - 256; b = s >> 1; kvh = s & 1; }
        const int nkeys = prompt ? 256 : 160;
        for (int id = tid; id < nkeys * 8; id += 512) {
            const int key = id >> 3, ch = id & 7;
            u32x4 w = (u32x4){0u, 0u, 0u, 0u};
            if (prompt) { if (!(nb == 0 && key < 128)) w = *(const u32x4*)(QKV + (size_t)(b * SEQ + 128 * (nb - 1) + key) * NQKV + 1024 + kvh * 64 + 8 * ch); }
            else if (key < 128) { const float* s = ck + ((size_t)(b * 128 + key) * 2 + kvh) * 64 + 8 * ch; const f32x4 a = *(const f32x4*)s, c = *(const f32x4*)(s + 4);
                w.x = cvt_pk_bf16(a.x, a.y); w.y = cvt_pk_bf16(a.z, a.w); w.z = cvt_pk_bf16(c.x, c.y); w.w = cvt_pk_bf16(c.z, c.w); }
            else if (key < 136) w = *(const u32x4*)(QKV + (size_t)(MP + b * 8 + key - 128) * NQKV + 1024 + kvh * 64 + 8 * ch);
            *(LAS u32x4*)(Ks + key * KS_PITCH + 8 * ch) = w;
        }
        for (int id = tid; id < nkeys * 8; id += 512) {
            const int key = id % nkeys, ch = id / nkeys;
            u32x4 w = (u32x4){0u, 0u, 0u, 0u};
            if (prompt) { if (!(nb == 0 && key < 128)) w = *(const u32x4*)(QKV + (size_t)(b * SEQ + 128 * (nb - 1) + key) * NQKV + 1152 + kvh * 64 + 8 * ch); }
            else if (key < 128) { const float* s = cv + ((size_t)(b * 128 + key) * 2 + kvh) * 64 + 8 * ch; const f32x4 a = *(const f32x4*)s, c = *(const f32x4*)(s + 4);
                w.x = cvt_pk_bf16(a.x, a.y); w.y = cvt_pk_bf16(a.z, a.w); w.z = cvt_pk_bf16(c.x, c.y); w.w = cvt_pk_bf16(c.z, c.w); }
            else if (key < 136) w = *(const u32x4*)(QKV + (size_t)(MP + b * 8 + key - 128) * NQKV + 1152 + kvh * 64 + 8 * ch);
            LAS bf16_t* vd = Vt + (8 * ch) * VT_PITCH + key;
            vd[0 * VT_PITCH] = (bf16_t)(w.x & 0xffff); vd[1 * VT_PITCH] = (bf16_t)(w.x >> 16); vd[2 * VT_PITCH] = (bf16_t)(w.y & 0xffff); vd[3 * VT_PITCH] = (bf16_t)(w.y >> 16);
            vd[4 * VT_PITCH] = (bf16_t)(w.z & 0xffff); vd[5 * VT_PITCH] = (bf16_t)(w.z >> 16); vd[6 * VT_PITCH] = (bf16_t)(w.w & 0xffff); vd[7 * VT_PITCH] = (bf16_t)(w.w >> 16);
        }
        __syncthreads();
        const int h = kvh * 8 + wave;
        const float sink8 = p.in[14][j * 16 + h] * 8.0f;
        const int nqs = prompt ? 4 : 1;
        for (int qs = 0; qs < nqs; ++qs) {
            const int qi = 32 * qs + l31;
            const bool qvalid = prompt || l31 < 8;
            const size_t qrow = prompt ? (size_t)(b * SEQ + 128 * nb + qi) : (size_t)(MP + b * 8 + (l31 < 8 ? l31 : 7));
            bf16x8 qf[4];
#pragma unroll
            for (int d0 = 0; d0 < 4; ++d0) qf[d0] = *(const bf16x8*)(QKV + qrow * NQKV + h * 64 + 16 * d0 + 8 * hi);
            constexpr float CS = 0.125f * LOG2E;
            float mrun = sink8, lrun = hi == 0 ? 1.f : 0.f;
            f32x16 o0 = {}, o1 = {};
            const int kt_lo = (prompt && nb == 0 && qs < 4) ? 4 : qs;
            for (int kt = kt_lo; kt < qs + 5; ++kt) {
                f32x16 s = {};
#pragma unroll
                for (int d0 = 0; d0 < 4; ++d0) { const bf16x8 kf = *(const LAS bf16x8*)(Ks + (32 * kt + l31) * KS_PITCH + 16 * d0 + 8 * hi); s = __builtin_amdgcn_mfma_f32_32x32x16_bf16(kf, qf[d0], s, 0, 0, 0); }
                if (kt == qs || kt == qs + 4) {
#pragma unroll
                    for (int r = 0; r < 16; ++r) { const int c = 32 * kt + (r & 3) + 8 * (r >> 2) + 4 * hi; const bool ok = (c > qi) && (c <= qi + 128); s[r] = ok ? s[r] : -1e30f; }
                }
                float mx = fmaxf(fmaxf(s[0], s[1]), fmaxf(s[2], s[3]));
#pragma unroll
                for (int r = 4; r < 16; r += 4) mx = fmaxf(mx, fmaxf(fmaxf(s[r], s[r + 1]), fmaxf(s[r + 2], s[r + 3])));
                mx = fmaxf(mx, __shfl_xor(mx, 32));
                if (__any(mx > mrun)) {
                    const float mnew = fmaxf(mrun, mx), alpha = __builtin_amdgcn_exp2f((mrun - mnew) * CS);
                    lrun *= alpha; mrun = mnew;
#pragma unroll
                    for (int r = 0; r < 16; ++r) { o0[r] *= alpha; o1[r] *= alpha; }
                }
                const float mc = -mrun * CS;
                float ps = 0.f;
#pragma unroll
                for (int r = 0; r < 16; ++r) { s[r] = __builtin_amdgcn_exp2f(__builtin_fmaf(s[r], CS, mc)); ps += s[r]; }
                lrun += ps;
#pragma unroll
                for (int ss = 0; ss < 2; ++ss) {
                    u32x4 pw; pw.x = cvt_pk_bf16(s[8 * ss + 0], s[8 * ss + 1]); pw.y = cvt_pk_bf16(s[8 * ss + 2], s[8 * ss + 3]); pw.z = cvt_pk_bf16(s[8 * ss + 4], s[8 * ss + 5]); pw.w = cvt_pk_bf16(s[8 * ss + 6], s[8 * ss + 7]);
                    const bf16x8 pb = __builtin_bit_cast(bf16x8, pw);
                    const LAS bf16_t* vb = Vt + l31 * VT_PITCH + 32 * kt + 16 * ss + 4 * hi;
                    const s16x4 a0 = *(const LAS s16x4*)(vb), a1 = *(const LAS s16x4*)(vb + 8);
                    const s16x4 c0 = *(const LAS s16x4*)(vb + 32 * VT_PITCH), c1 = *(const LAS s16x4*)(vb + 32 * VT_PITCH + 8);
                    const bf16x8 v0 = (bf16x8){a0[0], a0[1], a0[2], a0[3], a1[0], a1[1], a1[2], a1[3]};
                    const bf16x8 v1 = (bf16x8){c0[0], c0[1], c0[2], c0[3], c1[0], c1[1], c1[2], c1[3]};
                    o0 = __builtin_amdgcn_mfma_f32_32x32x16_bf16(v0, pb, o0, 0, 0, 0);
                    o1 = __builtin_amdgcn_mfma_f32_32x32x16_bf16(v1, pb, o1, 0, 0, 0);
                }
            }
            const float ltot = lrun + __shfl_xor(lrun, 32);
            const float inv = 1.0f / ltot;
            if (qvalid) {
                const size_t orow = prompt ? (size_t)(b * SEQ + 128 * nb + qi) : (size_t)(MP + b * 8 + l31);
                bf16_t* op = O + orow * DM + h * 64 + 4 * hi;
#pragma unroll
                for (int r4 = 0; r4 < 4; ++r4) {
                    u32x2 w; w.x = cvt_pk_bf16(o0[4 * r4] * inv, o0[4 * r4 + 1] * inv); w.y = cvt_pk_bf16(o0[4 * r4 + 2] * inv, o0[4 * r4 + 3] * inv); *(u32x2*)(op + 8 * r4) = w;
                    w.x = cvt_pk_bf16(o1[4 * r4] * inv, o1[4 * r4 + 1] * inv); w.y = cvt_pk_bf16(o1[4 * r4 + 2] * inv, o1[4 * r4 + 3] * inv); *(u32x2*)(op + 32 + 8 * r4) = w;
                }
            }
        }
        __syncthreads();
    }
}

__device__ __forceinline__ void rgconv_phase(const Params& p, int vcu, int G, const int tid) {
    const int gt = vcu * 512 + tid, NGT = G * 512;
    const bf16_t* __restrict__ V = (const bf16_t*)(p.ws + WS_S1); bf16_t* __restrict__ U = (bf16_t*)(p.ws + WS_S3);
    const float* __restrict__ cw = p.in[17]; const float* __restrict__ cb = p.in[18]; const float* __restrict__ buf = p.in[5];
#pragma unroll 2
    for (int e = gt; e < M * 128; e += NGT) {
        const int row = e >> 7, ch = (e & 127) * 8;
        int t, T; const float* sb = nullptr;
        if (row < MP) { t = row & (SEQ - 1); T = SEQ; } else { t = (row - MP) & 7; T = 8; sb = buf + (size_t)((row - MP) >> 3) * 3 * DM; }
        float accv[8];
        { const f32x4 b0 = *(const f32x4*)(cb + ch), b1 = *(const f32x4*)(cb + ch + 4);
#pragma unroll
          for (int k = 0; k < 4; ++k) { accv[k] = b0[k]; accv[4 + k] = b1[k]; } }
#pragma unroll
        for (int jj = 0; jj < 4; ++jj) {
            const int tt = t - 3 + jj;
            float xv[8];
            if (tt >= 0) { const u32x4 w = *(const u32x4*)(V + (size_t)(row - 3 + jj) * DM + ch);
                xv[0] = bflo(w.x); xv[1] = bfhi(w.x); xv[2] = bflo(w.y); xv[3] = bfhi(w.y); xv[4] = bflo(w.z); xv[5] = bfhi(w.z); xv[6] = bflo(w.w); xv[7] = bfhi(w.w); }
            else if (sb) { const f32x4 a = *(const f32x4*)(sb + (size_t)(tt + 3) * DM + ch), c = *(const f32x4*)(sb + (size_t)(tt + 3) * DM + ch + 4);
#pragma unroll
                for (int k = 0; k < 4; ++k) { xv[k] = a[k]; xv[4 + k] = c[k]; } }
            else {
#pragma unroll
                for (int k = 0; k < 8; ++k) xv[k] = 0.f; }
            const f32x4 w0 = *(const f32x4*)(cw + jj * DM + ch), w1 = *(const f32x4*)(cw + jj * DM + ch + 4);
#pragma unroll
            for (int k = 0; k < 4; ++k) { accv[k] += xv[k] * w0[k]; accv[4 + k] += xv[4 + k] * w1[k]; }
        }
        u32x4 w; w.x = cvt_pk_bf16(accv[0], accv[1]); w.y = cvt_pk_bf16(accv[2], accv[3]); w.z = cvt_pk_bf16(accv[4], accv[5]); w.w = cvt_pk_bf16(accv[6], accv[7]);
        *(u32x4*)(U + (size_t)row * DM + ch) = w;
        if (t >= T - 3) {
            const u32x4 vw = *(const u32x4*)(V + (size_t)row * DM + ch);
            float* dst = row < MP ? p.out + O_RCP + ((size_t)(row >> 12) * 3 + (t - (T - 3))) * DM + ch : p.out + O_RCS + ((size_t)((row - MP) >> 3) * 3 + (t - (T - 3))) * DM + ch;
            *(f32x4*)dst = (f32x4){bflo(vw.x), bfhi(vw.x), bflo(vw.y), bfhi(vw.y)}; *(f32x4*)(dst + 4) = (f32x4){bflo(vw.z), bfhi(vw.z), bflo(vw.w), bfhi(vw.w)};
        }
    }
}
__device__ __forceinline__ void rgscan_phase(const Params& p, LAS unsigned char* lds, int vcu, int G, const int tid) {
    const int lane = tid & 63, wave = tid >> 6;
    bf16_t* GATE = (bf16_t*)(p.ws + WS_S0); const bf16_t* LA = (const bf16_t*)(p.ws + WS_S1); const bf16_t* Bv = (const bf16_t*)(p.ws + WS_S2);
    LAS float* sm = (LAS float*)lds;
    for (int un = vcu; un < 256; un += G) {
        const int b = un >> 6, ch = (un & 63) * 16 + (lane & 15), chunk = wave * 4 + (lane >> 4);
        const size_t base = (size_t)(b * SEQ + chunk * 128) * DM + ch;
        float Ap = 0.f, Bp = 0.f;
        for (int t0 = 0; t0 < 128; t0 += 32) {
            unsigned short lv[32], bv_[32];
#pragma unroll
            for (int t = 0; t < 32; ++t) { lv[t] = LA[base + (size_t)(t0 + t) * DM]; bv_[t] = Bv[base + (size_t)(t0 + t) * DM]; }
#pragma unroll
            for (int t = 0; t < 32; ++t) { const float l2 = bf2f(lv[t]); Ap += l2; Bp = __builtin_amdgcn_exp2f(l2) * Bp + bf2f(bv_[t]); }
        }
        sm[(chunk * 16 + (lane & 15)) * 2] = __builtin_amdgcn_exp2f(Ap); sm[(chunk * 16 + (lane & 15)) * 2 + 1] = Bp;
        __syncthreads();
        float hcur = 0.f;
        for (int c = 0; c < chunk; ++c) hcur = sm[(c * 16 + (lane & 15)) * 2] * hcur + sm[(c * 16 + (lane & 15)) * 2 + 1];
        for (int t0 = 0; t0 < 128; t0 += 32) {
            unsigned short lv[32], bv_[32], gv_[32];
#pragma unroll
            for (int t = 0; t < 32; ++t) { lv[t] = LA[base + (size_t)(t0 + t) * DM]; bv_[t] = Bv[base + (size_t)(t0 + t) * DM]; gv_[t] = GATE[base + (size_t)(t0 + t) * DM]; }
#pragma unroll
            for (int t = 0; t < 32; ++t) { hcur = __builtin_amdgcn_exp2f(bf2f(lv[t])) * hcur + bf2f(bv_[t]); GATE[base + (size_t)(t0 + t) * DM] = (bf16_t)f2bf(hcur * bf2f(gv_[t])); }
        }
        if (chunk == 31) p.out[O_HP + (size_t)b * DM + ch] = hcur;
        __syncthreads();
    }
    const int gt = vcu * 512 + tid, NGT = G * 512;
    for (int e = gt; e < 128 * DM; e += NGT) {
        const int sq = e >> 10, ch = e & 1023; float hcur = p.in[4][e];
        const size_t base = (size_t)(MP + sq * 8) * DM + ch;
#pragma unroll
        for (int t = 0; t < 8; ++t) { const float l2 = bf2f(LA[base + (size_t)t * DM]); const float bb = bf2f(Bv[base + (size_t)t * DM]);
            hcur = __builtin_amdgcn_exp2f(l2) * hcur + bb; const float gt_ = bf2f(GATE[base + (size_t)t * DM]); GATE[base + (size_t)t * DM] = (bf16_t)f2bf(hcur * gt_); }
        p.out[O_HS + e] = hcur;
    }
}
__device__ __forceinline__ void scconv_phase(const Params& p, int vcu, int G, const int tid) {
    const int gt = vcu * 512 + tid, NGT = G * 512;
    const bf16_t* __restrict__ CX = (const bf16_t*)(p.ws + WS_S0); const bf16_t* __restrict__ BG = (const bf16_t*)(p.ws + WS_S1); bf16_t* __restrict__ YG = (bf16_t*)(p.ws + WS_S2);
    const float* __restrict__ cw = p.in[26]; const float* __restrict__ buf = p.in[6];
#pragma unroll 2
    for (int e = gt; e < M * 128; e += NGT) {
        const int row = e >> 7, ch = (e & 127) * 8;
        int t, T; const float* sb = nullptr;
        if (row < MP) { t = row & (SEQ - 1); T = SEQ; } else { t = (row - MP) & 7; T = 8; sb = buf + (size_t)((row - MP) >> 3) * 2 * DM; }
        float accv[8];
#pragma unroll
        for (int k = 0; k < 8; ++k) accv[k] = 0.f;
        u32x4 cur = (u32x4){0u, 0u, 0u, 0u};
#pragma unroll
        for (int jj = 0; jj < 3; ++jj) {
            const int tt = t - 2 + jj;
            float xv[8];
            if (tt >= 0) { const u32x4 w = *(const u32x4*)(CX + (size_t)(row - 2 + jj) * DM + ch); if (jj == 2) cur = w;
                xv[0] = bflo(w.x); xv[1] = bfhi(w.x); xv[2] = bflo(w.y); xv[3] = bfhi(w.y); xv[4] = bflo(w.z); xv[5] = bfhi(w.z); xv[6] = bflo(w.w); xv[7] = bfhi(w.w); }
            else if (sb) { const f32x4 a = *(const f32x4*)(sb + (size_t)(tt + 2) * DM + ch), c = *(const f32x4*)(sb + (size_t)(tt + 2) * DM + ch + 4);
#pragma unroll
                for (int k = 0; k < 4; ++k) { xv[k] = a[k]; xv[4 + k] = c[k]; } }
            else {
#pragma unroll
                for (int k = 0; k < 8; ++k) xv[k] = 0.f; }
            const f32x4 w0 = *(const f32x4*)(cw + jj * DM + ch), w1 = *(const f32x4*)(cw + jj * DM + ch + 4);
#pragma unroll
            for (int k = 0; k < 4; ++k) { accv[k] += xv[k] * w0[k]; accv[4 + k] += xv[4 + k] * w1[k]; }
        }
        const u32x4 g = *(const u32x4*)(BG + (size_t)row * DM + ch);
        u32x4 w; w.x = cvt_pk_bf16(accv[0] * bflo(g.x), accv[1] * bfhi(g.x)); w.y = cvt_pk_bf16(accv[2] * bflo(g.y), accv[3] * bfhi(g.y));
        w.z = cvt_pk_bf16(accv[4] * bflo(g.z), accv[5] * bfhi(g.z)); w.w = cvt_pk_bf16(accv[6] * bflo(g.w), accv[7] * bfhi(g.w));
        *(u32x4*)(YG + (size_t)row * DM + ch) = w;
        if (t >= T - 2) {
            float* dst = row < MP ? p.out + O_SCP + ((size_t)(row >> 12) * 2 + (t - (T - 2))) * DM + ch : p.out + O_SCS + ((size_t)((row - MP) >> 3) * 2 + (t - (T - 2))) * DM + ch;
            *(f32x4*)dst = (f32x4){bflo(cur.x), bfhi(cur.x), bflo(cur.y), bfhi(cur.y)}; *(f32x4*)(dst + 4) = (f32x4){bflo(cur.z), bfhi(cur.z), bflo(cur.w), bfhi(cur.w)};
        }
    }
}

#define XB_TMO      128
#define XB_XCNT(j)  (256  + 64 * (j))
#define XB_XSUB(j)  (1280 + 64 * (j))
#define XB_XGEN(j)  (2304 + 64 * (j))
#define XB_TOP      3328
#define XB_TOPGEN   3392
#define XCD_BAR_WORDS 3456
#define XB_SPIN_CAP (1u << 18)
__device__ __forceinline__ unsigned xb_ld(unsigned* p)              { return __hip_atomic_load(p, __ATOMIC_RELAXED, __HIP_MEMORY_SCOPE_AGENT); }
__device__ __forceinline__ unsigned xb_add(unsigned* p, unsigned v) { return __hip_atomic_fetch_add(p, v, __ATOMIC_RELAXED, __HIP_MEMORY_SCOPE_AGENT); }
__device__ __forceinline__ unsigned xb_xcc_id() { return (unsigned)__builtin_amdgcn_s_getreg((3 << 11) | 20) & 0xFu; }
#define XB_SPIN(cond, bar) do { unsigned _sp = 0; while (cond) { __builtin_amdgcn_s_sleep(1); \
    if ((++_sp & 255u) == 0u) { if (xb_ld(&(bar)[XB_TMO])) break; if (_sp > XB_SPIN_CAP) { atomicAdd(&(bar)[XB_TMO], 1u); break; } } } } while (0)
struct XcdBarrier { unsigned* bar; unsigned x; volatile LAS unsigned* st; };
__device__ __forceinline__ XcdBarrier xcd_barrier_post(unsigned* bar, volatile LAS unsigned* st) {
    XcdBarrier b; b.bar = bar; b.x = xb_xcc_id(); b.st = st;
    if (threadIdx.x == 0) (void)xb_add(&bar[XB_XCNT(b.x)], 1u);
    return b;
}
__device__ __forceinline__ void xcd_barrier_complete(unsigned* bar, unsigned x, unsigned& nloc, unsigned& nx) {
    const unsigned G = gridDim.x * gridDim.y * gridDim.z;
    unsigned sum, cnt, mine, sp = 0u;
    for (;;) {
        sum = 0u; cnt = 0u; mine = 0u;
#pragma unroll
        for (unsigned j = 0; j < 16; ++j) { const unsigned c = xb_ld(&bar[XB_XCNT(j)]); sum += c; cnt += (c > 0u) ? 1u : 0u; mine = (j == x) ? c : mine; }
        if (sum == G) break;
        __builtin_amdgcn_s_sleep(1);
        if ((++sp & 255u) == 0u) { if (xb_ld(&bar[XB_TMO])) break; if (sp > XB_SPIN_CAP) { atomicAdd(&bar[XB_TMO], 1u); break; } }
    }
    nloc = mine > 0u ? mine : 1u; nx = cnt > 0u ? cnt : 1u;
}
__device__ __forceinline__ void xcd_barrier(const XcdBarrier& b) {
    asm volatile("s_waitcnt vmcnt(0)" ::: "memory");
    __syncthreads();
    if (threadIdx.x == 0) {
        unsigned* bar = b.bar;
        __builtin_amdgcn_s_waitcnt(0);
        unsigned nloc = b.st[0], nx = b.st[1];
        if (nloc == 0u) { xcd_barrier_complete(bar, b.x, nloc, nx); b.st[0] = nloc; b.st[1] = nx; }
        const unsigned old = xb_add(&bar[XB_XSUB(b.x)], 1u);
        const unsigned gen = old / nloc;
        if (old + 1u == (gen + 1u) * nloc) {
            __builtin_amdgcn_fence(__ATOMIC_RELEASE, "agent");
            asm volatile("s_waitcnt vmcnt(0)" ::: "memory");
            const unsigned og = xb_add(&bar[XB_TOP], 1u);
            const unsigned tg = og / nx;
            if (og + 1u == (tg + 1u) * nx) xb_add(&bar[XB_TOPGEN], 1u);
            else XB_SPIN(xb_ld(&bar[XB_TOPGEN]) == tg, bar);
            __builtin_amdgcn_fence(__ATOMIC_ACQUIRE, "agent");
            xb_add(&bar[XB_XGEN(b.x)], 1u);
            asm volatile("s_waitcnt vmcnt(0)" ::: "memory");
        } else {
            XB_SPIN(xb_ld(&bar[XB_XGEN(b.x)]) == gen, bar);
            __builtin_amdgcn_fence(__ATOMIC_ACQUIRE, "agent");
            asm volatile("s_waitcnt vmcnt(0)" ::: "memory");
        }
    }
    __syncthreads();
}

enum Op { OP_PREP, OP_QKV, OP_ATTN, OP_RG1, OP_RGCONV, OP_RGGATES, OP_RGSCAN, OP_SC1, OP_SCCONV, OP_RESID_MIX, OP_NORM_F, OP_FFNUP, OP_RESID_FFN, OP_NORM_M };
constexpr int NSTEPS = 31;

__global__ void __launch_bounds__(512, 2) mega_fwd(Params p) {
    extern __shared__ __attribute__((aligned(16))) unsigned char lds_raw[];
    LAS unsigned char* lds = (LAS unsigned char*)lds_raw;
    const int G0 = gridDim.x, bx = blockIdx.x;
    volatile LAS unsigned* MISC = (volatile LAS unsigned*)(lds + 131072);
    if (threadIdx.x < 32) MISC[threadIdx.x] = 0u;
    __syncthreads();
    XcdBarrier bar = xcd_barrier_post((unsigned*)p.ws, MISC + 8);
    const int vcu0 = (G0 % 8 == 0) ? (bx % 8) * (G0 / 8) + bx / 8 : bx;
#if REP_MASK
    for (int it_ = 2 * p.ph_lo; it_ < 2 * p.ph_hi; ++it_) { const int step = it_ >> 1;
#else
    for (int step = p.ph_lo; step < p.ph_hi; ++step) {
#endif
        int tid = threadIdx.x, G = G0, vcu = vcu0; unsigned char* ws = p.ws; float* X = p.out;
        asm volatile("" : "+v"(tid)); asm volatile("" : "+s"(G)); asm volatile("" : "+s"(vcu)); asm volatile("" : "+s"(ws)); asm volatile("" : "+s"(X));
        bf16_t* XN = (bf16_t*)(ws + WS_XN);
        float* PART = (float*)(ws + WS_S3);
        int op, layer = 0;
        if (step == 0) op = OP_PREP;
        else {
            int s = step - 1, li;
            if (s < 7) { layer = 0; li = s; } else if (s < 16) { layer = 1; li = s - 7; } else if (s < 23) { layer = 2; li = s - 16; } else { layer = 3; li = s - 23; }
            const int kind = layer % 3, nmix = kind == 1 ? 4 : 2;
            if (li < nmix) op = kind == 0 ? (li == 0 ? OP_QKV : OP_ATTN) : kind == 1 ? (OP_RG1 + li) : (li == 0 ? OP_SC1 : OP_SCCONV);
            else op = OP_RESID_MIX + (li - nmix);
        }
        const int kind = layer % 3, j = layer / 3;
#if REP_MASK
        if ((it_ & 1) && !((REP_MASK >> op) & 1)) continue;
#endif
        pg8::GSched S; S.G = G; S.c = vcu; S.c2 = (int)blockIdx.x; S.mode = 0; S.nsplit = NSPLIT_MIX; S.lda = DM; S.ldb = DM; S.nt = 16; S.A = (const char*)XN;
        switch (op) {
        case OP_PREP: prep_phase(p, lds, vcu, G, tid); break;
        case OP_QKV: { S.Bt = (const char*)(ws + WS_WQKV + (size_t)j * NQKV * 1024 * 2); S.nN = 5;
            pg8::EpiQKV E{(bf16_t*)(ws + WS_S0), p.in[11] + j * NQKV, (const float*)(ws + WS_ROPE), (const float*)(ws + WS_RSTD)};
            pg8::gemm_phase<DM, DM>(lds, S, E, tid);
            if (layer == 0) convert_in_slack(p, ws, lds, 1, 68 * 5, vcu, G, tid); } break;
        case OP_ATTN: attn_phase(p, lds, j, vcu, G, tid); break;
        case OP_RG1: { S.Bt = (const char*)(ws + WS_WRG1); S.nN = 8;
            pg8::EpiPair<1> E{(bf16_t*)(ws + WS_S0), (bf16_t*)(ws + WS_S1), (const float*)(ws + WS_RSTD)};
            pg8::gemm_phase<DM, DM>(lds, S, E, tid);
            convert_in_slack(p, ws, lds, 2, 68 * 8, vcu, G, tid); } break;
        case OP_RGCONV: rgconv_phase(p, vcu, G, tid); break;
        case OP_RGGATES: { S.A = (const char*)(ws + WS_S3); S.Bt = (const char*)(ws + WS_WRG2); S.ldb = 256; S.nN = 8; S.nt = 4; S.mode = 2;
            pg8::EpiRgGates E{(const bf16_t*)(ws + WS_S3), (bf16_t*)(ws + WS_S1), (bf16_t*)(ws + WS_S2), p.in[20], p.in[22], (const float*)(ws + WS_C8)};
            pg8::gemm_phase<DM, 256>(lds, S, E, tid);
            convert_in_slack(p, ws, lds, 3, 68 * 8, vcu, G, tid); } break;
        case OP_RGSCAN: rgscan_phase(p, lds, vcu, G, tid); break;
        case OP_SC1: { S.Bt = (const char*)(ws + WS_WSC1); S.nN = 12;
            pg8::EpiPair<2> E{(bf16_t*)(ws + WS_S0), (bf16_t*)(ws + WS_S1), (const float*)(ws + WS_RSTD)};
            pg8::gemm_phase<DM, DM>(lds, S, E, tid);
            convert_in_slack(p, ws, lds, 4, 68 * 12, vcu, G, tid); } break;
        case OP_SCCONV: scconv_phase(p, vcu, G, tid); break;
        case OP_RESID_MIX: {
            const float* bias = (const float*)(ws + WS_ZB); S.nN = 4; S.mode = 1;
            if (kind == 0) { S.A = (const char*)(ws + WS_S2); S.Bt = (const char*)(ws + WS_WO + (size_t)j * 1024 * 1024 * 2); bias = p.in[13] + j * DM; }
            else if (kind == 1) { S.A = (const char*)(ws + WS_S0); S.Bt = (const char*)(ws + WS_WRG3); }
            else { S.A = (const char*)(ws + WS_S2); S.Bt = (const char*)(ws + WS_WSC2); }
            if (layer == 0) { pg8::EpiResid<true> E{p.in[0], PART, bias, XN, (float*)(ws + WS_SS)}; pg8::gemm_phase<DM, DM>(lds, S, E, tid); }
            else { pg8::EpiResid<false> E{nullptr, PART, bias, XN, (float*)(ws + WS_SS)}; pg8::gemm_phase<DM, DM>(lds, S, E, tid); }
            } break;
        case OP_RESID_FFN: {
            S.nN = 4; S.mode = 1; S.nsplit = NSPLIT_FFN; S.A = (const char*)(ws + WS_S0); S.lda = DFF; S.ldb = DFF; S.nt = 44; S.Bt = (const char*)(ws + WS_WFD + (size_t)layer * 1024 * DFF * 2);
            pg8::EpiResid<false> E{nullptr, PART, (const float*)(ws + WS_ZB), XN, (float*)(ws + WS_SS)};
            pg8::gemm_phase<DFF, DFF>(lds, S, E, tid); } break;
        case OP_NORM_F: fin_phase(layer == 0 ? p.in[1] : X + (size_t)MP * DM, X, PART, NSPLIT_MIX, kind == 0 ? p.in[13] + j * DM : nullptr, XN, (const float*)(ws + WS_SS), (float*)(ws + WS_RSTD), vcu, G, tid); break;
        case OP_FFNUP: { S.Bt = (const char*)(ws + WS_WFU + (size_t)layer * 5632 * 1024 * 2); S.nN = 22;
            pg8::EpiPair<0> E{(bf16_t*)(ws + WS_S0), nullptr, (const float*)(ws + WS_RSTD)};
            pg8::gemm_phase<DM, DM>(lds, S, E, tid); } break;
        case OP_NORM_M: if (layer == 3) norm_phase(X, PART, NSPLIT_FFN, nullptr, p.in[9], XN, true, vcu, G, tid);
                        else fin_phase(X + (size_t)MP * DM, X, PART, NSPLIT_FFN, nullptr, XN, (const float*)(ws + WS_SS), (float*)(ws + WS_RSTD), vcu, G, tid);
                        break;
        }
#if REP_MASK
        xcd_barrier(bar);
#else
        if (step + 1 < p.ph_hi) xcd_barrier(bar);
#endif
#if EXTRA_SYNC
        xcd_barrier(bar);
#endif
    }
}

#ifndef MK_N_LAUNCHES
#define MK_N_LAUNCHES 1
#endif
extern "C" void kernel_launch(void* const* d_in, const int* in_sizes, int n_in, void* d_out, int out_size, void* d_ws, size_t ws_size, hipStream_t stream) {
    static int grid = 0;
    if (grid == 0) {
        int dev = 0, cus = 0, per_cu = 0;
        hipGetDevice(&dev);
        hipDeviceGetAttribute(&cus, hipDeviceAttributeMultiprocessorCount, dev);
        hipFuncSetAttribute((const void*)mega_fwd, hipFuncAttributeMaxDynamicSharedMemorySize, LDS_BYTES);
        hipOccupancyMaxActiveBlocksPerMultiprocessor(&per_cu, (const void*)mega_fwd, 512, LDS_BYTES);
        if (per_cu < 1) { fprintf(stderr, "kernel_launch: occupancy query reports %d blocks per CU\n", per_cu); per_cu = 1; }
        if (per_cu > 1) per_cu = 1;
        grid = cus * per_cu;
        if (n_in != 31 || ws_size < 268 * MiB) fprintf(stderr, "kernel_launch: unexpected n_in %d / ws_size %zu\n", n_in, ws_size);
    }
    hipMemsetAsync(d_ws, 0, 16384, stream);
    Params p{};
    for (int i = 0; i < 31; ++i) p.in[i] = (const float*)d_in[i];
    p.out = (float*)d_out; p.ws = (unsigned char*)d_ws;
    const int nl = MK_N_LAUNCHES;
    for (int li = 0; li < nl; ++li) {
        p.ph_lo = (int)((long)NSTEPS * li / nl); p.ph_hi = (int)((long)NSTEPS * (li + 1) / nl);
        void* args[] = {&p};
        hipError_t e = hipLaunchCooperativeKernel((const void*)mega_fwd, dim3(grid), dim3(512), args, LDS_BYTES, stream);
        if (e != hipSuccess) fprintf(stderr, "cooperative launch failed: %s (grid %d)\n", hipGetErrorString(e), grid);
    }
}
```

```cpp
#include <hip/hip_runtime.h>
#include <hip/hip_cooperative_groups.h>
#include <cstdint>
#include <cstdio>
namespace cg = cooperative_groups;
#ifndef REP_MASK
#define REP_MASK 0
#endif
constexpr int NSPLIT_MIX = 4, NSPLIT_FFN = 8;
#ifndef EXTRA_SYNC
#define EXTRA_SYNC 0
#endif

#define LAS __attribute__((address_space(3)))
typedef unsigned short bf16_t;
typedef short bf16x8 __attribute__((ext_vector_type(8)));
typedef short s16x4 __attribute__((ext_vector_type(4)));
typedef float f32x4 __attribute__((ext_vector_type(4)));
typedef float f32x2 __attribute__((ext_vector_type(2)));
typedef float f32x16 __attribute__((ext_vector_type(16)));
typedef unsigned u32x4 __attribute__((ext_vector_type(4)));
typedef unsigned u32x2 __attribute__((ext_vector_type(2)));

constexpr int DM = 1024, MP = 16384, MS = 1024, M = MP + MS, SEQ = 4096, DFF = 2816, NQKV = 1280;
constexpr float EPS = 1e-6f, LOG2E = 1.4426950408889634f;
constexpr size_t MiB = 1u << 20;
constexpr size_t WS_ROPE = 1 * MiB;
constexpr size_t WS_RSTD = 4 * MiB;
constexpr size_t WS_SS = 5 * MiB;
constexpr size_t WS_ZB = 3 * MiB + 65536;
constexpr size_t WS_C8 = 3 * MiB;
constexpr size_t WS_WQKV = 8 * MiB;
constexpr size_t WS_WO = 13 * MiB;
constexpr size_t WS_WFU = 17 * MiB;
constexpr size_t WS_WFD = 61 * MiB;
constexpr size_t WS_WRG1 = 83 * MiB, WS_WRG2 = 87 * MiB, WS_WRG3 = 88 * MiB, WS_WSC1 = 90 * MiB, WS_WSC2 = 96 * MiB;
constexpr size_t WS_XN = 98 * MiB;
constexpr size_t SLOT = 34 * MiB;
constexpr size_t WS_S0 = 132 * MiB, WS_S1 = WS_S0 + SLOT, WS_S2 = WS_S1 + SLOT, WS_S3 = WS_S2 + SLOT;
constexpr size_t O_KP = 17825792, O_VP = 17956864, O_KS = 18087936, O_VS = 22282240, O_HP = 26476544, O_HS = 26480640,
                 O_RCP = 26611712, O_RCS = 26624000, O_SCP = 27017216, O_SCS = 27025408;

constexpr int LDS_BYTES = 131072 + 1024;

__device__ __forceinline__ unsigned cvt_pk_bf16(float lo, float hi) { unsigned r; asm volatile("v_cvt_pk_bf16_f32 %0, %1, %2" : "=v"(r) : "v"(lo), "v"(hi)); return r; }
__device__ __forceinline__ float bf2f(unsigned short v) { return __uint_as_float(((unsigned)v) << 16); }
__device__ __forceinline__ float bflo(unsigned w) { return __uint_as_float(w << 16); }
__device__ __forceinline__ float bfhi(unsigned w) { return __uint_as_float(w & 0xffff0000u); }
__device__ __forceinline__ float fast_sigmoid(float x) { return __builtin_amdgcn_rcpf(1.0f + __builtin_amdgcn_exp2f(-x * LOG2E)); }
__device__ __forceinline__ float wave_sum(float v) {
#pragma unroll
    for (int o = 1; o < 64; o <<= 1) v += __shfl_xor(v, o);
    return v;
}

namespace pg8 {
constexpr int BM = 256, BK = 64, HALF = 128, HTB = HALF * BK * 2, STAGE_BYTES = 8 * HTB;
__device__ __forceinline__ int lds_byte(int r, int c) { const int st = (r >> 4) * 2 + (c >> 5), rr = r & 15, cc = c & 31, ob = rr * 64 + cc * 2; return st * 1024 + (ob ^ (((ob >> 9) & 1) << 5)); }
__device__ __forceinline__ void stage_rc(int b, int& R, int& C) { const int st = b / 1024, sb = b % 1024, swz = sb ^ (((sb >> 9) & 1) << 5); R = (st >> 1) * 16 + swz / 64; C = (st & 1) * 32 + (swz % 64) / 2; }
__device__ __forceinline__ int perm32(int rho) { const int n = rho >> 4, i = rho & 15; return 8 * (i >> 2) + 4 * n + (i & 3); }

struct Unit { int pm, pn, nt, aux; const char* a; const char* b; };

struct GSched {
    const char* A; const char* Bt; int lda, ldb, nN, nt, mode, G, c, nsplit, c2;
    __device__ __forceinline__ bool next(int i, Unit& u) const {
        int L = i * G + c; const int nP = 64 * nN; int kt0 = 0; u.nt = nt; u.aux = 0;
        if (mode == 1) {
            const int nS = 4 * nsplit * nN;
            const bool hasS = (nS <= G) && (c2 < nS);
            if (nS <= G) {
                if (hasS && i == 0) L = c2; else L = nS + (i - (hasS ? 1 : 0)) * G + c;
            }
            if (L < nS) {
                const int sl = L % nsplit; u.pn = (L / nsplit) % nN; u.pm = 64 + (L / nsplit) / nN; u.aux = 1 + sl;
                const int q = (nt / (2 * nsplit)) * 2, extra = (nt - nsplit * q) >> 1;
                u.nt = sl < extra ? q + 2 : q; kt0 = sl < extra ? sl * (q + 2) : extra * (q + 2) + (sl - extra) * q;
            } else {
                L -= nS; if (L >= nP) return false;
                const int g = L / (8 * nN), r = L - g * 8 * nN; u.pm = 8 * g + (r & 7); u.pn = r >> 3;
            }
        } else if (L < nP) { const int g = L / (8 * nN), r = L - g * 8 * nN; u.pm = 8 * g + (r & 7); u.pn = r >> 3; }
        else { L -= nP; if (L >= 4 * nN) return false; u.pm = 64 + (L & 3); u.pn = L >> 2; }
        u.a = A + ((size_t)u.pm * 256 * lda + (size_t)kt0 * 64 + (mode == 2 ? 256 * (u.pn >> 1) : 0)) * 2;
        u.b = Bt + ((size_t)u.pn * 256 * ldb + (size_t)kt0 * 64) * 2;
        return true;
    }
};

template <int LDA, int LDB, class Epi>
__device__ __forceinline__ void gemm_phase(LAS unsigned char* lds, const GSched& S, const Epi& E, const int tid) {
    const int wid = __builtin_amdgcn_readfirstlane(tid >> 6), lane = tid & 63, wr = wid >> 2, wc = wid & 3, fr = lane & 15, fq = lane >> 4;
    constexpr int lda = LDA, ldb = LDB;
    unsigned voffA[2], voffB[2];
#pragma unroll
    for (int i = 0; i < 2; ++i) { int R, C; stage_rc(tid * 16 + i * 8192, R, C); const int Rb = Epi::PERM ? ((R & ~31) + perm32(R & 31)) : R;
        voffA[i] = (unsigned)(R * lda + C) * 2u; voffB[i] = (unsigned)(Rb * ldb + C) * 2u; }
    const size_t kstep = (size_t)(BK * 2);
    const size_t hstepA = (size_t)HALF * lda * 2, hstepB = (size_t)HALF * ldb * 2;
    const unsigned ldsw = (unsigned)wid * 1024u;
    const int aoff = lds_byte(wr * 64 + fr, fq * 8), boff = lds_byte(wc * 32 + fr, fq * 8);
#define PG8_SA(b, h) (((b) * 2 + (h)) * HTB)
#define PG8_SB(b, h) ((4 + (b) * 2 + (h)) * HTB)
#define PG8_STAGE(bufoff, gbase, voff) do { _Pragma("unroll") for (int _i = 0; _i < 2; ++_i) \
        __builtin_amdgcn_global_load_lds((const unsigned*)((const char*)(gbase) + (voff)[_i]), (LAS unsigned*)(lds + (bufoff) + ldsw + _i * 8192), 16, 0, 0); } while (0)
#define PG8_LDA(dst, b, h) do { _Pragma("unroll") for (int m = 0; m < 4; ++m) _Pragma("unroll") for (int k = 0; k < 2; ++k) dst[m][k] = *(const LAS bf16x8*)(lds + PG8_SA(b, h) + aoff + m * 2048 + k * 1024); } while (0)
#define PG8_LDB(dst, b, h) do { _Pragma("unroll") for (int n = 0; n < 2; ++n) _Pragma("unroll") for (int k = 0; k < 2; ++k) dst[n][k] = *(const LAS bf16x8*)(lds + PG8_SB(b, h) + boff + n * 2048 + k * 1024); } while (0)
#define PG8_MMA(ai, bj, At, Bt) do { __builtin_amdgcn_s_setprio(1); _Pragma("unroll") for (int m = 0; m < 4; ++m) _Pragma("unroll") for (int n = 0; n < 2; ++n) _Pragma("unroll") for (int k = 0; k < 2; ++k) \
        acc[ai][bj][m][n] = __builtin_amdgcn_mfma_f32_16x16x32_bf16(Bt[n][k], At[m][k], acc[ai][bj][m][n], 0, 0, 0); __builtin_amdgcn_s_setprio(0); } while (0)
#define PG8_WAIT_V(n) asm volatile("s_waitcnt vmcnt(" #n ")" ::: "memory")
#define PG8_WAIT_L(n) asm volatile("s_waitcnt lgkmcnt(" #n ")" ::: "memory")
#define PG8_BAR __builtin_amdgcn_s_barrier()
#define PG8_SCHED __builtin_amdgcn_sched_barrier(0)
    Unit cur, nxt; int ui = 0;
    if (!S.next(0, cur)) return;
    f32x4 acc[2][2][4][2];
#pragma unroll
    for (int a = 0; a < 2; ++a)
#pragma unroll
        for (int b = 0; b < 2; ++b)
#pragma unroll
            for (int m = 0; m < 4; ++m)
#pragma unroll
                for (int n = 0; n < 2; ++n) acc[a][b][m][n] = (f32x4){0.f, 0.f, 0.f, 0.f};
    bf16x8 At[4][2], B0[2][2], B1[2][2];
    const char* cA = cur.a; const char* cB = cur.b;
    PG8_STAGE(PG8_SB(0, 0), cB, voffB); PG8_STAGE(PG8_SB(0, 1), cB + hstepB, voffB); PG8_STAGE(PG8_SA(0, 0), cA, voffA); PG8_STAGE(PG8_SA(0, 1), cA + hstepA, voffA);
    if (wr == 1) PG8_BAR;
    PG8_WAIT_V(2); PG8_BAR;
    PG8_STAGE(PG8_SB(1, 0), cB + kstep, voffB); PG8_STAGE(PG8_SA(1, 0), cA + kstep, voffA); PG8_STAGE(PG8_SB(1, 1), cB + hstepB + kstep, voffB);
    PG8_WAIT_V(6); PG8_BAR;
    for (;;) {
        const bool has_next = S.next(ui + 1, nxt);
        const char* nA = has_next ? nxt.a : cA; const char* nB = has_next ? nxt.b : cB;
        const int nt = cur.nt;
        for (int t = 0; t < nt; t += 2) {
            const bool last = (t == nt - 2);
            const char* a1 = cA + (size_t)(t + 1) * kstep;
            const char* a2 = last ? nA : cA + (size_t)(t + 2) * kstep; const char* b2 = last ? nB : cB + (size_t)(t + 2) * kstep;
            const char* a3 = a2 + kstep; const char* b3 = b2 + kstep;
            PG8_LDB(B0, 0, 0); PG8_LDB(B1, 0, 1); PG8_SCHED; PG8_LDA(At, 0, 0); PG8_STAGE(PG8_SA(1, 1), a1 + hstepA, voffA);
            PG8_WAIT_V(8); PG8_WAIT_L(0); PG8_BAR; PG8_MMA(0, 0, At, B0); PG8_MMA(0, 1, At, B1); PG8_BAR; PG8_SCHED;
            PG8_LDA(At, 0, 1); PG8_STAGE(PG8_SB(0, 0), b2, voffB); PG8_STAGE(PG8_SB(0, 1), b2 + hstepB, voffB); PG8_STAGE(PG8_SA(0, 0), a2, voffA);
            PG8_WAIT_V(8); PG8_WAIT_L(0); PG8_BAR; PG8_MMA(1, 0, At, B0); PG8_MMA(1, 1, At, B1); PG8_BAR; PG8_SCHED;
            PG8_LDB(B0, 1, 0); PG8_LDB(B1, 1, 1); PG8_SCHED; PG8_LDA(At, 1, 0); PG8_STAGE(PG8_SA(0, 1), a2 + hstepA, voffA);
            PG8_WAIT_V(8); PG8_WAIT_L(0); PG8_BAR; PG8_MMA(0, 0, At, B0); PG8_MMA(0, 1, At, B1); PG8_BAR; PG8_SCHED;
            PG8_LDA(At, 1, 1); PG8_STAGE(PG8_SB(1, 0), b3, voffB); PG8_STAGE(PG8_SB(1, 1), b3 + hstepB, voffB); PG8_STAGE(PG8_SA(1, 0), a3, voffA);
            PG8_WAIT_V(8); PG8_WAIT_L(0); PG8_BAR; PG8_MMA(1, 0, At, B0); PG8_MMA(1, 1, At, B1); PG8_BAR; PG8_SCHED;
        }
        if (wr == 0) PG8_BAR;
        E(acc, cur, wr, wc, fr, fq);
        if (!has_next) break;
#pragma unroll
        for (int a = 0; a < 2; ++a)
#pragma unroll
            for (int b = 0; b < 2; ++b)
#pragma unroll
                for (int m = 0; m < 4; ++m)
#pragma unroll
                    for (int n = 0; n < 2; ++n) acc[a][b][m][n] = (f32x4){0.f, 0.f, 0.f, 0.f};
        cur = nxt; cA = nA; cB = nB; ++ui;
        if (wr == 1) PG8_BAR;
    }
    PG8_WAIT_V(0);
    PG8_BAR;
#undef PG8_SA
#undef PG8_SB
#undef PG8_STAGE
#undef PG8_LDA
#undef PG8_LDB
#undef PG8_MMA
#undef PG8_WAIT_V
#undef PG8_WAIT_L
#undef PG8_BAR
#undef PG8_SCHED
}

struct EpiQKV {
    static constexpr bool PERM = true;
    bf16_t* O; const float* bias; const float* rope; const float* rstd;
    __device__ __forceinline__ void operator()(const f32x4 (&acc)[2][2][4][2], const Unit& u, int wr, int wc, int fr, int fq) const {
        const int H = 4 * u.pn + wc, colb = H * 64 + 8 * fq;
        const f32x4 bl0 = *(const f32x4*)(bias + colb), bl1 = *(const f32x4*)(bias + colb + 4), bh0 = *(const f32x4*)(bias + colb + 32), bh1 = *(const f32x4*)(bias + colb + 36);
        const bool rot = H < 18;
        const int row0 = u.pm * 256 + wr * 64 + fr;
        float rs[8];
#pragma unroll
        for (int g = 0; g < 8; ++g) rs[g] = rstd[row0 + (g >> 2) * 128 + (g & 3) * 16];
        f32x4 cs[2][4];
#define QKV_LOADCS(g, b) do { const int row_ = row0 + ((g) >> 2) * 128 + ((g) & 3) * 16; const int pidx_ = row_ < MP ? (row_ & (SEQ - 1)) : SEQ + ((row_ - MP) & 7); \
            const float* rp_ = rope + (size_t)pidx_ * 64 + 8 * fq; cs[b][0] = *(const f32x4*)(rp_); cs[b][1] = *(const f32x4*)(rp_ + 4); cs[b][2] = *(const f32x4*)(rp_ + 32); cs[b][3] = *(const f32x4*)(rp_ + 36); } while (0)
        QKV_LOADCS(0, 0);
#pragma unroll
        for (int g = 0; g < 8; ++g) {
            const int ai = g >> 2, m = g & 3, b = g & 1;
            if (g + 1 < 8) QKV_LOADCS(g + 1, b ^ 1);
            const int row = row0 + ai * 128 + m * 16;
            f32x4 c0 = cs[b][0], c1 = cs[b][1], s0 = cs[b][2], s1 = cs[b][3];
            if (!rot) { c0 = (f32x4){1.f, 1.f, 1.f, 1.f}; c1 = c0; s0 = (f32x4){0.f, 0.f, 0.f, 0.f}; s1 = s0; }
            const float r = rs[g];
            const f32x4 l0 = acc[ai][0][m][0] * r + bl0, l1 = acc[ai][0][m][1] * r + bl1, h0 = acc[ai][1][m][0] * r + bh0, h1 = acc[ai][1][m][1] * r + bh1;
            const f32x4 ol0 = l0 * c0 - h0 * s0, ol1 = l1 * c1 - h1 * s1, oh0 = h0 * c0 + l0 * s0, oh1 = h1 * c1 + l1 * s1;
            bf16_t* op = O + (size_t)row * NQKV + colb;
            u32x4 w; w.x = cvt_pk_bf16(ol0[0], ol0[1]); w.y = cvt_pk_bf16(ol0[2], ol0[3]); w.z = cvt_pk_bf16(ol1[0], ol1[1]); w.w = cvt_pk_bf16(ol1[2], ol1[3]);
            *(u32x4*)op = w;
            w.x = cvt_pk_bf16(oh0[0], oh0[1]); w.y = cvt_pk_bf16(oh0[2], oh0[3]); w.z = cvt_pk_bf16(oh1[0], oh1[1]); w.w = cvt_pk_bf16(oh1[2], oh1[3]);
            *(u32x4*)(op + 32) = w;
        }
#undef QKV_LOADCS
    }
};
template <int MODE> struct EpiPair {
    static constexpr bool PERM = true;
    bf16_t* O0; bf16_t* O1; const float* rstd;
    __device__ __forceinline__ void operator()(const f32x4 (&acc)[2][2][4][2], const Unit& u, int wr, int wc, int fr, int fq) const {
        const int cc = 32 * wc + 8 * fq;
        float rsv[8];
#pragma unroll
        for (int g = 0; g < 8; ++g) rsv[g] = rstd[u.pm * 256 + wr * 64 + fr + (g >> 2) * 128 + (g & 3) * 16];
#pragma unroll
        for (int ai = 0; ai < 2; ++ai)
#pragma unroll
            for (int m = 0; m < 4; ++m) {
                const size_t row = (size_t)(u.pm * 256 + ai * 128 + wr * 64 + m * 16 + fr);
                const float rs = rsv[ai * 4 + m];
                f32x4 p0 = acc[ai][0][m][0] * rs, p1 = acc[ai][0][m][1] * rs, q0 = acc[ai][1][m][0] * rs, q1 = acc[ai][1][m][1] * rs;
                u32x4 w;
                if (MODE == 0) {
                    const float c1 = -rs * LOG2E, c2 = rs * rs;
                    const f32x4 a0 = acc[ai][0][m][0], a1 = acc[ai][0][m][1], b0 = acc[ai][1][m][0], b1 = acc[ai][1][m][1];
                    f32x4 t0 = a0 * c1, t1 = a1 * c1;
#pragma unroll
                    for (int j = 0; j < 4; ++j) { t0[j] = __builtin_amdgcn_exp2f(t0[j]); t1[j] = __builtin_amdgcn_exp2f(t1[j]); }
                    t0 = t0 + 1.0f; t1 = t1 + 1.0f;
#pragma unroll
                    for (int j = 0; j < 4; ++j) { t0[j] = __builtin_amdgcn_rcpf(t0[j]); t1[j] = __builtin_amdgcn_rcpf(t1[j]); }
                    p0 = (a0 * b0) * c2 * t0; p1 = (a1 * b1) * c2 * t1;
                    w.x = cvt_pk_bf16(p0[0], p0[1]); w.y = cvt_pk_bf16(p0[2], p0[3]); w.z = cvt_pk_bf16(p1[0], p1[1]); w.w = cvt_pk_bf16(p1[2], p1[3]);
                    *(u32x4*)(O0 + row * DFF + 128 * u.pn + cc) = w;
                } else if (MODE == 1) {
#pragma unroll
                    for (int j = 0; j < 4; ++j) { float x = p0[j]; p0[j] = x * fast_sigmoid(1.5957691216f * (x + 0.044715f * x * x * x)); x = p1[j]; p1[j] = x * fast_sigmoid(1.5957691216f * (x + 0.044715f * x * x * x)); }
                    w.x = cvt_pk_bf16(p0[0], p0[1]); w.y = cvt_pk_bf16(p0[2], p0[3]); w.z = cvt_pk_bf16(p1[0], p1[1]); w.w = cvt_pk_bf16(p1[2], p1[3]);
                    *(u32x4*)(O0 + row * DM + 128 * u.pn + cc) = w;
                    w.x = cvt_pk_bf16(q0[0], q0[1]); w.y = cvt_pk_bf16(q0[2], q0[3]); w.z = cvt_pk_bf16(q1[0], q1[1]); w.w = cvt_pk_bf16(q1[2], q1[3]);
                    *(u32x4*)(O1 + row * DM + 128 * u.pn + cc) = w;
                } else {
                    if (u.pn < 8) {
                        p0 = p0 * q0; p1 = p1 * q1;
                        w.x = cvt_pk_bf16(p0[0], p0[1]); w.y = cvt_pk_bf16(p0[2], p0[3]); w.z = cvt_pk_bf16(p1[0], p1[1]); w.w = cvt_pk_bf16(p1[2], p1[3]);
                        *(u32x4*)(O0 + row * DM + 128 * u.pn + cc) = w;
                    } else {
                        w.x = cvt_pk_bf16(p0[0], p0[1]); w.y = cvt_pk_bf16(p0[2], p0[3]); w.z = cvt_pk_bf16(p1[0], p1[1]); w.w = cvt_pk_bf16(p1[2], p1[3]);
                        *(u32x4*)(O1 + row * DM + 256 * (u.pn - 8) + cc) = w;
                        w.x = cvt_pk_bf16(q0[0], q0[1]); w.y = cvt_pk_bf16(q0[2], q0[3]); w.z = cvt_pk_bf16(q1[0], q1[1]); w.w = cvt_pk_bf16(q1[2], q1[3]);
                        *(u32x4*)(O1 + row * DM + 256 * (u.pn - 8) + 128 + cc) = w;
                    }
                }
            }
    }
};
struct EpiRgGates {
    static constexpr bool PERM = true;
    const bf16_t* U; bf16_t* LA; bf16_t* Bv; const float* ba; const float* bx; const float* c8;
    __device__ __forceinline__ void operator()(const f32x4 (&acc)[2][2][4][2], const Unit& u, int wr, int wc, int fr, int fq) const {
        const int ch = 128 * u.pn + 32 * wc + 8 * fq;
        f32x4 vba[2], vbx[2], vc8[2];
#pragma unroll
        for (int n = 0; n < 2; ++n) { vba[n] = *(const f32x4*)(ba + ch + 4 * n); vbx[n] = *(const f32x4*)(bx + ch + 4 * n); vc8[n] = *(const f32x4*)(c8 + ch + 4 * n); }
        u32x4 uws[8];
#pragma unroll
        for (int g = 0; g < 8; ++g) uws[g] = *(const u32x4*)(U + (size_t)(u.pm * 256 + (g >> 2) * 128 + wr * 64 + (g & 3) * 16 + fr) * DM + ch);
#pragma unroll
        for (int ai = 0; ai < 2; ++ai)
#pragma unroll
            for (int m = 0; m < 4; ++m) {
                const size_t off = (size_t)(u.pm * 256 + ai * 128 + wr * 64 + m * 16 + fr) * DM + ch;
                const u32x4 uw = uws[ai * 4 + m];
                float la[8], bb[8];
#pragma unroll
                for (int n = 0; n < 2; ++n)
#pragma unroll
                    for (int j = 0; j < 4; ++j) {
                        const float r = fast_sigmoid(acc[ai][0][m][n][j] + vba[n][j]), ig = fast_sigmoid(acc[ai][1][m][n][j] + vbx[n][j]);
                        const float l2 = vc8[n][j] * r; const float a2 = __builtin_amdgcn_exp2f(2.f * l2);
                        const unsigned uu = uw[n * 2 + (j >> 1)]; const float uv = (j & 1) ? bfhi(uu) : bflo(uu);
                        la[n * 4 + j] = l2; bb[n * 4 + j] = __builtin_sqrtf(fmaxf(1.f - a2, 0.f)) * ig * uv;
                    }
                u32x4 w; w.x = cvt_pk_bf16(la[0], la[1]); w.y = cvt_pk_bf16(la[2], la[3]); w.z = cvt_pk_bf16(la[4], la[5]); w.w = cvt_pk_bf16(la[6], la[7]);
                *(u32x4*)(LA + off) = w;
                w.x = cvt_pk_bf16(bb[0], bb[1]); w.y = cvt_pk_bf16(bb[2], bb[3]); w.z = cvt_pk_bf16(bb[4], bb[5]); w.w = cvt_pk_bf16(bb[6], bb[7]);
                *(u32x4*)(Bv + off) = w;
            }
    }
};
template <bool FIRST> struct EpiResid {
    static constexpr bool PERM = true;
    const float* Xin; float* PART; const float* bias; bf16_t* XB; float* SS;
    __device__ __forceinline__ void operator()(const f32x4 (&acc)[2][2][4][2], const Unit& u, int wr, int wc, int fr, int fq) const {
        const int col0 = u.pn * 256 + wc * 32 + 8 * fq;
        if (u.aux == 0) {
            f32x4 bv[2][2];
#pragma unroll
            for (int bj = 0; bj < 2; ++bj)
#pragma unroll
                for (int n = 0; n < 2; ++n) bv[bj][n] = *(const f32x4*)(bias + col0 + bj * 128 + 4 * n);
            const size_t row0 = (size_t)(u.pm * 256 + wr * 64 + fr);
            f32x4 xin[2][4];
#define RES_LOAD(g, b) do { if (FIRST) { const float* xp_ = Xin + (row0 + ((g) >> 2) * 128 + ((g) & 3) * 16) * DM + col0; \
                    xin[b][0] = __builtin_nontemporal_load((const f32x4*)(xp_)); xin[b][1] = __builtin_nontemporal_load((const f32x4*)(xp_ + 4)); xin[b][2] = __builtin_nontemporal_load((const f32x4*)(xp_ + 128)); xin[b][3] = __builtin_nontemporal_load((const f32x4*)(xp_ + 132)); } \
                else { const bf16_t* xp_ = XB + (row0 + ((g) >> 2) * 128 + ((g) & 3) * 16) * DM + col0; \
                    _Pragma("unroll") for (int q_ = 0; q_ < 2; ++q_) { const u32x4 w_ = *(const u32x4*)(xp_ + q_ * 128); \
                        xin[b][2 * q_] = (f32x4){bflo(w_.x), bfhi(w_.x), bflo(w_.y), bfhi(w_.y)}; xin[b][2 * q_ + 1] = (f32x4){bflo(w_.z), bfhi(w_.z), bflo(w_.w), bfhi(w_.w)}; } } } while (0)
            RES_LOAD(0, 0);
#pragma unroll
            for (int g = 0; g < 8; ++g) {
                const int ai = g >> 2, m = g & 3, b = g & 1;
                if (g + 1 < 8) RES_LOAD(g + 1, b ^ 1);
                const size_t row = row0 + ai * 128 + m * 16;
                bf16_t* bp = XB + row * DM + col0;
                float ss = 0.f;
#pragma unroll
                for (int bj = 0; bj < 2; ++bj) {
                    const f32x4 v0 = xin[b][bj * 2] + acc[ai][bj][m][0] + bv[bj][0], v1 = xin[b][bj * 2 + 1] + acc[ai][bj][m][1] + bv[bj][1];
                    u32x4 w; w.x = cvt_pk_bf16(v0[0], v0[1]); w.y = cvt_pk_bf16(v0[2], v0[3]); w.z = cvt_pk_bf16(v1[0], v1[1]); w.w = cvt_pk_bf16(v1[2], v1[3]);
                    *(u32x4*)(bp + bj * 128) = w;
                    ss += ((v0[0] * v0[0] + v0[1] * v0[1]) + (v0[2] * v0[2] + v0[3] * v0[3])) + ((v1[0] * v1[0] + v1[1] * v1[1]) + (v1[2] * v1[2] + v1[3] * v1[3]));
                }
                ss += __shfl_xor(ss, 16); ss += __shfl_xor(ss, 32);
                if (fq == 0) SS[row * 16 + u.pn * 4 + wc] = ss;
            }
#undef RES_LOAD
        } else {
            float* pp = PART + (size_t)(u.aux - 1) * MS * DM;
#pragma unroll
            for (int ai = 0; ai < 2; ++ai)
#pragma unroll
                for (int m = 0; m < 4; ++m) {
                    float* xp = pp + (size_t)(u.pm * 256 - MP + ai * 128 + wr * 64 + m * 16 + fr) * DM + col0;
#pragma unroll
                    for (int bj = 0; bj < 2; ++bj)
#pragma unroll
                        for (int n = 0; n < 2; ++n) *(f32x4*)(xp + bj * 128 + 4 * n) = acc[ai][bj][m][n];
                }
        }
    }
};
}

struct Params { const float* in[31]; float* out; unsigned char* ws; int ph_lo, ph_hi; };

__device__ __forceinline__ unsigned f2bf(float f) { unsigned u = __builtin_bit_cast(unsigned, f); return (u + 0x7fffu + ((u >> 16) & 1u)) >> 16; }
__device__ __forceinline__ unsigned pk2(float lo, float hi) { return f2bf(lo) | (f2bf(hi) << 16); }

struct TItem { const float* S; int Ns, K, n0, k0; bf16_t* WT; const float* gk; };
__device__ __forceinline__ void titem_load(const TItem& t, float (&tv)[32], int lane) {
#pragma unroll
    for (int i = 0; i < 32; ++i) tv[i] = __builtin_nontemporal_load(t.S + (size_t)(t.k0 + 2 * i + (lane >> 5)) * t.Ns + (lane & 31));
}
__device__ __forceinline__ void titem_finish(const TItem& t, const float (&tv)[32], LAS float* scr, int lane) {
    const int c = lane & 7;
    f32x4 g0 = (f32x4){1.f, 1.f, 1.f, 1.f}, g1 = g0;
    if (t.gk) { g0 = *(const f32x4*)(t.gk + t.k0 + 8 * c); g1 = *(const f32x4*)(t.gk + t.k0 + 8 * c + 4); }
#pragma unroll
    for (int i = 0; i < 32; ++i) scr[(2 * i + (lane >> 5)) * 33 + (lane & 31)] = tv[i];
    asm volatile("s_waitcnt lgkmcnt(0)" ::: "memory");
#pragma unroll
    for (int j = 0; j < 4; ++j) { const int n = (lane >> 3) + 8 * j; const LAS float* s = scr + (8 * c) * 33 + n;
        u32x4 o; o.x = pk2(s[0 * 33] * g0.x, s[1 * 33] * g0.y); o.y = pk2(s[2 * 33] * g0.z, s[3 * 33] * g0.w); o.z = pk2(s[4 * 33] * g1.x, s[5 * 33] * g1.y); o.w = pk2(s[6 * 33] * g1.z, s[7 * 33] * g1.w);
        *(u32x4*)(t.WT + (size_t)(t.n0 + n) * t.K + t.k0 + 8 * c) = o; }
    asm volatile("s_waitcnt lgkmcnt(0)" ::: "memory");
}

__device__ __forceinline__ bool titem_decode(const Params& p, unsigned char* ws, int it, TItem& t) {
    constexpr int I_QKV = 16 * 40, I_SQ = 16 * 32, I_FU = 16 * 176, I_FD = 44 * 32, I_RG1 = 16 * 64, I_RG2 = 4 * 64, I_SC1 = 16 * 96;
    constexpr int NITEMS = 2 * I_QKV + 2 * I_SQ + 4 * I_FU + 4 * I_FD + I_RG1 + I_RG2 + I_SQ + I_SC1 + I_SQ;
    if (it >= NITEMS) return false;
        int r = it;
        const float* S; int Ns, K, n0, k0; bf16_t* WT; const float* gk = nullptr;
        if (r < 2 * I_QKV) { const int j = r / I_QKV; r -= j * I_QKV; K = 1024; const int nb = r % 40, kb = r / 40; k0 = 64 * kb; n0 = 32 * nb;
            const int pn = nb >> 3, bj = (nb >> 2) & 1, hh = nb & 3; Ns = NQKV; S = p.in[10] + (size_t)j * 1024 * NQKV + (4 * pn + hh) * 64 + 32 * bj; WT = (bf16_t*)(ws + WS_WQKV) + (size_t)j * NQKV * 1024; gk = p.in[7] + 3 * j * DM; }
        else if ((r -= 2 * I_QKV) < 2 * I_SQ) { const int j = r / I_SQ; r -= j * I_SQ; K = 1024; const int nb = r % 32, kb = r / 32; k0 = 64 * kb; n0 = 32 * nb; Ns = 1024; S = p.in[12] + (size_t)j * 1024 * 1024 + n0; WT = (bf16_t*)(ws + WS_WO) + (size_t)j * 1024 * 1024; }
        else if ((r -= 2 * I_SQ) < 4 * I_FU) { const int i = r / I_FU; r -= i * I_FU; K = 1024; const int nb = r % 176, kb = r / 176; k0 = 64 * kb; n0 = 32 * nb;
            const int pn = nb >> 3, bj = (nb >> 2) & 1, c32 = nb & 3; Ns = DFF; S = (bj ? p.in[29] : p.in[28]) + (size_t)i * 1024 * DFF + 128 * pn + 32 * c32; WT = (bf16_t*)(ws + WS_WFU) + (size_t)i * 5632 * 1024; gk = p.in[8] + i * DM; }
        else if ((r -= 4 * I_FU) < 4 * I_FD) { const int i = r / I_FD; r -= i * I_FD; K = DFF; const int nb = r % 32, kb = r / 32; k0 = 64 * kb; n0 = 32 * nb; Ns = 1024; S = p.in[30] + (size_t)i * DFF * 1024 + n0; WT = (bf16_t*)(ws + WS_WFD) + (size_t)i * 1024 * DFF; }
        else if ((r -= 4 * I_FD) < I_RG1) { K = 1024; const int nb = r % 64, kb = r / 64; k0 = 64 * kb; n0 = 32 * nb;
            const int pn = nb >> 3, bj = (nb >> 2) & 1, c32 = nb & 3; Ns = 1024; S = (bj ? p.in[16] : p.in[15]) + 128 * pn + 32 * c32; WT = (bf16_t*)(ws + WS_WRG1); gk = p.in[7] + 1 * DM; }
        else if ((r -= I_RG1) < I_RG2) { K = 256; const int nb = r % 64, kb = r / 64; k0 = 64 * kb; n0 = 32 * nb;
            const int pn = nb >> 3, bj = (nb >> 2) & 1, c32 = nb & 3; Ns = 256; S = (bj ? p.in[21] : p.in[19]) + (size_t)(pn >> 1) * 65536 + 128 * (pn & 1) + 32 * c32; WT = (bf16_t*)(ws + WS_WRG2); }
        else if ((r -= I_RG2) < I_SQ) { K = 1024; const int nb = r % 32, kb = r / 32; k0 = 64 * kb; n0 = 32 * nb; Ns = 1024; S = p.in[24] + n0; WT = (bf16_t*)(ws + WS_WRG3); }
        else if ((r -= I_SQ) < I_SC1) { K = 1024; const int nb = r % 96, kb = r / 96; k0 = 64 * kb; n0 = 32 * nb;
            const int pn = nb >> 3, bj = (nb >> 2) & 1, c32 = nb & 3; Ns = 3072;
            const int col = pn < 8 ? (bj ? 2048 : 1024) + 128 * pn + 32 * c32 : 256 * (pn - 8) + 128 * bj + 32 * c32; S = p.in[25] + col; WT = (bf16_t*)(ws + WS_WSC1); gk = p.in[7] + 2 * DM; }
        else { r -= I_SC1; K = 1024; const int nb = r % 32, kb = r / 32; k0 = 64 * kb; n0 = 32 * nb; Ns = 1024; S = p.in[27] + n0; WT = (bf16_t*)(ws + WS_WSC2); }
        t.S = S; t.Ns = Ns; t.K = K; t.n0 = n0; t.k0 = k0; t.WT = WT; t.gk = gk;
    return true;
}

__device__ __forceinline__ int set_size(int s) { return s == 0 ? 640 : s == 1 ? 6528 : s == 2 ? 6272 : s == 3 ? 4224 : 5376; }
__device__ __forceinline__ int set_item(int s, int k) {
    if (s == 0) return k;
    if (s == 1) { if (k < 512) return 1280 + k; k -= 512; if (k < 2816) return 2304 + k; k -= 2816; if (k < 1408) return 13568 + k; k -= 1408; return 19200 + k; }
    if (s == 2) { if (k < 2816) return 5120 + k; k -= 2816; if (k < 1408) return 14976 + k; k -= 1408; return 20992 + k; }
    if (s == 3) { if (k < 2816) return 7936 + k; k -= 2816; return 16384 + k; }
    if (k < 640) return 640 + k; k -= 640; if (k < 512) return 1792 + k; k -= 512; if (k < 2816) return 10752 + k; k -= 2816; return 17792 + k;
}
__device__ __forceinline__ void convert_set(const Params& p, unsigned char* ws, LAS float* scr, int set, int widx, int nw, int lane) {
    const int n = set_size(set);
    TItem cur, nxt; float tv[32], tn[32];
    int k = widx;
    bool has = k < n;
    if (has) { titem_decode(p, ws, set_item(set, k), cur); titem_load(cur, tv, lane); }
    while (has) {
        k += nw;
        const bool hn = k < n;
        if (hn) { titem_decode(p, ws, set_item(set, k), nxt); titem_load(nxt, tn, lane); }
        titem_finish(cur, tv, scr, lane);
#pragma unroll
        for (int i = 0; i < 32; ++i) tv[i] = tn[i];
        cur = nxt; has = hn;
    }
}
__device__ __forceinline__ void convert_in_slack(const Params& p, unsigned char* ws, LAS unsigned char* lds, int set, int nU, int vcu, int G, const int tid) {
    const int first = nU % G, nidle = first == 0 ? G : G - first;
    const int k0 = first == 0 ? 0 : first;
    if (vcu < k0) return;
    const int lane = tid & 63, wave = __builtin_amdgcn_readfirstlane(tid >> 6);
    convert_set(p, ws, (LAS float*)(lds + wave * 16384), set, (vcu - k0) * 8 + wave, nidle * 8, lane);
}

__device__ __forceinline__ void prep_phase(const Params& p, LAS unsigned char* lds, int vcu, int G, const int tid) {
    const int lane = tid & 63, wave = __builtin_amdgcn_readfirstlane(tid >> 6);
    LAS float* scr = (LAS float*)(lds + wave * 16384);
    const int gw = vcu * 8 + wave, NGW = G * 8;
    unsigned char* ws = p.ws;
    convert_set(p, ws, scr, 0, gw, NGW, lane);
    {
        float* rstd = (float*)(ws + WS_RSTD);
        for (int m = gw; m < M; m += NGW) {
            const float* src = m < MP ? p.in[0] + (size_t)m * DM : p.in[1] + (size_t)(m - MP) * DM;
            f32x4 v[4]; float s = 0.f;
#pragma unroll
            for (int j = 0; j < 4; ++j) { v[j] = __builtin_nontemporal_load((const f32x4*)src + lane + 64 * j); s += (v[j].x * v[j].x + v[j].y * v[j].y) + (v[j].z * v[j].z + v[j].w * v[j].w); }
            s = wave_sum(s);
            if (lane == 0) rstd[m] = 1.0f / sqrtf(s * (1.f / DM) + EPS);
            u32x2* no = (u32x2*)((bf16_t*)(ws + WS_XN) + (size_t)m * DM) + lane;
#pragma unroll
            for (int j = 0; j < 4; ++j) { u32x2 w; w.x = cvt_pk_bf16(v[j].x, v[j].y); w.y = cvt_pk_bf16(v[j].z, v[j].w); no[64 * j] = w; }
        }
    }
    {
        const int gt = vcu * 512 + tid, NGT = G * 512;
        float* rope = (float*)(ws + WS_ROPE);
        for (int e = gt; e < 4104 * 32; e += NGT) {
            const int pi = e >> 5, d = e & 31; const int pos = pi < SEQ ? pi : 8192 + (pi - SEQ);
            double inv = 1.0; for (int k = 0; k < d; ++k) inv *= 0.7498942093324559;
            const float ang = (float)pos * (float)inv;
            const double rev = (double)ang * 0.15915494309189535; const double fr = rev - __builtin_rint(rev);
            rope[(size_t)pi * 64 + d] = __builtin_amdgcn_cosf((float)fr); rope[(size_t)pi * 64 + 32 + d] = __builtin_amdgcn_sinf((float)fr);
        }
        float* c8 = (float*)(ws + WS_C8);
        for (int e = gt; e < 1024; e += NGT) { const float lam = p.in[23][e]; c8[e] = -8.0f * log1pf(__expf(-lam)) * LOG2E; ((float*)(ws + WS_ZB))[e] = 0.f; }
    }
}

__device__ __forceinline__ void norm_phase(float* X, const float* PART, int nsplit, const float* bias, const float* g, bf16_t* XN, bool final_, int vcu, int G, const int tid) {
    const int lane = tid & 63, wave = tid >> 6;
    const int gw = vcu * 8 + wave, NGW = G * 8;
    f32x4 gv[4];
#pragma unroll
    for (int j = 0; j < 4; ++j) gv[j] = *((const f32x4*)g + lane + 64 * j);
    for (int m = gw; m < M; m += NGW) {
        f32x4* xr = (f32x4*)(X + (size_t)m * DM) + lane;
        f32x4 v[4]; float s = 0.f;
        if (m >= MP) {
#pragma unroll
            for (int j = 0; j < 4; ++j) v[j] = xr[64 * j];
        } else {
            const u32x2* br = (const u32x2*)(XN + (size_t)m * DM) + lane;
#pragma unroll
            for (int j = 0; j < 4; ++j) { const u32x2 w = __builtin_nontemporal_load(br + 64 * j); v[j] = (f32x4){bflo(w.x), bfhi(w.x), bflo(w.y), bfhi(w.y)}; }
        }
        if (m >= MP) {
#pragma unroll 4
            for (int sl = 0; sl < nsplit; ++sl) { const f32x4* pr = (const f32x4*)(PART + ((size_t)sl * MS + (m - MP)) * DM) + lane;
#pragma unroll
                for (int j = 0; j < 4; ++j) v[j] += pr[64 * j]; }
            if (bias) {
#pragma unroll
                for (int j = 0; j < 4; ++j) v[j] += *((const f32x4*)bias + lane + 64 * j); }
            if (!final_) {
#pragma unroll
                for (int j = 0; j < 4; ++j) xr[64 * j] = v[j]; }
        }
#pragma unroll
        for (int j = 0; j < 4; ++j) s += (v[j].x * v[j].x + v[j].y * v[j].y) + (v[j].z * v[j].z + v[j].w * v[j].w);
        const float rstd = 1.0f / sqrtf(wave_sum(s) * (1.f / DM) + EPS);
        if (final_) {
#pragma unroll
            for (int j = 0; j < 4; ++j) __builtin_nontemporal_store(v[j] * rstd * gv[j], xr + 64 * j);
        } else {
            u32x2* no = (u32x2*)(XN + (size_t)m * DM) + lane;
#pragma unroll
            for (int j = 0; j < 4; ++j) { const f32x4 y = v[j] * rstd * gv[j]; u32x2 w; w.x = cvt_pk_bf16(y.x, y.y); w.y = cvt_pk_bf16(y.z, y.w); no[64 * j] = w; }
        }
    }
}

__device__ __forceinline__ void fin_phase(const float* Xin, float* X, const float* PART, int nsplit, const float* bias, bf16_t* XB, const float* SS, float* rstd, int vcu, int G, const int tid) {
    const int lane = tid & 63, wave = tid >> 6;
    const int gw = vcu * 8 + wave, NGW = G * 8;
    for (int r = gw; r < MS; r += NGW) {
        const int m = MP + r;
        f32x4* xr = (f32x4*)(X + (size_t)m * DM) + lane;
        const f32x4* xi = (const f32x4*)(Xin + (size_t)r * DM) + lane;
        f32x4 v[4]; float s = 0.f;
#pragma unroll
        for (int j = 0; j < 4; ++j) v[j] = xi[64 * j];
#pragma unroll 4
        for (int sl = 0; sl < nsplit; ++sl) { const f32x4* pr = (const f32x4*)(PART + ((size_t)sl * MS + r) * DM) + lane;
#pragma unroll
            for (int j = 0; j < 4; ++j) v[j] += pr[64 * j]; }
        if (bias) {
#pragma unroll
            for (int j = 0; j < 4; ++j) v[j] += *((const f32x4*)bias + lane + 64 * j); }
        u32x2* no = (u32x2*)(XB + (size_t)m * DM) + lane;
#pragma unroll
        for (int j = 0; j < 4; ++j) { xr[64 * j] = v[j]; u32x2 w; w.x = cvt_pk_bf16(v[j].x, v[j].y); w.y = cvt_pk_bf16(v[j].z, v[j].w); no[64 * j] = w;
            s += (v[j].x * v[j].x + v[j].y * v[j].y) + (v[j].z * v[j].z + v[j].w * v[j].w); }
        s = wave_sum(s);
        if (lane == 0) rstd[m] = 1.0f / sqrtf(s * (1.f / DM) + EPS);
    }
    const int gt = vcu * 512 + tid, NGT = G * 512;
    for (int m = NGT - 1 - gt; m < MP; m += NGT) {
        const f32x4* sp = (const f32x4*)(SS + (size_t)m * 16);
        const f32x4 a = sp[0], b = sp[1], c = sp[2], d = sp[3];
        const float s = ((a.x + a.y) + (a.z + a.w)) + ((b.x + b.y) + (b.z + b.w)) + ((c.x + c.y) + (c.z + c.w)) + ((d.x + d.y) + (d.z + d.w));
        rstd[m] = 1.0f / sqrtf(s * (1.f / DM) + EPS);
    }
}

constexpr int KS_PITCH = 72, VT_PITCH = 260;
constexpr int ATT_KS = 0, ATT_VT = 256 * KS_PITCH * 2;
__device__ __forceinline__ void attn_phase(const Params& p, LAS unsigned char* lds, int j, int vcu, int G, const int tid) {
    const int lane = tid & 63, wave = __builtin_amdgcn_readfirstlane(tid >> 6), l31 = lane & 31, hi = lane >> 5;
    const bf16_t* QKV = (const bf16_t*)(p.ws + WS_S0);
    bf16_t* O = (bf16_t*)(p.ws + WS_S2);
    LAS bf16_t* Ks = (LAS bf16_t*)(lds + ATT_KS);
    LAS bf16_t* Vt = (LAS bf16_t*)(lds + ATT_VT);
    const float* ck = p.in[2] + (size_t)j * 128 * 128 * 128;
    const float* cv = p.in[3] + (size_t)j * 128 * 128 * 128;
    {
        const int gt = vcu * 512 + tid, NGT = G * 512;
        float* kp = p.out + O_KP + (size_t)j * 65536; float* vp = p.out + O_VP + (size_t)j * 65536;
        for (int e = gt; e < 65536; e += NGT) { const int d = e & 127, t = (e >> 7) & 127, b = e >> 14; const size_t src = (size_t)(b * SEQ + SEQ - 128 + t) * NQKV + 1024 + d;
            kp[e] = bf2f(QKV[src]); vp[e] = bf2f(QKV[src + 128]); }
        float* ksn = p.out + O_KS + (size_t)j * 2097152; float* vsn = p.out + O_VS + (size_t)j * 2097152;
        f32x4 kv4[4], vv4[4];
#pragma unroll
        for (int it = 0; it < 4; ++it) {
            const int e4 = gt + it * NGT;
            if (e4 < 524288) { const int e = e4 * 4, d = e & 127, c = (e >> 7) & 127, b = e >> 14;
                if (c < 120) { kv4[it] = __builtin_nontemporal_load((const f32x4*)(ck + e + 8 * 128)); vv4[it] = __builtin_nontemporal_load((const f32x4*)(cv + e + 8 * 128)); }
                else { const size_t src = (size_t)(MP + b * 8 + c - 120) * NQKV + 1024 + d; const u32x2 kw = *(const u32x2*)(QKV + src), vw = *(const u32x2*)(QKV + src + 128);
                    kv4[it] = (f32x4){bflo(kw.x), bfhi(kw.x), bflo(kw.y), bfhi(kw.y)}; vv4[it] = (f32x4){bflo(vw.x), bfhi(vw.x), bflo(vw.y), bfhi(vw.y)}; } }
        }
#pragma unroll
        for (int it = 0; it < 4; ++it) { const int e4 = gt + it * NGT; if (e4 < 524288) { __builtin_nontemporal_store(kv4[it], (f32x4*)(ksn + (size_t)e4 * 4)); __builtin_nontemporal_store(vv4[it], (f32x4*)(vsn + (size_t)e4 * 4)); } }
        for (int e4 = gt + 4 * NGT; e4 < 524288; e4 += NGT) {
            const int e = e4 * 4, d = e & 127, c = (e >> 7) & 127, b = e >> 14;
            if (c < 120) { *(f32x4*)(ksn + e) = *(const f32x4*)(ck + e + 8 * 128); *(f32x4*)(vsn + e) = *(const f32x4*)(cv + e + 8 * 128); }
            else { const size_t src = (size_t)(MP + b * 8 + c - 120) * NQKV + 1024 + d; const u32x2 kw = *(const u32x2*)(QKV + src), vw = *(const u32x2*)(QKV + src + 128);
                *(f32x4*)(ksn + e) = (f32x4){bflo(kw.x), bfhi(kw.x), bflo(kw.y), bfhi(kw.y)}; *(f32x4*)(vsn + e) = (f32x4){bflo(vw.x), bfhi(vw.x), bflo(vw.y), bfhi(vw.y)}; }
        }
    }
    for (int un = vcu; un < 512; un += G) {
        const bool prompt = un < 256;
        int b, kvh, nb = 0;
        if (prompt) { b = un >> 6; kvh = (un >> 5) & 1; nb = un & 31; } else { const int s = un - 256; b = s >> 1; kvh = s & 1; }
        const int nkeys = prompt ? 256 : 160;
        for (int id = tid; id < nkeys * 8; id += 512) {
            const int key = id >> 3, ch = id & 7;
            u32x4 w = (u32x4){0u, 0u, 0u, 0u};
            if (prompt) { if (!(nb == 0 && key < 128)) w = *(const u32x4*)(QKV + (size_t)(b * SEQ + 128 * (nb - 1) + key) * NQKV + 1024 + kvh * 64 + 8 * ch); }
            else if (key < 128) { const float* s = ck + ((size_t)(b * 128 + key) * 2 + kvh) * 64 + 8 * ch; const f32x4 a = *(const f32x4*)s, c = *(const f32x4*)(s + 4);
                w.x = cvt_pk_bf16(a.x, a.y); w.y = cvt_pk_bf16(a.z, a.w); w.z = cvt_pk_bf16(c.x, c.y); w.w = cvt_pk_bf16(c.z, c.w); }
            else if (key < 136) w = *(const u32x4*)(QKV + (size_t)(MP + b * 8 + key - 128) * NQKV + 1024 + kvh * 64 + 8 * ch);
            *(LAS u32x4*)(Ks + key * KS_PITCH + 8 * ch) = w;
        }
        for (int id = tid; id < nkeys * 8; id += 512) {
            const int key = id % nkeys, ch = id / nkeys;
            u32x4 w = (u32x4){0u, 0u, 0u, 0u};
            if (prompt) { if (!(nb == 0 && key < 128)) w = *(const u32x4*)(QKV + (size_t)(b * SEQ + 128 * (nb - 1) + key) * NQKV + 1152 + kvh * 64 + 8 * ch); }
            else if (key < 128) { const float* s = cv + ((size_t)(b * 128 + key) * 2 + kvh) * 64 + 8 * ch; const f32x4 a = *(const f32x4*)s, c = *(const f32x4*)(s + 4);
                w.x = cvt_pk_bf16(a.x, a.y); w.y = cvt_pk_bf16(a.z, a.w); w.z = cvt_pk_bf16(c.x, c.y); w.w = cvt_pk_bf16(c.z, c.w); }
            else if (key < 136) w = *(const u32x4*)(QKV + (size_t)(MP + b * 8 + key - 128) * NQKV + 1152 + kvh * 64 + 8 * ch);
            LAS bf16_t* vd = Vt + (8 * ch) * VT_PITCH + key;
            vd[0 * VT_PITCH] = (bf16_t)(w.x & 0xffff); vd[1 * VT_PITCH] = (bf16_t)(w.x >> 16); vd[2 * VT_PITCH] = (bf16_t)(w.y & 0xffff); vd[3 * VT_PITCH] = (bf16_t)(w.y >> 16);
            vd[4 * VT_PITCH] = (bf16_t)(w.z & 0xffff); vd[5 * VT_PITCH] = (bf16_t)(w.z >> 16); vd[6 * VT_PITCH] = (bf16_t)(w.w & 0xffff); vd[7 * VT_PITCH] = (bf16_t)(w.w >> 16);
        }
        __syncthreads();
        const int h = kvh * 8 + wave;
        const float sink8 = p.in[14][j * 16 + h] * 8.0f;
        const int nqs = prompt ? 4 : 1;
        for (int qs = 0; qs < nqs; ++qs) {
            const int qi = 32 * qs + l31;
            const bool qvalid = prompt || l31 < 8;
            const size_t qrow = prompt ? (size_t)(b * SEQ + 128 * nb + qi) : (size_t)(MP + b * 8 + (l31 < 8 ? l31 : 7));
            bf16x8 qf[4];
#pragma unroll
            for (int d0 = 0; d0 < 4; ++d0) qf[d0] = *(const bf16x8*)(QKV + qrow * NQKV + h * 64 + 16 * d0 + 8 * hi);
            constexpr float CS = 0.125f * LOG2E;
            float mrun = sink8, lrun = hi == 0 ? 1.f : 0.f;
            f32x16 o0 = {}, o1 = {};
            const int kt_lo = (prompt && nb == 0 && qs < 4) ? 4 : qs;
            for (int kt = kt_lo; kt < qs + 5; ++kt) {
                f32x16 s = {};
#pragma unroll
                for (int d0 = 0; d0 < 4; ++d0) { const bf16x8 kf = *(const LAS bf16x8*)(Ks + (32 * kt + l31) * KS_PITCH + 16 * d0 + 8 * hi); s = __builtin_amdgcn_mfma_f32_32x32x16_bf16(kf, qf[d0], s, 0, 0, 0); }
                if (kt == qs || kt == qs + 4) {
#pragma unroll
                    for (int r = 0; r < 16; ++r) { const int c = 32 * kt + (r & 3) + 8 * (r >> 2) + 4 * hi; const bool ok = (c > qi) && (c <= qi + 128); s[r] = ok ? s[r] : -1e30f; }
                }
                float mx = fmaxf(fmaxf(s[0], s[1]), fmaxf(s[2], s[3]));
#pragma unroll
                for (int r = 4; r < 16; r += 4) mx = fmaxf(mx, fmaxf(fmaxf(s[r], s[r + 1]), fmaxf(s[r + 2], s[r + 3])));
                mx = fmaxf(mx, __shfl_xor(mx, 32));
                if (__any(mx > mrun)) {
                    const float mnew = fmaxf(mrun, mx), alpha = __builtin_amdgcn_exp2f((mrun - mnew) * CS);
                    lrun *= alpha; mrun = mnew;
#pragma unroll
                    for (int r = 0; r < 16; ++r) { o0[r] *= alpha; o1[r] *= alpha; }
                }
                const float mc = -mrun * CS;
                float ps = 0.f;
#pragma unroll
                for (int r = 0; r < 16; ++r) { s[r] = __builtin_amdgcn_exp2f(__builtin_fmaf(s[r], CS, mc)); ps += s[r]; }
                lrun += ps;
#pragma unroll
                for (int ss = 0; ss < 2; ++ss) {
                    u32x4 pw; pw.x = cvt_pk_bf16(s[8 * ss + 0], s[8 * ss + 1]); pw.y = cvt_pk_bf16(s[8 * ss + 2], s[8 * ss + 3]); pw.z = cvt_pk_bf16(s[8 * ss + 4], s[8 * ss + 5]); pw.w = cvt_pk_bf16(s[8 * ss + 6], s[8 * ss + 7]);
                    const bf16x8 pb = __builtin_bit_cast(bf16x8, pw);
                    const LAS bf16_t* vb = Vt + l31 * VT_PITCH + 32 * kt + 16 * ss + 4 * hi;
                    const s16x4 a0 = *(const LAS s16x4*)(vb), a1 = *(const LAS s16x4*)(vb + 8);
                    const s16x4 c0 = *(const LAS s16x4*)(vb + 32 * VT_PITCH), c1 = *(const LAS s16x4*)(vb + 32 * VT_PITCH + 8);
                    const bf16x8 v0 = (bf16x8){a0[0], a0[1], a0[2], a0[3], a1[0], a1[1], a1[2], a1[3]};
                    const bf16x8 v1 = (bf16x8){c0[0], c0[1], c0[2], c0[3], c1[0], c1[1], c1[2], c1[3]};
                    o0 = __builtin_amdgcn_mfma_f32_32x32x16_bf16(v0, pb, o0, 0, 0, 0);
                    o1 = __builtin_amdgcn_mfma_f32_32x32x16_bf16(v1, pb, o1, 0, 0, 0);
                }
            }
            const float ltot = lrun + __shfl_xor(lrun, 32);
            const float inv = 1.0f / ltot;
            if (qvalid) {
                const size_t orow = prompt ? (size_t)(b * SEQ + 128 * nb + qi) : (size_t)(MP + b * 8 + l31);
                bf16_t* op = O + orow * DM + h * 64 + 4 * hi;
#pragma unroll
                for (int r4 = 0; r4 < 4; ++r4) {
                    u32x2 w; w.x = cvt_pk_bf16(o0[4 * r4] * inv, o0[4 * r4 + 1] * inv); w.y = cvt_pk_bf16(o0[4 * r4 + 2] * inv, o0[4 * r4 + 3] * inv); *(u32x2*)(op + 8 * r4) = w;
                    w.x = cvt_pk_bf16(o1[4 * r4] * inv, o1[4 * r4 + 1] * inv); w.y = cvt_pk_bf16(o1[4 * r4 + 2] * inv, o1[4 * r4 + 3] * inv); *(u32x2*)(op + 32 + 8 * r4) = w;
                }
            }
        }
        __syncthreads();
    }
}

__device__ __forceinline__ void rgconv_phase(const Params& p, int vcu, int G, const int tid) {
    const int gt = vcu * 512 + tid, NGT = G * 512;
    const bf16_t* __restrict__ V = (const bf16_t*)(p.ws + WS_S1); bf16_t* __restrict__ U = (bf16_t*)(p.ws + WS_S3);
    const float* __restrict__ cw = p.in[17]; const float* __restrict__ cb = p.in[18]; const float* __restrict__ buf = p.in[5];
#pragma unroll 2
    for (int e = gt; e < M * 128; e += NGT) {
        const int row = e >> 7, ch = (e & 127) * 8;
        int t, T; const float* sb = nullptr;
        if (row < MP) { t = row & (SEQ - 1); T = SEQ; } else { t = (row - MP) & 7; T = 8; sb = buf + (size_t)((row - MP) >> 3) * 3 * DM; }
        float accv[8];
        { const f32x4 b0 = *(const f32x4*)(cb + ch), b1 = *(const f32x4*)(cb + ch + 4);
#pragma unroll
          for (int k = 0; k < 4; ++k) { accv[k] = b0[k]; accv[4 + k] = b1[k]; } }
#pragma unroll
        for (int jj = 0; jj < 4; ++jj) {
            const int tt = t - 3 + jj;
            float xv[8];
            if (tt >= 0) { const u32x4 w = *(const u32x4*)(V + (size_t)(row - 3 + jj) * DM + ch);
                xv[0] = bflo(w.x); xv[1] = bfhi(w.x); xv[2] = bflo(w.y); xv[3] = bfhi(w.y); xv[4] = bflo(w.z); xv[5] = bfhi(w.z); xv[6] = bflo(w.w); xv[7] = bfhi(w.w); }
            else if (sb) { const f32x4 a = *(const f32x4*)(sb + (size_t)(tt + 3) * DM + ch), c = *(const f32x4*)(sb + (size_t)(tt + 3) * DM + ch + 4);
#pragma unroll
                for (int k = 0; k < 4; ++k) { xv[k] = a[k]; xv[4 + k] = c[k]; } }
            else {
#pragma unroll
                for (int k = 0; k < 8; ++k) xv[k] = 0.f; }
            const f32x4 w0 = *(const f32x4*)(cw + jj * DM + ch), w1 = *(const f32x4*)(cw + jj * DM + ch + 4);
#pragma unroll
            for (int k = 0; k < 4; ++k) { accv[k] += xv[k] * w0[k]; accv[4 + k] += xv[4 + k] * w1[k]; }
        }
        u32x4 w; w.x = cvt_pk_bf16(accv[0], accv[1]); w.y = cvt_pk_bf16(accv[2], accv[3]); w.z = cvt_pk_bf16(accv[4], accv[5]); w.w = cvt_pk_bf16(accv[6], accv[7]);
        *(u32x4*)(U + (size_t)row * DM + ch) = w;
        if (t >= T - 3) {
            const u32x4 vw = *(const u32x4*)(V + (size_t)row * DM + ch);
            float* dst = row < MP ? p.out + O_RCP + ((size_t)(row >> 12) * 3 + (t - (T - 3))) * DM + ch : p.out + O_RCS + ((size_t)((row - MP) >> 3) * 3 + (t - (T - 3))) * DM + ch;
            *(f32x4*)dst = (f32x4){bflo(vw.x), bfhi(vw.x), bflo(vw.y), bfhi(vw.y)}; *(f32x4*)(dst + 4) = (f32x4){bflo(vw.z), bfhi(vw.z), bflo(vw.w), bfhi(vw.w)};
        }
    }
}
__device__ __forceinline__ void rgscan_phase(const Params& p, LAS unsigned char* lds, int vcu, int G, const int tid) {
    const int lane = tid & 63, wave = tid >> 6;
    bf16_t* GATE = (bf16_t*)(p.ws + WS_S0); const bf16_t* LA = (const bf16_t*)(p.ws + WS_S1); const bf16_t* Bv = (const bf16_t*)(p.ws + WS_S2);
    LAS float* sm = (LAS float*)lds;
    for (int un = vcu; un < 256; un += G) {
        const int b = un >> 6, ch = (un & 63) * 16 + (lane & 15), chunk = wave * 4 + (lane >> 4);
        const size_t base = (size_t)(b * SEQ + chunk * 128) * DM + ch;
        float Ap = 0.f, Bp = 0.f;
        for (int t0 = 0; t0 < 128; t0 += 32) {
            unsigned short lv[32], bv_[32];
#pragma unroll
            for (int t = 0; t < 32; ++t) { lv[t] = LA[base + (size_t)(t0 + t) * DM]; bv_[t] = Bv[base + (size_t)(t0 + t) * DM]; }
#pragma unroll
            for (int t = 0; t < 32; ++t) { const float l2 = bf2f(lv[t]); Ap += l2; Bp = __builtin_amdgcn_exp2f(l2) * Bp + bf2f(bv_[t]); }
        }
        sm[(chunk * 16 + (lane & 15)) * 2] = __builtin_amdgcn_exp2f(Ap); sm[(chunk * 16 + (lane & 15)) * 2 + 1] = Bp;
        __syncthreads();
        float hcur = 0.f;
        for (int c = 0; c < chunk; ++c) hcur = sm[(c * 16 + (lane & 15)) * 2] * hcur + sm[(c * 16 + (lane & 15)) * 2 + 1];
        for (int t0 = 0; t0 < 128; t0 += 32) {
            unsigned short lv[32], bv_[32], gv_[32];
#pragma unroll
            for (int t = 0; t < 32; ++t) { lv[t] = LA[base + (size_t)(t0 + t) * DM]; bv_[t] = Bv[base + (size_t)(t0 + t) * DM]; gv_[t] = GATE[base + (size_t)(t0 + t) * DM]; }
#pragma unroll
            for (int t = 0; t < 32; ++t) { hcur = __builtin_amdgcn_exp2f(bf2f(lv[t])) * hcur + bf2f(bv_[t]); GATE[base + (size_t)(t0 + t) * DM] = (bf16_t)f2bf(hcur * bf2f(gv_[t])); }
        }
        if (chunk == 31) p.out[O_HP + (size_t)b * DM + ch] = hcur;
        __syncthreads();
    }
    const int gt = vcu * 512 + tid, NGT = G * 512;
    for (int e = gt; e < 128 * DM; e += NGT) {
        const int sq = e >> 10, ch = e & 1023; float hcur = p.in[4][e];
        const size_t base = (size_t)(MP + sq * 8) * DM + ch;
#pragma unroll
        for (int t = 0; t < 8; ++t) { const float l2 = bf2f(LA[base + (size_t)t * DM]); const float bb = bf2f(Bv[base + (size_t)t * DM]);
            hcur = __builtin_amdgcn_exp2f(l2) * hcur + bb; const float gt_ = bf2f(GATE[base + (size_t)t * DM]); GATE[base + (size_t)t * DM] = (bf16_t)f2bf(hcur * gt_); }
        p.out[O_HS + e] = hcur;
    }
}
__device__ __forceinline__ void scconv_phase(const Params& p, int vcu, int G, const int tid) {
    const int gt = vcu * 512 + tid, NGT = G * 512;
    const bf16_t* __restrict__ CX = (const bf16_t*)(p.ws + WS_S0); const bf16_t* __restrict__ BG = (const bf16_t*)(p.ws + WS_S1); bf16_t* __restrict__ YG = (bf16_t*)(p.ws + WS_S2);
    const float* __restrict__ cw = p.in[26]; const float* __restrict__ buf = p.in[6];
#pragma unroll 2
    for (int e = gt; e < M * 128; e += NGT) {
        const int row = e >> 7, ch = (e & 127) * 8;
        int t, T; const float* sb = nullptr;
        if (row < MP) { t = row & (SEQ - 1); T = SEQ; } else { t = (row - MP) & 7; T = 8; sb = buf + (size_t)((row - MP) >> 3) * 2 * DM; }
        float accv[8];
#pragma unroll
        for (int k = 0; k < 8; ++k) accv[k] = 0.f;
        u32x4 cur = (u32x4){0u, 0u, 0u, 0u};
#pragma unroll
        for (int jj = 0; jj < 3; ++jj) {
            const int tt = t - 2 + jj;
            float xv[8];
            if (tt >= 0) { const u32x4 w = *(const u32x4*)(CX + (size_t)(row - 2 + jj) * DM + ch); if (jj == 2) cur = w;
                xv[0] = bflo(w.x); xv[1] = bfhi(w.x); xv[2] = bflo(w.y); xv[3] = bfhi(w.y); xv[4] = bflo(w.z); xv[5] = bfhi(w.z); xv[6] = bflo(w.w); xv[7] = bfhi(w.w); }
            else if (sb) { const f32x4 a = *(const f32x4*)(sb + (size_t)(tt + 2) * DM + ch), c = *(const f32x4*)(sb + (size_t)(tt + 2) * DM + ch + 4);
#pragma unroll
                for (int k = 0; k < 4; ++k) { xv[k] = a[k]; xv[4 + k] = c[k]; } }
            else {
#pragma unroll
                for (int k = 0; k < 8; ++k) xv[k] = 0.f; }
            const f32x4 w0 = *(const f32x4*)(cw + jj * DM + ch), w1 = *(const f32x4*)(cw + jj * DM + ch + 4);
#pragma unroll
            for (int k = 0; k < 4; ++k) { accv[k] += xv[k] * w0[k]; accv[4 + k] += xv[4 + k] * w1[k]; }
        }
        const u32x4 g = *(const u32x4*)(BG + (size_t)row * DM + ch);
        u32x4 w; w.x = cvt_pk_bf16(accv[0] * bflo(g.x), accv[1] * bfhi(g.x)); w.y = cvt_pk_bf16(accv[2] * bflo(g.y), accv[3] * bfhi(g.y));
        w.z = cvt_pk_bf16(accv[4] * bflo(g.z), accv[5] * bfhi(g.z)); w.w = cvt_pk_bf16(accv[6] * bflo(g.w), accv[7] * bfhi(g.w));
        *(u32x4*)(YG + (size_t)row * DM + ch) = w;
        if (t >= T - 2) {
            float* dst = row < MP ? p.out + O_SCP + ((size_t)(row >> 12) * 2 + (t - (T - 2))) * DM + ch : p.out + O_SCS + ((size_t)((row - MP) >> 3) * 2 + (t - (T - 2))) * DM + ch;
            *(f32x4*)dst = (f32x4){bflo(cur.x), bfhi(cur.x), bflo(cur.y), bfhi(cur.y)}; *(f32x4*)(dst + 4) = (f32x4){bflo(cur.z), bfhi(cur.z), bflo(cur.w), bfhi(cur.w)};
        }
    }
}

#define XB_TMO      128
#define XB_XCNT(j)  (256  + 64 * (j))
#define XB_XSUB(j)  (1280 + 64 * (j))
#define XB_XGEN(j)  (2304 + 64 * (j))
#define XB_TOP      3328
#define XB_TOPGEN   3392
#define XCD_BAR_WORDS 3456
#define XB_SPIN_CAP (1u << 18)
__device__ __forceinline__ unsigned xb_ld(unsigned* p)              { return __hip_atomic_load(p, __ATOMIC_RELAXED, __HIP_MEMORY_SCOPE_AGENT); }
__device__ __forceinline__ unsigned xb_add(unsigned* p, unsigned v) { return __hip_atomic_fetch_add(p, v, __ATOMIC_RELAXED, __HIP_MEMORY_SCOPE_AGENT); }
__device__ __forceinline__ unsigned xb_xcc_id() { return (unsigned)__builtin_amdgcn_s_getreg((3 << 11) | 20) & 0xFu; }
#define XB_SPIN(cond, bar) do { unsigned _sp = 0; while (cond) { __builtin_amdgcn_s_sleep(1); \
    if ((++_sp & 255u) == 0u) { if (xb_ld(&(bar)[XB_TMO])) break; if (_sp > XB_SPIN_CAP) { atomicAdd(&(bar)[XB_TMO], 1u); break; } } } } while (0)
struct XcdBarrier { unsigned* bar; unsigned x; volatile LAS unsigned* st; };
__device__ __forceinline__ XcdBarrier xcd_barrier_post(unsigned* bar, volatile LAS unsigned* st) {
    XcdBarrier b; b.bar = bar; b.x = xb_xcc_id(); b.st = st;
    if (threadIdx.x == 0) (void)xb_add(&bar[XB_XCNT(b.x)], 1u);
    return b;
}
__device__ __forceinline__ void xcd_barrier_complete(unsigned* bar, unsigned x, unsigned& nloc, unsigned& nx) {
    const unsigned G = gridDim.x * gridDim.y * gridDim.z;
    unsigned sum, cnt, mine, sp = 0u;
    for (;;) {
        sum = 0u; cnt = 0u; mine = 0u;
#pragma unroll
        for (unsigned j = 0; j < 16; ++j) { const unsigned c = xb_ld(&bar[XB_XCNT(j)]); sum += c; cnt += (c > 0u) ? 1u : 0u; mine = (j == x) ? c : mine; }
        if (sum == G) break;
        __builtin_amdgcn_s_sleep(1);
        if ((++sp & 255u) == 0u) { if (xb_ld(&bar[XB_TMO])) break; if (sp > XB_SPIN_CAP) { atomicAdd(&bar[XB_TMO], 1u); break; } }
    }
    nloc = mine > 0u ? mine : 1u; nx = cnt > 0u ? cnt : 1u;
}
__device__ __forceinline__ void xcd_barrier(const XcdBarrier& b) {
    asm volatile("s_waitcnt vmcnt(0)" ::: "memory");
    __syncthreads();
    if (threadIdx.x == 0) {
        unsigned* bar = b.bar;
        __builtin_amdgcn_s_waitcnt(0);
        unsigned nloc = b.st[0], nx = b.st[1];
        if (nloc == 0u) { xcd_barrier_complete(bar, b.x, nloc, nx); b.st[0] = nloc; b.st[1] = nx; }
        const unsigned old = xb_add(&bar[XB_XSUB(b.x)], 1u);
        const unsigned gen = old / nloc;
        if (old + 1u == (gen + 1u) * nloc) {
            __builtin_amdgcn_fence(__ATOMIC_RELEASE, "agent");
            asm volatile("s_waitcnt vmcnt(0)" ::: "memory");
            const unsigned og = xb_add(&bar[XB_TOP], 1u);
            const unsigned tg = og / nx;
            if (og + 1u == (tg + 1u) * nx) xb_add(&bar[XB_TOPGEN], 1u);
            else XB_SPIN(xb_ld(&bar[XB_TOPGEN]) == tg, bar);
            __builtin_amdgcn_fence(__ATOMIC_ACQUIRE, "agent");
            xb_add(&bar[XB_XGEN(b.x)], 1u);
            asm volatile("s_waitcnt vmcnt(0)" ::: "memory");
        } else {
            XB_SPIN(xb_ld(&bar[XB_XGEN(b.x)]) == gen, bar);
            __builtin_amdgcn_fence(__ATOMIC_ACQUIRE, "agent");
            asm volatile("s_waitcnt vmcnt(0)" ::: "memory");
        }
    }
    __syncthreads();
}

enum Op { OP_PREP, OP_QKV, OP_ATTN, OP_RG1, OP_RGCONV, OP_RGGATES, OP_RGSCAN, OP_SC1, OP_SCCONV, OP_RESID_MIX, OP_NORM_F, OP_FFNUP, OP_RESID_FFN, OP_NORM_M };
constexpr int NSTEPS = 31;

__global__ void __launch_bounds__(512, 2) mega_fwd(Params p) {
    extern __shared__ __attribute__((aligned(16))) unsigned char lds_raw[];
    LAS unsigned char* lds = (LAS unsigned char*)lds_raw;
    const int G0 = gridDim.x, bx = blockIdx.x;
    volatile LAS unsigned* MISC = (volatile LAS unsigned*)(lds + 131072);
    if (threadIdx.x < 32) MISC[threadIdx.x] = 0u;
    __syncthreads();
    XcdBarrier bar = xcd_barrier_post((unsigned*)p.ws, MISC + 8);
    const int vcu0 = (G0 % 8 == 0) ? (bx % 8) * (G0 / 8) + bx / 8 : bx;
#if REP_MASK
    for (int it_ = 2 * p.ph_lo; it_ < 2 * p.ph_hi; ++it_) { const int step = it_ >> 1;
#else
    for (int step = p.ph_lo; step < p.ph_hi; ++step) {
#endif
        int tid = threadIdx.x, G = G0, vcu = vcu0; unsigned char* ws = p.ws; float* X = p.out;
        asm volatile("" : "+v"(tid)); asm volatile("" : "+s"(G)); asm volatile("" : "+s"(vcu)); asm volatile("" : "+s"(ws)); asm volatile("" : "+s"(X));
        bf16_t* XN = (bf16_t*)(ws + WS_XN);
        float* PART = (float*)(ws + WS_S3);
        int op, layer = 0;
        if (step == 0) op = OP_PREP;
        else {
            int s = step - 1, li;
            if (s < 7) { layer = 0; li = s; } else if (s < 16) { layer = 1; li = s - 7; } else if (s < 23) { layer = 2; li = s - 16; } else { layer = 3; li = s - 23; }
            const int kind = layer % 3, nmix = kind == 1 ? 4 : 2;
            if (li < nmix) op = kind == 0 ? (li == 0 ? OP_QKV : OP_ATTN) : kind == 1 ? (OP_RG1 + li) : (li == 0 ? OP_SC1 : OP_SCCONV);
            else op = OP_RESID_MIX + (li - nmix);
        }
        const int kind = layer % 3, j = layer / 3;
#if REP_MASK
        if ((it_ & 1) && !((REP_MASK >> op) & 1)) continue;
#endif
        pg8::GSched S; S.G = G; S.c = vcu; S.c2 = (int)blockIdx.x; S.mode = 0; S.nsplit = NSPLIT_MIX; S.lda = DM; S.ldb = DM; S.nt = 16; S.A = (const char*)XN;
        switch (op) {
        case OP_PREP: prep_phase(p, lds, vcu, G, tid); break;
        case OP_QKV: { S.Bt = (const char*)(ws + WS_WQKV + (size_t)j * NQKV * 1024 * 2); S.nN = 5;
            pg8::EpiQKV E{(bf16_t*)(ws + WS_S0), p.in[11] + j * NQKV, (const float*)(ws + WS_ROPE), (const float*)(ws + WS_RSTD)};
            pg8::gemm_phase<DM, DM>(lds, S, E, tid);
            if (layer == 0) convert_in_slack(p, ws, lds, 1, 68 * 5, vcu, G, tid); } break;
        case OP_ATTN: attn_phase(p, lds, j, vcu, G, tid); break;
        case OP_RG1: { S.Bt = (const char*)(ws + WS_WRG1); S.nN = 8;
            pg8::EpiPair<1> E{(bf16_t*)(ws + WS_S0), (bf16_t*)(ws + WS_S1), (const float*)(ws + WS_RSTD)};
            pg8::gemm_phase<DM, DM>(lds, S, E, tid);
            convert_in_slack(p, ws, lds, 2, 68 * 8, vcu, G, tid); } break;
        case OP_RGCONV: rgconv_phase(p, vcu, G, tid); break;
        case OP_RGGATES: { S.A = (const char*)(ws + WS_S3); S.Bt = (const char*)(ws + WS_WRG2); S.ldb = 256; S.nN = 8; S.nt = 4; S.mode = 2;
            pg8::EpiRgGates E{(const bf16_t*)(ws + WS_S3), (bf16_t*)(ws + WS_S1), (bf16_t*)(ws + WS_S2), p.in[20], p.in[22], (const float*)(ws + WS_C8)};
            pg8::gemm_phase<DM, 256>(lds, S, E, tid);
            convert_in_slack(p, ws, lds, 3, 68 * 8, vcu, G, tid); } break;
        case OP_RGSCAN: rgscan_phase(p, lds, vcu, G, tid); break;
        case OP_SC1: { S.Bt = (const char*)(ws + WS_WSC1); S.nN = 12;
            pg8::EpiPair<2> E{(bf16_t*)(ws + WS_S0), (bf16_t*)(ws + WS_S1), (const float*)(ws + WS_RSTD)};
            pg8::gemm_phase<DM, DM>(lds, S, E, tid);
            convert_in_slack(p, ws, lds, 4, 68 * 12, vcu, G, tid); } break;
        case OP_SCCONV: scconv_phase(p, vcu, G, tid); break;
        case OP_RESID_MIX: {
            const float* bias = (const float*)(ws + WS_ZB); S.nN = 4; S.mode = 1;
            if (kind == 0) { S.A = (const char*)(ws + WS_S2); S.Bt = (const char*)(ws + WS_WO + (size_t)j * 1024 * 1024 * 2); bias = p.in[13] + j * DM; }
            else if (kind == 1) { S.A = (const char*)(ws + WS_S0); S.Bt = (const char*)(ws + WS_WRG3); }
            else { S.A = (const char*)(ws + WS_S2); S.Bt = (const char*)(ws + WS_WSC2); }
            if (layer == 0) { pg8::EpiResid<true> E{p.in[0], PART, bias, XN, (float*)(ws + WS_SS)}; pg8::gemm_phase<DM, DM>(lds, S, E, tid); }
            else { pg8::EpiResid<false> E{nullptr, PART, bias, XN, (float*)(ws + WS_SS)}; pg8::gemm_phase<DM, DM>(lds, S, E, tid); }
            } break;
        case OP_RESID_FFN: {
            S.nN = 4; S.mode = 1; S.nsplit = NSPLIT_FFN; S.A = (const char*)(ws + WS_S0); S.lda = DFF; S.ldb = DFF; S.nt = 44; S.Bt = (const char*)(ws + WS_WFD + (size_t)layer * 1024 * DFF * 2);
            pg8::EpiResid<false> E{nullptr, PART, (const float*)(ws + WS_ZB), XN, (float*)(ws + WS_SS)};
            pg8::gemm_phase<DFF, DFF>(lds, S, E, tid); } break;
        case OP_NORM_F: fin_phase(layer == 0 ? p.in[1] : X + (size_t)MP * DM, X, PART, NSPLIT_MIX, kind == 0 ? p.in[13] + j * DM : nullptr, XN, (const float*)(ws + WS_SS), (float*)(ws + WS_RSTD), vcu, G, tid); break;
        case OP_FFNUP: { S.Bt = (const char*)(ws + WS_WFU + (size_t)layer * 5632 * 1024 * 2); S.nN = 22;
            pg8::EpiPair<0> E{(bf16_t*)(ws + WS_S0), nullptr, (const float*)(ws + WS_RSTD)};
            pg8::gemm_phase<DM, DM>(lds, S, E, tid); } break;
        case OP_NORM_M: if (layer == 3) norm_phase(X, PART, NSPLIT_FFN, nullptr, p.in[9], XN, true, vcu, G, tid);
                        else fin_phase(X + (size_t)MP * DM, X, PART, NSPLIT_FFN, nullptr, XN, (const float*)(ws + WS_SS), (float*)(ws + WS_RSTD), vcu, G, tid);
                        break;
        }
#if REP_MASK
        xcd_barrier(bar);
#else
        if (step + 1 < p.ph_hi) xcd_barrier(bar);
#endif
#if EXTRA_SYNC
        xcd_barrier(bar);
#endif
    }
}

#ifndef MK_N_LAUNCHES
#define MK_N_LAUNCHES 1
#endif
extern "C" void kernel_launch(void* const* d_in, const int* in_sizes, int n_in, void* d_out, int out_size, void* d_ws, size_t ws_size, hipStream_t stream) {
    static int grid = 0;
    if (grid == 0) {
        int dev = 0, cus = 0, per_cu = 0;
        hipGetDevice(&dev);
        hipDeviceGetAttribute(&cus, hipDeviceAttributeMultiprocessorCount, dev);
        hipFuncSetAttribute((const void*)mega_fwd, hipFuncAttributeMaxDynamicSharedMemorySize, LDS_BYTES);
        hipOccupancyMaxActiveBlocksPerMultiprocessor(&per_cu, (const void*)mega_fwd, 512, LDS_BYTES);
        if (per_cu < 1) { fprintf(stderr, "kernel_launch: occupancy query reports %d blocks per CU\n", per_cu); per_cu = 1; }
        if (per_cu > 1) per_cu = 1;
        grid = cus * per_cu;
        if (n_in != 31 || ws_size < 268 * MiB) fprintf(stderr, "kernel_launch: unexpected n_in %d / ws_size %zu\n", n_in, ws_size);
    }
    hipMemsetAsync(d_ws, 0, 16384, stream);
    Params p{};
    for (int i = 0; i < 31; ++i) p.in[i] = (const float*)d_in[i];
    p.out = (float*)d_out; p.ws = (unsigned char*)d_ws;
    const int nl = MK_N_LAUNCHES;
    for (int li = 0; li < nl; ++li) {
        p.ph_lo = (int)((long)NSTEPS * li / nl); p.ph_hi = (int)((long)NSTEPS * (li + 1) / nl);
        void* args[] = {&p};
        hipError_t e = hipLaunchCooperativeKernel((const void*)mega_fwd, dim3(grid), dim3(512), args, LDS_BYTES, stream);
        if (e != hipSuccess) fprintf(stderr, "cooperative launch failed: %s (grid %d)\n", hipGetErrorString(e), grid);
    }
}
```

```cpp
#include <hip/hip_runtime.h>
#include <hip/hip_cooperative_groups.h>
#include <cstdint>
#include <cstdio>
namespace cg = cooperative_groups;
#ifndef REP_MASK
#define REP_MASK 0
#endif
constexpr int NSPLIT_MIX = 4, NSPLIT_FFN = 8;
#ifndef EXTRA_SYNC
#define EXTRA_SYNC 0
#endif

#define LAS __attribute__((address_space(3)))
typedef unsigned short bf16_t;
typedef short bf16x8 __attribute__((ext_vector_type(8)));
typedef short s16x4 __attribute__((ext_vector_type(4)));
typedef float f32x4 __attribute__((ext_vector_type(4)));
typedef float f32x2 __attribute__((ext_vector_type(2)));
typedef float f32x16 __attribute__((ext_vector_type(16)));
typedef unsigned u32x4 __attribute__((ext_vector_type(4)));
typedef unsigned u32x2 __attribute__((ext_vector_type(2)));

constexpr int DM = 1024, MP = 16384, MS = 1024, M = MP + MS, SEQ = 4096, DFF = 2816, NQKV = 1280;
constexpr float EPS = 1e-6f, LOG2E = 1.4426950408889634f;
constexpr size_t MiB = 1u << 20;
constexpr size_t WS_ROPE = 1 * MiB;
constexpr size_t WS_RSTD = 4 * MiB;
constexpr size_t WS_SS = 5 * MiB;
constexpr size_t WS_ZB = 3 * MiB + 65536;
constexpr size_t WS_C8 = 3 * MiB;
constexpr size_t WS_WQKV = 8 * MiB;
constexpr size_t WS_WO = 13 * MiB;
constexpr size_t WS_WFU = 17 * MiB;
constexpr size_t WS_WFD = 61 * MiB;
constexpr size_t WS_WRG1 = 83 * MiB, WS_WRG2 = 87 * MiB, WS_WRG3 = 88 * MiB, WS_WSC1 = 90 * MiB, WS_WSC2 = 96 * MiB;
constexpr size_t WS_XN = 98 * MiB;
constexpr size_t SLOT = 34 * MiB;
constexpr size_t WS_S0 = 132 * MiB, WS_S1 = WS_S0 + SLOT, WS_S2 = WS_S1 + SLOT, WS_S3 = WS_S2 + SLOT;
constexpr size_t O_KP = 17825792, O_VP = 17956864, O_KS = 18087936, O_VS = 22282240, O_HP = 26476544, O_HS = 26480640,
                 O_RCP = 26611712, O_RCS = 26624000, O_SCP = 27017216, O_SCS = 27025408;

constexpr int LDS_BYTES = 131072 + 1024;

__device__ __forceinline__ unsigned cvt_pk_bf16(float lo, float hi) { unsigned r; asm volatile("v_cvt_pk_bf16_f32 %0, %1, %2" : "=v"(r) : "v"(lo), "v"(hi)); return r; }
__device__ __forceinline__ float bf2f(unsigned short v) { return __uint_as_float(((unsigned)v) << 16); }
__device__ __forceinline__ float bflo(unsigned w) { return __uint_as_float(w << 16); }
__device__ __forceinline__ float bfhi(unsigned w) { return __uint_as_float(w & 0xffff0000u); }
__device__ __forceinline__ float fast_sigmoid(float x) { return __builtin_amdgcn_rcpf(1.0f + __builtin_amdgcn_exp2f(-x * LOG2E)); }
__device__ __forceinline__ float wave_sum(float v) {
#pragma unroll
    for (int o = 1; o < 64; o <<= 1) v += __shfl_xor(v, o);
    return v;
}

namespace pg8 {
constexpr int BM = 256, BK = 64, HALF = 128, HTB = HALF * BK * 2, STAGE_BYTES = 8 * HTB;
__device__ __forceinline__ int lds_byte(int r, int c) { const int st = (r >> 4) * 2 + (c >> 5), rr = r & 15, cc = c & 31, ob = rr * 64 + cc * 2; return st * 1024 + (ob ^ (((ob >> 9) & 1) << 5)); }
__device__ __forceinline__ void stage_rc(int b, int& R, int& C) { const int st = b / 1024, sb = b % 1024, swz = sb ^ (((sb >> 9) & 1) << 5); R = (st >> 1) * 16 + swz / 64; C = (st & 1) * 32 + (swz % 64) / 2; }
__device__ __forceinline__ int perm32(int rho) { const int n = rho >> 4, i = rho & 15; return 8 * (i >> 2) + 4 * n + (i & 3); }

struct Unit { int pm, pn, nt, aux; const char* a; const char* b; };

struct GSched {
    const char* A; const char* Bt; int lda, ldb, nN, nt, mode, G, c, nsplit, c2;
    __device__ __forceinline__ bool next(int i, Unit& u) const {
        int L = i * G + c; const int nP = 64 * nN; int kt0 = 0; u.nt = nt; u.aux = 0;
        if (mode == 1) {
            const int nS = 4 * nsplit * nN;
            const bool hasS = (nS <= G) && (c2 < nS);
            if (nS <= G) {
                if (hasS && i == 0) L = c2; else L = nS + (i - (hasS ? 1 : 0)) * G + c;
            }
            if (L < nS) {
                const int sl = L % nsplit; u.pn = (L / nsplit) % nN; u.pm = 64 + (L / nsplit) / nN; u.aux = 1 + sl;
                const int q = (nt / (2 * nsplit)) * 2, extra = (nt - nsplit * q) >> 1;
                u.nt = sl < extra ? q + 2 : q; kt0 = sl < extra ? sl * (q + 2) : extra * (q + 2) + (sl - extra) * q;
            } else {
                L -= nS; if (L >= nP) return false;
                const int g = L / (8 * nN), r = L - g * 8 * nN; u.pm = 8 * g + (r & 7); u.pn = r >> 3;
            }
        } else if (L < nP) { const int g = L / (8 * nN), r = L - g * 8 * nN; u.pm = 8 * g + (r & 7); u.pn = r >> 3; }
        else { L -= nP; if (L >= 4 * nN) return false; u.pm = 64 + (L & 3); u.pn = L >> 2; }
        u.a = A + ((size_t)u.pm * 256 * lda + (size_t)kt0 * 64 + (mode == 2 ? 256 * (u.pn >> 1) : 0)) * 2;
        u.b = Bt + ((size_t)u.pn * 256 * ldb + (size_t)kt0 * 64) * 2;
        return true;
    }
};

template <int LDA, int LDB, class Epi>
__device__ __forceinline__ void gemm_phase(LAS unsigned char* lds, const GSched& S, const Epi& E, const int tid) {
    const int wid = __builtin_amdgcn_readfirstlane(tid >> 6), lane = tid & 63, wr = wid >> 2, wc = wid & 3, fr = lane & 15, fq = lane >> 4;
    constexpr int lda = LDA, ldb = LDB;
    unsigned voffA[2], voffB[2];
#pragma unroll
    for (int i = 0; i < 2; ++i) { int R, C; stage_rc(tid * 16 + i * 8192, R, C); const int Rb = Epi::PERM ? ((R & ~31) + perm32(R & 31)) : R;
        voffA[i] = (unsigned)(R * lda + C) * 2u; voffB[i] = (unsigned)(Rb * ldb + C) * 2u; }
    const size_t kstep = (size_t)(BK * 2);
    const size_t hstepA = (size_t)HALF * lda * 2, hstepB = (size_t)HALF * ldb * 2;
    const unsigned ldsw = (unsigned)wid * 1024u;
    const int aoff = lds_byte(wr * 64 + fr, fq * 8), boff = lds_byte(wc * 32 + fr, fq * 8);
#define PG8_SA(b, h) (((b) * 2 + (h)) * HTB)
#define PG8_SB(b, h) ((4 + (b) * 2 + (h)) * HTB)
#define PG8_STAGE(bufoff, gbase, voff) do { _Pragma("unroll") for (int _i = 0; _i < 2; ++_i) \
        __builtin_amdgcn_global_load_lds((const unsigned*)((const char*)(gbase) + (voff)[_i]), (LAS unsigned*)(lds + (bufoff) + ldsw + _i * 8192), 16, 0, 0); } while (0)
#define PG8_LDA(dst, b, h) do { _Pragma("unroll") for (int m = 0; m < 4; ++m) _Pragma("unroll") for (int k = 0; k < 2; ++k) dst[m][k] = *(const LAS bf16x8*)(lds + PG8_SA(b, h) + aoff + m * 2048 + k * 1024); } while (0)
#define PG8_LDB(dst, b, h) do { _Pragma("unroll") for (int n = 0; n < 2; ++n) _Pragma("unroll") for (int k = 0; k < 2; ++k) dst[n][k] = *(const LAS bf16x8*)(lds + PG8_SB(b, h) + boff + n * 2048 + k * 1024); } while (0)
#define PG8_MMA(ai, bj, At, Bt) do { __builtin_amdgcn_s_setprio(1); _Pragma("unroll") for (int m = 0; m < 4; ++m) _Pragma("unroll") for (int n = 0; n < 2; ++n) _Pragma("unroll") for (int k = 0; k < 2; ++k) \
        acc[ai][bj][m][n] = __builtin_amdgcn_mfma_f32_16x16x32_bf16(Bt[n][k], At[m][k], acc[ai][bj][m][n], 0, 0, 0); __builtin_amdgcn_s_setprio(0); } while (0)
#define PG8_WAIT_V(n) asm volatile("s_waitcnt vmcnt(" #n ")" ::: "memory")
#define PG8_WAIT_L(n) asm volatile("s_waitcnt lgkmcnt(" #n ")" ::: "memory")
#define PG8_BAR __builtin_amdgcn_s_barrier()
#define PG8_SCHED __builtin_amdgcn_sched_barrier(0)
    Unit cur, nxt; int ui = 0;
    if (!S.next(0, cur)) return;
    f32x4 acc[2][2][4][2];
#pragma unroll
    for (int a = 0; a < 2; ++a)
#pragma unroll
        for (int b = 0; b < 2; ++b)
#pragma unroll
            for (int m = 0; m < 4; ++m)
#pragma unroll
                for (int n = 0; n < 2; ++n) acc[a][b][m][n] = (f32x4){0.f, 0.f, 0.f, 0.f};
    bf16x8 At[4][2], B0[2][2], B1[2][2];
    const char* cA = cur.a; const char* cB = cur.b;
    PG8_STAGE(PG8_SB(0, 0), cB, voffB); PG8_STAGE(PG8_SB(0, 1), cB + hstepB, voffB); PG8_STAGE(PG8_SA(0, 0), cA, voffA); PG8_STAGE(PG8_SA(0, 1), cA + hstepA, voffA);
    if (wr == 1) PG8_BAR;
    PG8_WAIT_V(2); PG8_BAR;
    PG8_STAGE(PG8_SB(1, 0), cB + kstep, voffB); PG8_STAGE(PG8_SA(1, 0), cA + kstep, voffA); PG8_STAGE(PG8_SB(1, 1), cB + hstepB + kstep, voffB);
    PG8_WAIT_V(6); PG8_BAR;
    for (;;) {
        const bool has_next = S.next(ui + 1, nxt);
        const char* nA = has_next ? nxt.a : cA; const char* nB = has_next ? nxt.b : cB;
        const int nt = cur.nt;
        for (int t = 0; t < nt; t += 2) {
            const bool last = (t == nt - 2);
            const char* a1 = cA + (size_t)(t + 1) * kstep;
            const char* a2 = last ? nA : cA + (size_t)(t + 2) * kstep; const char* b2 = last ? nB : cB + (size_t)(t + 2) * kstep;
            const char* a3 = a2 + kstep; const char* b3 = b2 + kstep;
            PG8_LDB(B0, 0, 0); PG8_LDB(B1, 0, 1); PG8_SCHED; PG8_LDA(At, 0, 0); PG8_STAGE(PG8_SA(1, 1), a1 + hstepA, voffA);
            PG8_WAIT_V(8); PG8_WAIT_L(0); PG8_BAR; PG8_MMA(0, 0, At, B0); PG8_MMA(0, 1, At, B1); PG8_BAR; PG8_SCHED;
            PG8_LDA(At, 0, 1); PG8_STAGE(PG8_SB(0, 0), b2, voffB); PG8_STAGE(PG8_SB(0, 1), b2 + hstepB, voffB); PG8_STAGE(PG8_SA(0, 0), a2, voffA);
            PG8_WAIT_V(8); PG8_WAIT_L(0); PG8_BAR; PG8_MMA(1, 0, At, B0); PG8_MMA(1, 1, At, B1); PG8_BAR; PG8_SCHED;
            PG8_LDB(B0, 1, 0); PG8_LDB(B1, 1, 1); PG8_SCHED; PG8_LDA(At, 1, 0); PG8_STAGE(PG8_SA(0, 1), a2 + hstepA, voffA);
            PG8_WAIT_V(8); PG8_WAIT_L(0); PG8_BAR; PG8_MMA(0, 0, At, B0); PG8_MMA(0, 1, At, B1); PG8_BAR; PG8_SCHED;
            PG8_LDA(At, 1, 1); PG8_STAGE(PG8_SB(1, 0), b3, voffB); PG8_STAGE(PG8_SB(1, 1), b3 + hstepB, voffB); PG8_STAGE(PG8_SA(1, 0), a3, voffA);
            PG8_WAIT_V(8); PG8_WAIT_L(0); PG8_BAR; PG8_MMA(1, 0, At, B0); PG8_MMA(1, 1, At, B1); PG8_BAR; PG8_SCHED;
        }
        if (wr == 0) PG8_BAR;
        E(acc, cur, wr, wc, fr, fq);
        if (!has_next) break;
#pragma unroll
        for (int a = 0; a < 2; ++a)
#pragma unroll
            for (int b = 0; b < 2; ++b)
#pragma unroll
                for (int m = 0; m < 4; ++m)
#pragma unroll
                    for (int n = 0; n < 2; ++n) acc[a][b][m][n] = (f32x4){0.f, 0.f, 0.f, 0.f};
        cur = nxt; cA = nA; cB = nB; ++ui;
        if (wr == 1) PG8_BAR;
    }
    PG8_WAIT_V(0);
    PG8_BAR;
#undef PG8_SA
#undef PG8_SB
#undef PG8_STAGE
#undef PG8_LDA
#undef PG8_LDB
#undef PG8_MMA
#undef PG8_WAIT_V
#undef PG8_WAIT_L
#undef PG8_BAR
#undef PG8_SCHED
}

struct EpiQKV {
    static constexpr bool PERM = true;
    bf16_t* O; const float* bias; const float* rope; const float* rstd;
    __device__ __forceinline__ void operator()(const f32x4 (&acc)[2][2][4][2], const Unit& u, int wr, int wc, int fr, int fq) const {
        const int H = 4 * u.pn + wc, colb = H * 64 + 8 * fq;
        const f32x4 bl0 = *(const f32x4*)(bias + colb), bl1 = *(const f32x4*)(bias + colb + 4), bh0 = *(const f32x4*)(bias + colb + 32), bh1 = *(const f32x4*)(bias + colb + 36);
        const bool rot = H < 18;
        const int row0 = u.pm * 256 + wr * 64 + fr;
        float rs[8];
#pragma unroll
        for (int g = 0; g < 8; ++g) rs[g] = rstd[row0 + (g >> 2) * 128 + (g & 3) * 16];
        f32x4 cs[2][4];
#define QKV_LOADCS(g, b) do { const int row_ = row0 + ((g) >> 2) * 128 + ((g) & 3) * 16; const int pidx_ = row_ < MP ? (row_ & (SEQ - 1)) : SEQ + ((row_ - MP) & 7); \
            const float* rp_ = rope + (size_t)pidx_ * 64 + 8 * fq; cs[b][0] = *(const f32x4*)(rp_); cs[b][1] = *(const f32x4*)(rp_ + 4); cs[b][2] = *(const f32x4*)(rp_ + 32); cs[b][3] = *(const f32x4*)(rp_ + 36); } while (0)
        QKV_LOADCS(0, 0);
#pragma unroll
        for (int g = 0; g < 8; ++g) {
            const int ai = g >> 2, m = g & 3, b = g & 1;
            if (g + 1 < 8) QKV_LOADCS(g + 1, b ^ 1);
            const int row = row0 + ai * 128 + m * 16;
            f32x4 c0 = cs[b][0], c1 = cs[b][1], s0 = cs[b][2], s1 = cs[b][3];
            if (!rot) { c0 = (f32x4){1.f, 1.f, 1.f, 1.f}; c1 = c0; s0 = (f32x4){0.f, 0.f, 0.f, 0.f}; s1 = s0; }
            const float r = rs[g];
            const f32x4 l0 = acc[ai][0][m][0] * r + bl0, l1 = acc[ai][0][m][1] * r + bl1, h0 = acc[ai][1][m][0] * r + bh0, h1 = acc[ai][1][m][1] * r + bh1;
            const f32x4 ol0 = l0 * c0 - h0 * s0, ol1 = l1 * c1 - h1 * s1, oh0 = h0 * c0 + l0 * s0, oh1 = h1 * c1 + l1 * s1;
            bf16_t* op = O + (size_t)row * NQKV + colb;
            u32x4 w; w.x = cvt_pk_bf16(ol0[0], ol0[1]); w.y = cvt_pk_bf16(ol0[2], ol0[3]); w.z = cvt_pk_bf16(ol1[0], ol1[1]); w.w = cvt_pk_bf16(ol1[2], ol1[3]);
            *(u32x4*)op = w;
            w.x = cvt_pk_bf16(oh0[0], oh0[1]); w.y = cvt_pk_bf16(oh0[2], oh0[3]); w.z = cvt_pk_bf16(oh1[0], oh1[1]); w.w = cvt_pk_bf16(oh1[2], oh1[3]);
            *(u32x4*)(op + 32) = w;
        }
#undef QKV_LOADCS
    }
};
template <int MODE> struct EpiPair {
    static constexpr bool PERM = true;
    bf16_t* O0; bf16_t* O1; const float* rstd;
    __device__ __forceinline__ void operator()(const f32x4 (&acc)[2][2][4][2], const Unit& u, int wr, int wc, int fr, int fq) const {
        const int cc = 32 * wc + 8 * fq;
        float rsv[8];
#pragma unroll
        for (int g = 0; g < 8; ++g) rsv[g] = rstd[u.pm * 256 + wr * 64 + fr + (g >> 2) * 128 + (g & 3) * 16];
#pragma unroll
        for (int ai = 0; ai < 2; ++ai)
#pragma unroll
            for (int m = 0; m < 4; ++m) {
                const size_t row = (size_t)(u.pm * 256 + ai * 128 + wr * 64 + m * 16 + fr);
                const float rs = rsv[ai * 4 + m];
                f32x4 p0 = acc[ai][0][m][0] * rs, p1 = acc[ai][0][m][1] * rs, q0 = acc[ai][1][m][0] * rs, q1 = acc[ai][1][m][1] * rs;
                u32x4 w;
                if (MODE == 0) {
                    const float c1 = -rs * LOG2E, c2 = rs * rs;
                    const f32x4 a0 = acc[ai][0][m][0], a1 = acc[ai][0][m][1], b0 = acc[ai][1][m][0], b1 = acc[ai][1][m][1];
                    f32x4 t0 = a0 * c1, t1 = a1 * c1;
#pragma unroll
                    for (int j = 0; j < 4; ++j) { t0[j] = __builtin_amdgcn_exp2f(t0[j]); t1[j] = __builtin_amdgcn_exp2f(t1[j]); }
                    t0 = t0 + 1.0f; t1 = t1 + 1.0f;
#pragma unroll
                    for (int j = 0; j < 4; ++j) { t0[j] = __builtin_amdgcn_rcpf(t0[j]); t1[j] = __builtin_amdgcn_rcpf(t1[j]); }
                    p0 = (a0 * b0) * c2 * t0; p1 = (a1 * b1) * c2 * t1;
                    w.x = cvt_pk_bf16(p0[0], p0[1]); w.y = cvt_pk_bf16(p0[2], p0[3]); w.z = cvt_pk_bf16(p1[0], p1[1]); w.w = cvt_pk_bf16(p1[2], p1[3]);
                    *(u32x4*)(O0 + row * DFF + 128 * u.pn + cc) = w;
                } else if (MODE == 1) {
#pragma unroll
                    for (int j = 0; j < 4; ++j) { float x = p0[j]; p0[j] = x * fast_sigmoid(1.5957691216f * (x + 0.044715f * x * x * x)); x = p1[j]; p1[j] = x * fast_sigmoid(1.5957691216f * (x + 0.044715f * x * x * x)); }
                    w.x = cvt_pk_bf16(p0[0], p0[1]); w.y = cvt_pk_bf16(p0[2], p0[3]); w.z = cvt_pk_bf16(p1[0], p1[1]); w.w = cvt_pk_bf16(p1[2], p1[3]);
                    *(u32x4*)(O0 + row * DM + 128 * u.pn + cc) = w;
                    w.x = cvt_pk_bf16(q0[0], q0[1]); w.y = cvt_pk_bf16(q0[2], q0[3]); w.z = cvt_pk_bf16(q1[0], q1[1]); w.w = cvt_pk_bf16(q1[2], q1[3]);
                    *(u32x4*)(O1 + row * DM + 128 * u.pn + cc) = w;
                } else {
                    if (u.pn < 8) {
                        p0 = p0 * q0; p1 = p1 * q1;
                        w.x = cvt_pk_bf16(p0[0], p0[1]); w.y = cvt_pk_bf16(p0[2], p0[3]); w.z = cvt_pk_bf16(p1[0], p1[1]); w.w = cvt_pk_bf16(p1[2], p1[3]);
                        *(u32x4*)(O0 + row * DM + 128 * u.pn + cc) = w;
                    } else {
                        w.x = cvt_pk_bf16(p0[0], p0[1]); w.y = cvt_pk_bf16(p0[2], p0[3]); w.z = cvt_pk_bf16(p1[0], p1[1]); w.w = cvt_pk_bf16(p1[2], p1[3]);
                        *(u32x4*)(O1 + row * DM + 256 * (u.pn - 8) + cc) = w;
                        w.x = cvt_pk_bf16(q0[0], q0[1]); w.y = cvt_pk_bf16(q0[2], q0[3]); w.z = cvt_pk_bf16(q1[0], q1[1]); w.w = cvt_pk_bf16(q1[2], q1[3]);
                        *(u32x4*)(O1 + row * DM + 256 * (u.pn - 8) + 128 + cc) = w;
                    }
                }
            }
    }
};
struct EpiRgGates {
    static constexpr bool PERM = true;
    const bf16_t* U; bf16_t* LA; bf16_t* Bv; const float* ba; const float* bx; const float* c8;
    __device__ __forceinline__ void operator()(const f32x4 (&acc)[2][2][4][2], const Unit& u, int wr, int wc, int fr, int fq) const {
        const int ch = 128 * u.pn + 32 * wc + 8 * fq;
        f32x4 vba[2], vbx[2], vc8[2];
#pragma unroll
        for (int n = 0; n < 2; ++n) { vba[n] = *(const f32x4*)(ba + ch + 4 * n); vbx[n] = *(const f32x4*)(bx + ch + 4 * n); vc8[n] = *(const f32x4*)(c8 + ch + 4 * n); }
        u32x4 uws[8];
#pragma unroll
        for (int g = 0; g < 8; ++g) uws[g] = *(const u32x4*)(U + (size_t)(u.pm * 256 + (g >> 2) * 128 + wr * 64 + (g & 3) * 16 + fr) * DM + ch);
#pragma unroll
        for (int ai = 0; ai < 2; ++ai)
#pragma unroll
            for (int m = 0; m < 4; ++m) {
                const size_t off = (size_t)(u.pm * 256 + ai * 128 + wr * 64 + m * 16 + fr) * DM + ch;
                const u32x4 uw = uws[ai * 4 + m];
                float la[8], bb[8];
#pragma unroll
                for (int n = 0; n < 2; ++n)
#pragma unroll
                    for (int j = 0; j < 4; ++j) {
                        const float r = fast_sigmoid(acc[ai][0][m][n][j] + vba[n][j]), ig = fast_sigmoid(acc[ai][1][m][n][j] + vbx[n][j]);
                        const float l2 = vc8[n][j] * r; const float a2 = __builtin_amdgcn_exp2f(2.f * l2);
                        const unsigned uu = uw[n * 2 + (j >> 1)]; const float uv = (j & 1) ? bfhi(uu) : bflo(uu);
                        la[n * 4 + j] = l2; bb[n * 4 + j] = __builtin_sqrtf(fmaxf(1.f - a2, 0.f)) * ig * uv;
                    }
                u32x4 w; w.x = cvt_pk_bf16(la[0], la[1]); w.y = cvt_pk_bf16(la[2], la[3]); w.z = cvt_pk_bf16(la[4], la[5]); w.w = cvt_pk_bf16(la[6], la[7]);
                *(u32x4*)(LA + off) = w;
                w.x = cvt_pk_bf16(bb[0], bb[1]); w.y = cvt_pk_bf16(bb[2], bb[3]); w.z = cvt_pk_bf16(bb[4], bb[5]); w.w = cvt_pk_bf16(bb[6], bb[7]);
                *(u32x4*)(Bv + off) = w;
            }
    }
};
template <bool FIRST> struct EpiResid {
    static constexpr bool PERM = true;
    const float* Xin; float* PART; const float* bias; bf16_t* XB; float* SS;
    __device__ __forceinline__ void operator()(const f32x4 (&acc)[2][2][4][2], const Unit& u, int wr, int wc, int fr, int fq) const {
        const int col0 = u.pn * 256 + wc * 32 + 8 * fq;
        if (u.aux == 0) {
            f32x4 bv[2][2];
#pragma unroll
            for (int bj = 0; bj < 2; ++bj)
#pragma unroll
                for (int n = 0; n < 2; ++n) bv[bj][n] = *(const f32x4*)(bias + col0 + bj * 128 + 4 * n);
            const size_t row0 = (size_t)(u.pm * 256 + wr * 64 + fr);
            f32x4 xin[2][4];
#define RES_LOAD(g, b) do { if (FIRST) { const float* xp_ = Xin + (row0 + ((g) >> 2) * 128 + ((g) & 3) * 16) * DM + col0; \
                    xin[b][0] = __builtin_nontemporal_load((const f32x4*)(xp_)); xin[b][1] = __builtin_nontemporal_load((const f32x4*)(xp_ + 4)); xin[b][2] = __builtin_nontemporal_load((const f32x4*)(xp_ + 128)); xin[b][3] = __builtin_nontemporal_load((const f32x4*)(xp_ + 132)); } \
                else { const bf16_t* xp_ = XB + (row0 + ((g) >> 2) * 128 + ((g) & 3) * 16) * DM + col0; \
                    _Pragma("unroll") for (int q_ = 0; q_ < 2; ++q_) { const u32x4 w_ = *(const u32x4*)(xp_ + q_ * 128); \
                        xin[b][2 * q_] = (f32x4){bflo(w_.x), bfhi(w_.x), bflo(w_.y), bfhi(w_.y)}; xin[b][2 * q_ + 1] = (f32x4){bflo(w_.z), bfhi(w_.z), bflo(w_.w), bfhi(w_.w)}; } } } while (0)
            RES_LOAD(0, 0);
#pragma unroll
            for (int g = 0; g < 8; ++g) {
                const int ai = g >> 2, m = g & 3, b = g & 1;
                if (g + 1 < 8) RES_LOAD(g + 1, b ^ 1);
                const size_t row = row0 + ai * 128 + m * 16;
                bf16_t* bp = XB + row * DM + col0;
                float ss = 0.f;
#pragma unroll
                for (int bj = 0; bj < 2; ++bj) {
                    const f32x4 v0 = xin[b][bj * 2] + acc[ai][bj][m][0] + bv[bj][0], v1 = xin[b][bj * 2 + 1] + acc[ai][bj][m][1] + bv[bj][1];
                    u32x4 w; w.x = cvt_pk_bf16(v0[0], v0[1]); w.y = cvt_pk_bf16(v0[2], v0[3]); w.z = cvt_pk_bf16(v1[0], v1[1]); w.w = cvt_pk_bf16(v1[2], v1[3]);
                    *(u32x4*)(bp + bj * 128) = w;
                    ss += ((v0[0] * v0[0] + v0[1] * v0[1]) + (v0[2] * v0[2] + v0[3] * v0[3])) + ((v1[0] * v1[0] + v1[1] * v1[1]) + (v1[2] * v1[2] + v1[3] * v1[3]));
                }
                ss += __shfl_xor(ss, 16); ss += __shfl_xor(ss, 32);
                if (fq == 0) SS[row * 16 + u.pn * 4 + wc] = ss;
            }
#undef RES_LOAD
        } else {
            bf16_t* pp = (bf16_t*)PART + (size_t)(u.aux - 1) * MS * DM;
#pragma unroll
            for (int ai = 0; ai < 2; ++ai)
#pragma unroll
                for (int m = 0; m < 4; ++m) {
                    bf16_t* xp = pp + (size_t)(u.pm * 256 - MP + ai * 128 + wr * 64 + m * 16 + fr) * DM + col0;
#pragma unroll
                    for (int bj = 0; bj < 2; ++bj) {
                        const f32x4 v0 = acc[ai][bj][m][0], v1 = acc[ai][bj][m][1];
                        u32x4 w; w.x = cvt_pk_bf16(v0[0], v0[1]); w.y = cvt_pk_bf16(v0[2], v0[3]); w.z = cvt_pk_bf16(v1[0], v1[1]); w.w = cvt_pk_bf16(v1[2], v1[3]);
                        *(u32x4*)(xp + bj * 128) = w;
                    }
                }
        }
    }
};
}

struct Params { const float* in[31]; float* out; unsigned char* ws; int ph_lo, ph_hi; };

__device__ __forceinline__ unsigned f2bf(float f) { unsigned u = __builtin_bit_cast(unsigned, f); return (u + 0x7fffu + ((u >> 16) & 1u)) >> 16; }
__device__ __forceinline__ unsigned pk2(float lo, float hi) { return f2bf(lo) | (f2bf(hi) << 16); }

struct TItem { const float* S; int Ns, K, n0, k0; bf16_t* WT; const float* gk; };
__device__ __forceinline__ void titem_load(const TItem& t, float (&tv)[32], int lane) {
#pragma unroll
    for (int i = 0; i < 32; ++i) tv[i] = __builtin_nontemporal_load(t.S + (size_t)(t.k0 + 2 * i + (lane >> 5)) * t.Ns + (lane & 31));
}
__device__ __forceinline__ void titem_finish(const TItem& t, const float (&tv)[32], LAS float* scr, int lane) {
    const int c = lane & 7;
    f32x4 g0 = (f32x4){1.f, 1.f, 1.f, 1.f}, g1 = g0;
    if (t.gk) { g0 = *(const f32x4*)(t.gk + t.k0 + 8 * c); g1 = *(const f32x4*)(t.gk + t.k0 + 8 * c + 4); }
#pragma unroll
    for (int i = 0; i < 32; ++i) scr[(2 * i + (lane >> 5)) * 33 + (lane & 31)] = tv[i];
    asm volatile("s_waitcnt lgkmcnt(0)" ::: "memory");
#pragma unroll
    for (int j = 0; j < 4; ++j) { const int n = (lane >> 3) + 8 * j; const LAS float* s = scr + (8 * c) * 33 + n;
        u32x4 o; o.x = pk2(s[0 * 33] * g0.x, s[1 * 33] * g0.y); o.y = pk2(s[2 * 33] * g0.z, s[3 * 33] * g0.w); o.z = pk2(s[4 * 33] * g1.x, s[5 * 33] * g1.y); o.w = pk2(s[6 * 33] * g1.z, s[7 * 33] * g1.w);
        *(u32x4*)(t.WT + (size_t)(t.n0 + n) * t.K + t.k0 + 8 * c) = o; }
    asm volatile("s_waitcnt lgkmcnt(0)" ::: "memory");
}

__device__ __forceinline__ bool titem_decode(const Params& p, unsigned char* ws, int it, TItem& t) {
    constexpr int I_QKV = 16 * 40, I_SQ = 16 * 32, I_FU = 16 * 176, I_FD = 44 * 32, I_RG1 = 16 * 64, I_RG2 = 4 * 64, I_SC1 = 16 * 96;
    constexpr int NITEMS = 2 * I_QKV + 2 * I_SQ + 4 * I_FU + 4 * I_FD + I_RG1 + I_RG2 + I_SQ + I_SC1 + I_SQ;
    if (it >= NITEMS) return false;
        int r = it;
        const float* S; int Ns, K, n0, k0; bf16_t* WT; const float* gk = nullptr;
        if (r < 2 * I_QKV) { const int j = r / I_QKV; r -= j * I_QKV; K = 1024; const int nb = r % 40, kb = r / 40; k0 = 64 * kb; n0 = 32 * nb;
            const int pn = nb >> 3, bj = (nb >> 2) & 1, hh = nb & 3; Ns = NQKV; S = p.in[10] + (size_t)j * 1024 * NQKV + (4 * pn + hh) * 64 + 32 * bj; WT = (bf16_t*)(ws + WS_WQKV) + (size_t)j * NQKV * 1024; gk = p.in[7] + 3 * j * DM; }
        else if ((r -= 2 * I_QKV) < 2 * I_SQ) { const int j = r / I_SQ; r -= j * I_SQ; K = 1024; const int nb = r % 32, kb = r / 32; k0 = 64 * kb; n0 = 32 * nb; Ns = 1024; S = p.in[12] + (size_t)j * 1024 * 1024 + n0; WT = (bf16_t*)(ws + WS_WO) + (size_t)j * 1024 * 1024; }
        else if ((r -= 2 * I_SQ) < 4 * I_FU) { const int i = r / I_FU; r -= i * I_FU; K = 1024; const int nb = r % 176, kb = r / 176; k0 = 64 * kb; n0 = 32 * nb;
            const int pn = nb >> 3, bj = (nb >> 2) & 1, c32 = nb & 3; Ns = DFF; S = (bj ? p.in[29] : p.in[28]) + (size_t)i * 1024 * DFF + 128 * pn + 32 * c32; WT = (bf16_t*)(ws + WS_WFU) + (size_t)i * 5632 * 1024; gk = p.in[8] + i * DM; }
        else if ((r -= 4 * I_FU) < 4 * I_FD) { const int i = r / I_FD; r -= i * I_FD; K = DFF; const int nb = r % 32, kb = r / 32; k0 = 64 * kb; n0 = 32 * nb; Ns = 1024; S = p.in[30] + (size_t)i * DFF * 1024 + n0; WT = (bf16_t*)(ws + WS_WFD) + (size_t)i * 1024 * DFF; }
        else if ((r -= 4 * I_FD) < I_RG1) { K = 1024; const int nb = r % 64, kb = r / 64; k0 = 64 * kb; n0 = 32 * nb;
            const int pn = nb >> 3, bj = (nb >> 2) & 1, c32 = nb & 3; Ns = 1024; S = (bj ? p.in[16] : p.in[15]) + 128 * pn + 32 * c32; WT = (bf16_t*)(ws + WS_WRG1); gk = p.in[7] + 1 * DM; }
        else if ((r -= I_RG1) < I_RG2) { K = 256; const int nb = r % 64, kb = r / 64; k0 = 64 * kb; n0 = 32 * nb;
            const int pn = nb >> 3, bj = (nb >> 2) & 1, c32 = nb & 3; Ns = 256; S = (bj ? p.in[21] : p.in[19]) + (size_t)(pn >> 1) * 65536 + 128 * (pn & 1) + 32 * c32; WT = (bf16_t*)(ws + WS_WRG2); }
        else if ((r -= I_RG2) < I_SQ) { K = 1024; const int nb = r % 32, kb = r / 32; k0 = 64 * kb; n0 = 32 * nb; Ns = 1024; S = p.in[24] + n0; WT = (bf16_t*)(ws + WS_WRG3); }
        else if ((r -= I_SQ) < I_SC1) { K = 1024; const int nb = r % 96, kb = r / 96; k0 = 64 * kb; n0 = 32 * nb;
            const int pn = nb >> 3, bj = (nb >> 2) & 1, c32 = nb & 3; Ns = 3072;
            const int col = pn < 8 ? (bj ? 2048 : 1024) + 128 * pn + 32 * c32 : 256 * (pn - 8) + 128 * bj + 32 * c32; S = p.in[25] + col; WT = (bf16_t*)(ws + WS_WSC1); gk = p.in[7] + 2 * DM; }
        else { r -= I_SC1; K = 1024; const int nb = r % 32, kb = r / 32; k0 = 64 * kb; n0 = 32 * nb; Ns = 1024; S = p.in[27] + n0; WT = (bf16_t*)(ws + WS_WSC2); }
        t.S = S; t.Ns = Ns; t.K = K; t.n0 = n0; t.k0 = k0; t.WT = WT; t.gk = gk;
    return true;
}

__device__ __forceinline__ int set_size(int s) { return s == 0 ? 640 : s == 1 ? 6528 : s == 2 ? 6272 : s == 3 ? 4224 : 5376; }
__device__ __forceinline__ int set_item(int s, int k) {
    if (s == 0) return k;
    if (s == 1) { if (k < 512) return 1280 + k; k -= 512; if (k < 2816) return 2304 + k; k -= 2816; if (k < 1408) return 13568 + k; k -= 1408; return 19200 + k; }
    if (s == 2) { if (k < 2816) return 5120 + k; k -= 2816; if (k < 1408) return 14976 + k; k -= 1408; return 20992 + k; }
    if (s == 3) { if (k < 2816) return 7936 + k; k -= 2816; return 16384 + k; }
    if (k < 640) return 640 + k; k -= 640; if (k < 512) return 1792 + k; k -= 512; if (k < 2816) return 10752 + k; k -= 2816; return 17792 + k;
}
__device__ __forceinline__ void convert_set(const Params& p, unsigned char* ws, LAS float* scr, int set, int widx, int nw, int lane) {
    const int n = set_size(set);
    TItem cur, nxt; float tv[32], tn[32];
    int k = widx;
    bool has = k < n;
    if (has) { titem_decode(p, ws, set_item(set, k), cur); titem_load(cur, tv, lane); }
    while (has) {
        k += nw;
        const bool hn = k < n;
        if (hn) { titem_decode(p, ws, set_item(set, k), nxt); titem_load(nxt, tn, lane); }
        titem_finish(cur, tv, scr, lane);
#pragma unroll
        for (int i = 0; i < 32; ++i) tv[i] = tn[i];
        cur = nxt; has = hn;
    }
}
__device__ __forceinline__ void convert_in_slack(const Params& p, unsigned char* ws, LAS unsigned char* lds, int set, int nU, int vcu, int G, const int tid) {
    const int first = nU % G, nidle = first == 0 ? G : G - first;
    const int k0 = first == 0 ? 0 : first;
    if (vcu < k0) return;
    const int lane = tid & 63, wave = __builtin_amdgcn_readfirstlane(tid >> 6);
    convert_set(p, ws, (LAS float*)(lds + wave * 16384), set, (vcu - k0) * 8 + wave, nidle * 8, lane);
}

__device__ __forceinline__ void prep_phase(const Params& p, LAS unsigned char* lds, int vcu, int G, const int tid) {
    const int lane = tid & 63, wave = __builtin_amdgcn_readfirstlane(tid >> 6);
    LAS float* scr = (LAS float*)(lds + wave * 16384);
    const int gw = vcu * 8 + wave, NGW = G * 8;
    unsigned char* ws = p.ws;
    convert_set(p, ws, scr, 0, gw, NGW, lane);
    {
        float* rstd = (float*)(ws + WS_RSTD);
        for (int m = gw; m < M; m += NGW) {
            const float* src = m < MP ? p.in[0] + (size_t)m * DM : p.in[1] + (size_t)(m - MP) * DM;
            f32x4 v[4]; float s = 0.f;
#pragma unroll
            for (int j = 0; j < 4; ++j) { v[j] = __builtin_nontemporal_load((const f32x4*)src + lane + 64 * j); s += (v[j].x * v[j].x + v[j].y * v[j].y) + (v[j].z * v[j].z + v[j].w * v[j].w); }
            s = wave_sum(s);
            if (lane == 0) rstd[m] = 1.0f / sqrtf(s * (1.f / DM) + EPS);
            u32x2* no = (u32x2*)((bf16_t*)(ws + WS_XN) + (size_t)m * DM) + lane;
#pragma unroll
            for (int j = 0; j < 4; ++j) { u32x2 w; w.x = cvt_pk_bf16(v[j].x, v[j].y); w.y = cvt_pk_bf16(v[j].z, v[j].w); no[64 * j] = w; }
        }
    }
    {
        const int gt = vcu * 512 + tid, NGT = G * 512;
        float* rope = (float*)(ws + WS_ROPE);
        for (int e = gt; e < 4104 * 32; e += NGT) {
            const int pi = e >> 5, d = e & 31; const int pos = pi < SEQ ? pi : 8192 + (pi - SEQ);
            double inv = 1.0; for (int k = 0; k < d; ++k) inv *= 0.7498942093324559;
            const float ang = (float)pos * (float)inv;
            const double rev = (double)ang * 0.15915494309189535; const double fr = rev - __builtin_rint(rev);
            rope[(size_t)pi * 64 + d] = __builtin_amdgcn_cosf((float)fr); rope[(size_t)pi * 64 + 32 + d] = __builtin_amdgcn_sinf((float)fr);
        }
        float* c8 = (float*)(ws + WS_C8);
        for (int e = gt; e < 1024; e += NGT) { const float lam = p.in[23][e]; c8[e] = -8.0f * log1pf(__expf(-lam)) * LOG2E; ((float*)(ws + WS_ZB))[e] = 0.f; }
    }
}

__device__ __forceinline__ void norm_phase(float* X, const float* PART, int nsplit, const float* bias, const float* g, bf16_t* XN, bool final_, int vcu, int G, const int tid) {
    const int lane = tid & 63, wave = tid >> 6;
    const int gw = vcu * 8 + wave, NGW = G * 8;
    f32x4 gv[4];
#pragma unroll
    for (int j = 0; j < 4; ++j) gv[j] = *((const f32x4*)g + lane + 64 * j);
    for (int m = gw; m < M; m += NGW) {
        f32x4* xr = (f32x4*)(X + (size_t)m * DM) + lane;
        f32x4 v[4]; float s = 0.f;
        if (m >= MP) {
#pragma unroll
            for (int j = 0; j < 4; ++j) v[j] = xr[64 * j];
        } else {
            const u32x2* br = (const u32x2*)(XN + (size_t)m * DM) + lane;
#pragma unroll
            for (int j = 0; j < 4; ++j) { const u32x2 w = __builtin_nontemporal_load(br + 64 * j); v[j] = (f32x4){bflo(w.x), bfhi(w.x), bflo(w.y), bfhi(w.y)}; }
        }
        if (m >= MP) {
#pragma unroll 4
            for (int sl = 0; sl < nsplit; ++sl) { const u32x2* pr = (const u32x2*)((const bf16_t*)PART + ((size_t)sl * MS + (m - MP)) * DM) + lane;
#pragma unroll
                for (int j = 0; j < 4; ++j) { const u32x2 w = pr[64 * j]; v[j] += (f32x4){bflo(w.x), bfhi(w.x), bflo(w.y), bfhi(w.y)}; } }
            if (bias) {
#pragma unroll
                for (int j = 0; j < 4; ++j) v[j] += *((const f32x4*)bias + lane + 64 * j); }
            if (!final_) {
#pragma unroll
                for (int j = 0; j < 4; ++j) xr[64 * j] = v[j]; }
        }
#pragma unroll
        for (int j = 0; j < 4; ++j) s += (v[j].x * v[j].x + v[j].y * v[j].y) + (v[j].z * v[j].z + v[j].w * v[j].w);
        const float rstd = 1.0f / sqrtf(wave_sum(s) * (1.f / DM) + EPS);
        if (final_) {
#pragma unroll
            for (int j = 0; j < 4; ++j) __builtin_nontemporal_store(v[j] * rstd * gv[j], xr + 64 * j);
        } else {
            u32x2* no = (u32x2*)(XN + (size_t)m * DM) + lane;
#pragma unroll
            for (int j = 0; j < 4; ++j) { const f32x4 y = v[j] * rstd * gv[j]; u32x2 w; w.x = cvt_pk_bf16(y.x, y.y); w.y = cvt_pk_bf16(y.z, y.w); no[64 * j] = w; }
        }
    }
}

__device__ __forceinline__ void fin_phase(const float* Xin, float* X, const float* PART, int nsplit, const float* bias, bf16_t* XB, const float* SS, float* rstd, int vcu, int G, const int tid) {
    const int lane = tid & 63, wave = tid >> 6;
    const int gw = vcu * 8 + wave, NGW = G * 8;
    for (int r = gw; r < MS; r += NGW) {
        const int m = MP + r;
        f32x4* xr = (f32x4*)(X + (size_t)m * DM) + lane;
        const f32x4* xi = (const f32x4*)(Xin + (size_t)r * DM) + lane;
        f32x4 v[4]; float s = 0.f;
#pragma unroll
        for (int j = 0; j < 4; ++j) v[j] = xi[64 * j];
#pragma unroll 4
        for (int sl = 0; sl < nsplit; ++sl) { const u32x2* pr = (const u32x2*)((const bf16_t*)PART + ((size_t)sl * MS + r) * DM) + lane;
#pragma unroll
            for (int j = 0; j < 4; ++j) { const u32x2 w = pr[64 * j]; v[j] += (f32x4){bflo(w.x), bfhi(w.x), bflo(w.y), bfhi(w.y)}; } }
        if (bias) {
#pragma unroll
            for (int j = 0; j < 4; ++j) v[j] += *((const f32x4*)bias + lane + 64 * j); }
        u32x2* no = (u32x2*)(XB + (size_t)m * DM) + lane;
#pragma unroll
        for (int j = 0; j < 4; ++j) { xr[64 * j] = v[j]; u32x2 w; w.x = cvt_pk_bf16(v[j].x, v[j].y); w.y = cvt_pk_bf16(v[j].z, v[j].w); no[64 * j] = w;
            s += (v[j].x * v[j].x + v[j].y * v[j].y) + (v[j].z * v[j].z + v[j].w * v[j].w); }
        s = wave_sum(s);
        if (lane == 0) rstd[m] = 1.0f / sqrtf(s * (1.f / DM) + EPS);
    }
    const int gt = vcu * 512 + tid, NGT = G * 512;
    for (int m = NGT - 1 - gt; m < MP; m += NGT) {
        const f32x4* sp = (const f32x4*)(SS + (size_t)m * 16);
        const f32x4 a = sp[0], b = sp[1], c = sp[2], d = sp[3];
        const float s = ((a.x + a.y) + (a.z + a.w)) + ((b.x + b.y) + (b.z + b.w)) + ((c.x + c.y) + (c.z + c.w)) + ((d.x + d.y) + (d.z + d.w));
        rstd[m] = 1.0f / sqrtf(s * (1.f / DM) + EPS);
    }
}

constexpr int KS_PITCH = 72, VT_PITCH = 260;
constexpr int ATT_KS = 0, ATT_VT = 256 * KS_PITCH * 2;
__device__ __forceinline__ void attn_phase(const Params& p, LAS unsigned char* lds, int j, int vcu, int G, const int tid) {
    const int lane = tid & 63, wave = __builtin_amdgcn_readfirstlane(tid >> 6), l31 = lane & 31, hi = lane >> 5;
    const bf16_t* QKV = (const bf16_t*)(p.ws + WS_S0);
    bf16_t* O = (bf16_t*)(p.ws + WS_S2);
    LAS bf16_t* Ks = (LAS bf16_t*)(lds + ATT_KS);
    LAS bf16_t* Vt = (LAS bf16_t*)(lds + ATT_VT);
    const float* ck = p.in[2] + (size_t)j * 128 * 128 * 128;
    const float* cv = p.in[3] + (size_t)j * 128 * 128 * 128;
    {
        const int gt = vcu * 512 + tid, NGT = G * 512;
        float* kp = p.out + O_KP + (size_t)j * 65536; float* vp = p.out + O_VP + (size_t)j * 65536;
        for (int e = gt; e < 65536; e += NGT) { const int d = e & 127, t = (e >> 7) & 127, b = e >> 14; const size_t src = (size_t)(b * SEQ + SEQ - 128 + t) * NQKV + 1024 + d;
            kp[e] = bf2f(QKV[src]); vp[e] = bf2f(QKV[src + 128]); }
        float* ksn = p.out + O_KS + (size_t)j * 2097152; float* vsn = p.out + O_VS + (size_t)j * 2097152;
        f32x4 kv4[4], vv4[4];
#pragma unroll
        for (int it = 0; it < 4; ++it) {
            const int e4 = gt + it * NGT;
            if (e4 < 524288) { const int e = e4 * 4, d = e & 127, c = (e >> 7) & 127, b = e >> 14;
                if (c < 120) { kv4[it] = __builtin_nontemporal_load((const f32x4*)(ck + e + 8 * 128)); vv4[it] = __builtin_nontemporal_load((const f32x4*)(cv + e + 8 * 128)); }
                else { const size_t src = (size_t)(MP + b * 8 + c - 120) * NQKV + 1024 + d; const u32x2 kw = *(const u32x2*)(QKV + src), vw = *(const u32x2*)(QKV + src + 128);
                    kv4[it] = (f32x4){bflo(kw.x), bfhi(kw.x), bflo(kw.y), bfhi(kw.y)}; vv4[it] = (f32x4){bflo(vw.x), bfhi(vw.x), bflo(vw.y), bfhi(vw.y)}; } }
        }
#pragma unroll
        for (int it = 0; it < 4; ++it) { const int e4 = gt + it * NGT; if (e4 < 524288) { __builtin_nontemporal_store(kv4[it], (f32x4*)(ksn + (size_t)e4 * 4)); __builtin_nontemporal_store(vv4[it], (f32x4*)(vsn + (size_t)e4 * 4)); } }
        for (int e4 = gt + 4 * NGT; e4 < 524288; e4 += NGT) {
            const int e = e4 * 4, d = e & 127, c = (e >> 7) & 127, b = e >> 14;
            if (c < 120) { *(f32x4*)(ksn + e) = *(const f32x4*)(ck + e + 8 * 128); *(f32x4*)(vsn + e) = *(const f32x4*)(cv + e + 8 * 128); }
            else { const size_t src = (size_t)(MP + b * 8 + c - 120) * NQKV + 1024 + d; const u32x2 kw = *(const u32x2*)(QKV + src), vw = *(const u32x2*)(QKV + src + 128);
                *(f32x4*)(ksn + e) = (f32x4){bflo(kw.x), bfhi(kw.x), bflo(kw.y), bfhi(kw.y)}; *(f32x4*)(vsn + e) = (f32x4){bflo(vw.x), bfhi(vw.x), bflo(vw.y), bfhi(vw.y)}; }
        }
    }
    for (int un = vcu; un < 512; un += G) {
        const bool prompt = un < 256;
        int b, kvh, nb = 0;
        if (prompt) { b = un >> 6; kvh = (un >> 5) & 1; nb = un & 31; } else { const int s = un - 256; b = s >> 1; kvh = s & 1; }
        const int nkeys = prompt ? 256 : 160;
        for (int id = tid; id < nkeys * 8; id += 512) {
            const int key = id >> 3, ch = id & 7;
            u32x4 w = (u32x4){0u, 0u, 0u, 0u};
            if (prompt) { if (!(nb == 0 && key < 128)) w = *(const u32x4*)(QKV + (size_t)(b * SEQ + 128 * (nb - 1) + key) * NQKV + 1024 + kvh * 64 + 8 * ch); }
            else if (key < 128) { const float* s = ck + ((size_t)(b * 128 + key) * 2 + kvh) * 64 + 8 * ch; const f32x4 a = *(const f32x4*)s, c = *(const f32x4*)(s + 4);
                w.x = cvt_pk_bf16(a.x, a.y); w.y = cvt_pk_bf16(a.z, a.w); w.z = cvt_pk_bf16(c.x, c.y); w.w = cvt_pk_bf16(c.z, c.w); }
            else if (key < 136) w = *(const u32x4*)(QKV + (size_t)(MP + b * 8 + key - 128) * NQKV + 1024 + kvh * 64 + 8 * ch);
            *(LAS u32x4*)(Ks + key * KS_PITCH + 8 * ch) = w;
        }
        for (int id = tid; id < nkeys * 8; id += 512) {
            const int key = id % nkeys, ch = id / nkeys;
            u32x4 w = (u32x4){0u, 0u, 0u, 0u};
            if (prompt) { if (!(nb == 0 && key < 128)) w = *(const u32x4*)(QKV + (size_t)(b * SEQ + 128 * (nb - 1) + key) * NQKV + 1152 + kvh * 64 + 8 * ch); }
            else if (key < 128) { const float* s = cv + ((size_t)(b * 128 + key) * 2 + kvh) * 64 + 8 * ch; const f32x4 a = *(const f32x4*)s, c = *(const f32x4*)(s + 4);
                w.x = cvt_pk_bf16(a.x, a.y); w.y = cvt_pk_bf16(a.z, a.w); w.z = cvt_pk_bf16(c.x, c.y); w.w = cvt_pk_bf16(c.z, c.w); }
            else if (key < 136) w = *(const u32x4*)(QKV + (size_t)(MP + b * 8 + key - 128) * NQKV + 1152 + kvh * 64 + 8 * ch);
            LAS bf16_t* vd = Vt + (8 * ch) * VT_PITCH + key;
            vd[0 * VT_PITCH] = (bf16_t)(w.x & 0xffff); vd[1 * VT_PITCH] = (bf16_t)(w.x >> 16); vd[2 * VT_PITCH] = (bf16_t)(w.y & 0xffff); vd[3 * VT_PITCH] = (bf16_t)(w.y >> 16);
            vd[4 * VT_PITCH] = (bf16_t)(w.z & 0xffff); vd[5 * VT_PITCH] = (bf16_t)(w.z >> 16); vd[6 * VT_PITCH] = (bf16_t)(w.w & 0xffff); vd[7 * VT_PITCH] = (bf16_t)(w.w >> 16);
        }
        __syncthreads();
        const int h = kvh * 8 + wave;
        const float sink8 = p.in[14][j * 16 + h] * 8.0f;
        const int nqs = prompt ? 4 : 1;
        for (int qs = 0; qs < nqs; ++qs) {
            const int qi = 32 * qs + l31;
            const bool qvalid = prompt || l31 < 8;
            const size_t qrow = prompt ? (size_t)(b * SEQ + 128 * nb + qi) : (size_t)(MP + b * 8 + (l31 < 8 ? l31 : 7));
            bf16x8 qf[4];
#pragma unroll
            for (int d0 = 0; d0 < 4; ++d0) qf[d0] = *(const bf16x8*)(QKV + qrow * NQKV + h * 64 + 16 * d0 + 8 * hi);
            constexpr float CS = 0.125f * LOG2E;
            float mrun = sink8, lrun = hi == 0 ? 1.f : 0.f;
            f32x16 o0 = {}, o1 = {};
            const int kt_lo = (prompt && nb == 0 && qs < 4) ? 4 : qs;
            for (int kt = kt_lo; kt < qs + 5; ++kt) {
                f32x16 s = {};
#pragma unroll
                for (int d0 = 0; d0 < 4; ++d0) { const bf16x8 kf = *(const LAS bf16x8*)(Ks + (32 * kt + l31) * KS_PITCH + 16 * d0 + 8 * hi); s = __builtin_amdgcn_mfma_f32_32x32x16_bf16(kf, qf[d0], s, 0, 0, 0); }
                if (kt == qs || kt == qs + 4) {
#pragma unroll
                    for (int r = 0; r < 16; ++r) { const int c = 32 * kt + (r & 3) + 8 * (r >> 2) + 4 * hi; const bool ok = (c > qi) && (c <= qi + 128); s[r] = ok ? s[r] : -1e30f; }
                }
                float mx = fmaxf(fmaxf(s[0], s[1]), fmaxf(s[2], s[3]));
#pragma unroll
                for (int r = 4; r < 16; r += 4) mx = fmaxf(mx, fmaxf(fmaxf(s[r], s[r + 1]), fmaxf(s[r + 2], s[r + 3])));
                mx = fmaxf(mx, __shfl_xor(mx, 32));
                if (__any(mx > mrun)) {
                    const float mnew = fmaxf(mrun, mx), alpha = __builtin_amdgcn_exp2f((mrun - mnew) * CS);
                    lrun *= alpha; mrun = mnew;
#pragma unroll
                    for (int r = 0; r < 16; ++r) { o0[r] *= alpha; o1[r] *= alpha; }
                }
                const float mc = -mrun * CS;
                float ps = 0.f;
#pragma unroll
                for (int r = 0; r < 16; ++r) { s[r] = __builtin_amdgcn_exp2f(__builtin_fmaf(s[r], CS, mc)); ps += s[r]; }
                lrun += ps;
#pragma unroll
                for (int ss = 0; ss < 2; ++ss) {
                    u32x4 pw; pw.x = cvt_pk_bf16(s[8 * ss + 0], s[8 * ss + 1]); pw.y = cvt_pk_bf16(s[8 * ss + 2], s[8 * ss + 3]); pw.z = cvt_pk_bf16(s[8 * ss + 4], s[8 * ss + 5]); pw.w = cvt_pk_bf16(s[8 * ss + 6], s[8 * ss + 7]);
                    const bf16x8 pb = __builtin_bit_cast(bf16x8, pw);
                    const LAS bf16_t* vb = Vt + l31 * VT_PITCH + 32 * kt + 16 * ss + 4 * hi;
                    const s16x4 a0 = *(const LAS s16x4*)(vb), a1 = *(const LAS s16x4*)(vb + 8);
                    const s16x4 c0 = *(const LAS s16x4*)(vb + 32 * VT_PITCH), c1 = *(const LAS s16x4*)(vb + 32 * VT_PITCH + 8);
                    const bf16x8 v0 = (bf16x8){a0[0], a0[1], a0[2], a0[3], a1[0], a1[1], a1[2], a1[3]};
                    const bf16x8 v1 = (bf16x8){c0[0], c0[1], c0[2], c0[3], c1[0], c1[1], c1[2], c1[3]};
                    o0 = __builtin_amdgcn_mfma_f32_32x32x16_bf16(v0, pb, o0, 0, 0, 0);
                    o1 = __builtin_amdgcn_mfma_f32_32x32x16_bf16(v1, pb, o1, 0, 0, 0);
                }
            }
            const float ltot = lrun + __shfl_xor(lrun, 32);
            const float inv = 1.0f / ltot;
            if (qvalid) {
                const size_t orow = prompt ? (size_t)(b * SEQ + 128 * nb + qi) : (size_t)(MP + b * 8 + l31);
                bf16_t* op = O + orow * DM + h * 64 + 4 * hi;
#pragma unroll
                for (int r4 = 0; r4 < 4; ++r4) {
                    u32x2 w; w.x = cvt_pk_bf16(o0[4 * r4] * inv, o0[4 * r4 + 1] * inv); w.y = cvt_pk_bf16(o0[4 * r4 + 2] * inv, o0[4 * r4 + 3] * inv); *(u32x2*)(op + 8 * r4) = w;
                    w.x = cvt_pk_bf16(o1[4 * r4] * inv, o1[4 * r4 + 1] * inv); w.y = cvt_pk_bf16(o1[4 * r4 + 2] * inv, o1[4 * r4 + 3] * inv); *(u32x2*)(op + 32 + 8 * r4) = w;
                }
            }
        }
        __syncthreads();
    }
}

__device__ __forceinline__ void rgconv_phase(const Params& p, int vcu, int G, const int tid) {
    const int gt = vcu * 512 + tid, NGT = G * 512;
    const bf16_t* __restrict__ V = (const bf16_t*)(p.ws + WS_S1); bf16_t* __restrict__ U = (bf16_t*)(p.ws + WS_S3);
    const float* __restrict__ cw = p.in[17]; const float* __restrict__ cb = p.in[18]; const float* __restrict__ buf = p.in[5];
#pragma unroll 2
    for (int e = gt; e < M * 128; e += NGT) {
        const int row = e >> 7, ch = (e & 127) * 8;
        int t, T; const float* sb = nullptr;
        if (row < MP) { t = row & (SEQ - 1); T = SEQ; } else { t = (row - MP) & 7; T = 8; sb = buf + (size_t)((row - MP) >> 3) * 3 * DM; }
        float accv[8];
        { const f32x4 b0 = *(const f32x4*)(cb + ch), b1 = *(const f32x4*)(cb + ch + 4);
#pragma unroll
          for (int k = 0; k < 4; ++k) { accv[k] = b0[k]; accv[4 + k] = b1[k]; } }
#pragma unroll
        for (int jj = 0; jj < 4; ++jj) {
            const int tt = t - 3 + jj;
            float xv[8];
            if (tt >= 0) { const u32x4 w = *(const u32x4*)(V + (size_t)(row - 3 + jj) * DM + ch);
                xv[0] = bflo(w.x); xv[1] = bfhi(w.x); xv[2] = bflo(w.y); xv[3] = bfhi(w.y); xv[4] = bflo(w.z); xv[5] = bfhi(w.z); xv[6] = bflo(w.w); xv[7] = bfhi(w.w); }
            else if (sb) { const f32x4 a = *(const f32x4*)(sb + (size_t)(tt + 3) * DM + ch), c = *(const f32x4*)(sb + (size_t)(tt + 3) * DM + ch + 4);
#pragma unroll
                for (int k = 0; k < 4; ++k) { xv[k] = a[k]; xv[4 + k] = c[k]; } }
            else {
#pragma unroll
                for (int k = 0; k < 8; ++k) xv[k] = 0.f; }
            const f32x4 w0 = *(const f32x4*)(cw + jj * DM + ch), w1 = *(const f32x4*)(cw + jj * DM + ch + 4);
#pragma unroll
            for (int k = 0; k < 4; ++k) { accv[k] += xv[k] * w0[k]; accv[4 + k] += xv[4 + k] * w1[k]; }
        }
        u32x4 w; w.x = cvt_pk_bf16(accv[0], accv[1]); w.y = cvt_pk_bf16(accv[2], accv[3]); w.z = cvt_pk_bf16(accv[4], accv[5]); w.w = cvt_pk_bf16(accv[6], accv[7]);
        *(u32x4*)(U + (size_t)row * DM + ch) = w;
        if (t >= T - 3) {
            const u32x4 vw = *(const u32x4*)(V + (size_t)row * DM + ch);
            float* dst = row < MP ? p.out + O_RCP + ((size_t)(row >> 12) * 3 + (t - (T - 3))) * DM + ch : p.out + O_RCS + ((size_t)((row - MP) >> 3) * 3 + (t - (T - 3))) * DM + ch;
            *(f32x4*)dst = (f32x4){bflo(vw.x), bfhi(vw.x), bflo(vw.y), bfhi(vw.y)}; *(f32x4*)(dst + 4) = (f32x4){bflo(vw.z), bfhi(vw.z), bflo(vw.w), bfhi(vw.w)};
        }
    }
}
__device__ __forceinline__ void rgscan_phase(const Params& p, LAS unsigned char* lds, int vcu, int G, const int tid) {
    const int lane = tid & 63, wave = tid >> 6;
    bf16_t* GATE = (bf16_t*)(p.ws + WS_S0); const bf16_t* LA = (const bf16_t*)(p.ws + WS_S1); const bf16_t* Bv = (const bf16_t*)(p.ws + WS_S2);
    LAS float* sm = (LAS float*)lds;
    for (int un = vcu; un < 256; un += G) {
        const int b = un >> 6, ch = (un & 63) * 16 + (lane & 15), chunk = wave * 4 + (lane >> 4);
        const size_t base = (size_t)(b * SEQ + chunk * 128) * DM + ch;
        float Ap = 0.f, Bp = 0.f;
        for (int t0 = 0; t0 < 128; t0 += 32) {
            unsigned short lv[32], bv_[32];
#pragma unroll
            for (int t = 0; t < 32; ++t) { lv[t] = LA[base + (size_t)(t0 + t) * DM]; bv_[t] = Bv[base + (size_t)(t0 + t) * DM]; }
#pragma unroll
            for (int t = 0; t < 32; ++t) { const float l2 = bf2f(lv[t]); Ap += l2; Bp = __builtin_amdgcn_exp2f(l2) * Bp + bf2f(bv_[t]); }
        }
        sm[(chunk * 16 + (lane & 15)) * 2] = __builtin_amdgcn_exp2f(Ap); sm[(chunk * 16 + (lane & 15)) * 2 + 1] = Bp;
        __syncthreads();
        float hcur = 0.f;
        for (int c = 0; c < chunk; ++c) hcur = sm[(c * 16 + (lane & 15)) * 2] * hcur + sm[(c * 16 + (lane & 15)) * 2 + 1];
        for (int t0 = 0; t0 < 128; t0 += 32) {
            unsigned short lv[32], bv_[32], gv_[32];
#pragma unroll
            for (int t = 0; t < 32; ++t) { lv[t] = LA[base + (size_t)(t0 + t) * DM]; bv_[t] = Bv[base + (size_t)(t0 + t) * DM]; gv_[t] = GATE[base + (size_t)(t0 + t) * DM]; }
#pragma unroll
            for (int t = 0; t < 32; ++t) { hcur = __builtin_amdgcn_exp2f(bf2f(lv[t])) * hcur + bf2f(bv_[t]); GATE[base + (size_t)(t0 + t) * DM] = (bf16_t)f2bf(hcur * bf2f(gv_[t])); }
        }
        if (chunk == 31) p.out[O_HP + (size_t)b * DM + ch] = hcur;
        __syncthreads();
    }
    const int gt = vcu * 512 + tid, NGT = G * 512;
    for (int e = gt; e < 128 * DM; e += NGT) {
        const int sq = e >> 10, ch = e & 1023; float hcur = p.in[4][e];
        const size_t base = (size_t)(MP + sq * 8) * DM + ch;
#pragma unroll
        for (int t = 0; t < 8; ++t) { const float l2 = bf2f(LA[base + (size_t)t * DM]); const float bb = bf2f(Bv[base + (size_t)t * DM]);
            hcur = __builtin_amdgcn_exp2f(l2) * hcur + bb; const float gt_ = bf2f(GATE[base + (size_t)t * DM]); GATE[base + (size_t)t * DM] = (bf16_t)f2bf(hcur * gt_); }
        p.out[O_HS + e] = hcur;
    }
}
__device__ __forceinline__ void scconv_phase(const Params& p, int vcu, int G, const int tid) {
    const int gt = vcu * 512 + tid, NGT = G * 512;
    const bf16_t* __restrict__ CX = (const bf16_t*)(p.ws + WS_S0); const bf16_t* __restrict__ BG = (const bf16_t*)(p.ws + WS_S1); bf16_t* __restrict__ YG = (bf16_t*)(p.ws + WS_S2);
    const float* __restrict__ cw = p.in[26]; const float* __restrict__ buf = p.in[6];
#pragma unroll 2
    for (int e = gt; e < M * 128; e += NGT) {
        const int row = e >> 7, ch = (e & 127) * 8;
        int t, T; const float* sb = nullptr;
        if (row < MP) { t = row & (SEQ - 1); T = SEQ; } else { t = (row - MP) & 7; T = 8; sb = buf + (size_t)((row - MP) >> 3) * 2 * DM; }
        float accv[8];
#pragma unroll
        for (int k = 0; k < 8; ++k) accv[k] = 0.f;
        u32x4 cur = (u32x4){0u, 0u, 0u, 0u};
#pragma unroll
        for (int jj = 0; jj < 3; ++jj) {
            const int tt = t - 2 + jj;
            float xv[8];
            if (tt >= 0) { const u32x4 w = *(const u32x4*)(CX + (size_t)(row - 2 + jj) * DM + ch); if (jj == 2) cur = w;
                xv[0] = bflo(w.x); xv[1] = bfhi(w.x); xv[2] = bflo(w.y); xv[3] = bfhi(w.y); xv[4] = bflo(w.z); xv[5] = bfhi(w.z); xv[6] = bflo(w.w); xv[7] = bfhi(w.w); }
            else if (sb) { const f32x4 a = *(const f32x4*)(sb + (size_t)(tt + 2) * DM + ch), c = *(const f32x4*)(sb + (size_t)(tt + 2) * DM + ch + 4);
#pragma unroll
                for (int k = 0; k < 4; ++k) { xv[k] = a[k]; xv[4 + k] = c[k]; } }
            else {
#pragma unroll
                for (int k = 0; k < 8; ++k) xv[k] = 0.f; }
            const f32x4 w0 = *(const f32x4*)(cw + jj * DM + ch), w1 = *(const f32x4*)(cw + jj * DM + ch + 4);
#pragma unroll
            for (int k = 0; k < 4; ++k) { accv[k] += xv[k] * w0[k]; accv[4 + k] += xv[4 + k] * w1[k]; }
        }
        const u32x4 g = *(const u32x4*)(BG + (size_t)row * DM + ch);
        u32x4 w; w.x = cvt_pk_bf16(accv[0] * bflo(g.x), accv[1] * bfhi(g.x)); w.y = cvt_pk_bf16(accv[2] * bflo(g.y), accv[3] * bfhi(g.y));
        w.z = cvt_pk_bf16(accv[4] * bflo(g.z), accv[5] * bfhi(g.z)); w.w = cvt_pk_bf16(accv[6] * bflo(g.w), accv[7] * bfhi(g.w));
        *(u32x4*)(YG + (size_t)row * DM + ch) = w;
        if (t >= T - 2) {
            float* dst = row < MP ? p.out + O_SCP + ((size_t)(row >> 12) * 2 + (t - (T - 2))) * DM + ch : p.out + O_SCS + ((size_t)((row - MP) >> 3) * 2 + (t - (T - 2))) * DM + ch;
            *(f32x4*)dst = (f32x4){bflo(cur.x), bfhi(cur.x), bflo(cur.y), bfhi(cur.y)}; *(f32x4*)(dst + 4) = (f32x4){bflo(cur.z), bfhi(cur.z), bflo(cur.w), bfhi(cur.w)};
        }
    }
}

#define XB_TMO      128
#define XB_XCNT(j)  (256  + 64 * (j))
#define XB_XSUB(j)  (1280 + 64 * (j))
#define XB_XGEN(j)  (2304 + 64 * (j))
#define XB_TOP      3328
#define XB_TOPGEN   3392
#define XCD_BAR_WORDS 3456
#define XB_SPIN_CAP (1u << 18)
__device__ __forceinline__ unsigned xb_ld(unsigned* p)              { return __hip_atomic_load(p, __ATOMIC_RELAXED, __HIP_MEMORY_SCOPE_AGENT); }
__device__ __forceinline__ unsigned xb_add(unsigned* p, unsigned v) { return __hip_atomic_fetch_add(p, v, __ATOMIC_RELAXED, __HIP_MEMORY_SCOPE_AGENT); }
__device__ __forceinline__ unsigned xb_xcc_id() { return (unsigned)__builtin_amdgcn_s_getreg((3 << 11) | 20) & 0xFu; }
#define XB_SPIN(cond, bar) do { unsigned _sp = 0; while (cond) { __builtin_amdgcn_s_sleep(1); \
    if ((++_sp & 255u) == 0u) { if (xb_ld(&(bar)[XB_TMO])) break; if (_sp > XB_SPIN_CAP) { atomicAdd(&(bar)[XB_TMO], 1u); break; } } } } while (0)
struct XcdBarrier { unsigned* bar; unsigned x; volatile LAS unsigned* st; };
__device__ __forceinline__ XcdBarrier xcd_barrier_post(unsigned* bar, volatile LAS unsigned* st) {
    XcdBarrier b; b.bar = bar; b.x = xb_xcc_id(); b.st = st;
    if (threadIdx.x == 0) (void)xb_add(&bar[XB_XCNT(b.x)], 1u);
    return b;
}
__device__ __forceinline__ void xcd_barrier_complete(unsigned* bar, unsigned x, unsigned& nloc, unsigned& nx) {
    const unsigned G = gridDim.x * gridDim.y * gridDim.z;
    unsigned sum, cnt, mine, sp = 0u;
    for (;;) {
        sum = 0u; cnt = 0u; mine = 0u;
#pragma unroll
        for (unsigned j = 0; j < 16; ++j) { const unsigned c = xb_ld(&bar[XB_XCNT(j)]); sum += c; cnt += (c > 0u) ? 1u : 0u; mine = (j == x) ? c : mine; }
        if (sum == G) break;
        __builtin_amdgcn_s_sleep(1);
        if ((++sp & 255u) == 0u) { if (xb_ld(&bar[XB_TMO])) break; if (sp > XB_SPIN_CAP) { atomicAdd(&bar[XB_TMO], 1u); break; } }
    }
    nloc = mine > 0u ? mine : 1u; nx = cnt > 0u ? cnt : 1u;
}
__device__ __forceinline__ void xcd_barrier(const XcdBarrier& b) {
    asm volatile("s_waitcnt vmcnt(0)" ::: "memory");
    __syncthreads();
    if (threadIdx.x == 0) {
        unsigned* bar = b.bar;
        __builtin_amdgcn_s_waitcnt(0);
        unsigned nloc = b.st[0], nx = b.st[1];
        if (nloc == 0u) { xcd_barrier_complete(bar, b.x, nloc, nx); b.st[0] = nloc; b.st[1] = nx; }
        const unsigned old = xb_add(&bar[XB_XSUB(b.x)], 1u);
        const unsigned gen = old / nloc;
        if (old + 1u == (gen + 1u) * nloc) {
            __builtin_amdgcn_fence(__ATOMIC_RELEASE, "agent");
            asm volatile("s_waitcnt vmcnt(0)" ::: "memory");
            const unsigned og = xb_add(&bar[XB_TOP], 1u);
            const unsigned tg = og / nx;
            if (og + 1u == (tg + 1u) * nx) xb_add(&bar[XB_TOPGEN], 1u);
            else XB_SPIN(xb_ld(&bar[XB_TOPGEN]) == tg, bar);
            __builtin_amdgcn_fence(__ATOMIC_ACQUIRE, "agent");
            xb_add(&bar[XB_XGEN(b.x)], 1u);
            asm volatile("s_waitcnt vmcnt(0)" ::: "memory");
        } else {
            XB_SPIN(xb_ld(&bar[XB_XGEN(b.x)]) == gen, bar);
            __builtin_amdgcn_fence(__ATOMIC_ACQUIRE, "agent");
            asm volatile("s_waitcnt vmcnt(0)" ::: "memory");
        }
    }
    __syncthreads();
}

enum Op { OP_PREP, OP_QKV, OP_ATTN, OP_RG1, OP_RGCONV, OP_RGGATES, OP_RGSCAN, OP_SC1, OP_SCCONV, OP_RESID_MIX, OP_NORM_F, OP_FFNUP, OP_RESID_FFN, OP_NORM_M };
constexpr int NSTEPS = 31;

__global__ void __launch_bounds__(512, 2) mega_fwd(Params p) {
    extern __shared__ __attribute__((aligned(16))) unsigned char lds_raw[];
    LAS unsigned char* lds = (LAS unsigned char*)lds_raw;
    const int G0 = gridDim.x, bx = blockIdx.x;
    volatile LAS unsigned* MISC = (volatile LAS unsigned*)(lds + 131072);
    if (threadIdx.x < 32) MISC[threadIdx.x] = 0u;
    __syncthreads();
    XcdBarrier bar = xcd_barrier_post((unsigned*)p.ws, MISC + 8);
    const int vcu0 = (G0 % 8 == 0) ? (bx % 8) * (G0 / 8) + bx / 8 : bx;
#if REP_MASK
    for (int it_ = 2 * p.ph_lo; it_ < 2 * p.ph_hi; ++it_) { const int step = it_ >> 1;
#else
    for (int step = p.ph_lo; step < p.ph_hi; ++step) {
#endif
        int tid = threadIdx.x, G = G0, vcu = vcu0; unsigned char* ws = p.ws; float* X = p.out;
        asm volatile("" : "+v"(tid)); asm volatile("" : "+s"(G)); asm volatile("" : "+s"(vcu)); asm volatile("" : "+s"(ws)); asm volatile("" : "+s"(X));
        bf16_t* XN = (bf16_t*)(ws + WS_XN);
        float* PART = (float*)(ws + WS_S3);
        int op, layer = 0;
        if (step == 0) op = OP_PREP;
        else {
            int s = step - 1, li;
            if (s < 7) { layer = 0; li = s; } else if (s < 16) { layer = 1; li = s - 7; } else if (s < 23) { layer = 2; li = s - 16; } else { layer = 3; li = s - 23; }
            const int kind = layer % 3, nmix = kind == 1 ? 4 : 2;
            if (li < nmix) op = kind == 0 ? (li == 0 ? OP_QKV : OP_ATTN) : kind == 1 ? (OP_RG1 + li) : (li == 0 ? OP_SC1 : OP_SCCONV);
            else op = OP_RESID_MIX + (li - nmix);
        }
        const int kind = layer % 3, j = layer / 3;
#if REP_MASK
        if ((it_ & 1) && !((REP_MASK >> op) & 1)) continue;
#endif
        pg8::GSched S; S.G = G; S.c = vcu; S.c2 = (int)blockIdx.x; S.mode = 0; S.nsplit = NSPLIT_MIX; S.lda = DM; S.ldb = DM; S.nt = 16; S.A = (const char*)XN;
        switch (op) {
        case OP_PREP: prep_phase(p, lds, vcu, G, tid); break;
        case OP_QKV: { S.Bt = (const char*)(ws + WS_WQKV + (size_t)j * NQKV * 1024 * 2); S.nN = 5;
            pg8::EpiQKV E{(bf16_t*)(ws + WS_S0), p.in[11] + j * NQKV, (const float*)(ws + WS_ROPE), (const float*)(ws + WS_RSTD)};
            pg8::gemm_phase<DM, DM>(lds, S, E, tid);
            if (layer == 0) convert_in_slack(p, ws, lds, 1, 68 * 5, vcu, G, tid); } break;
        case OP_ATTN: attn_phase(p, lds, j, vcu, G, tid); break;
        case OP_RG1: { S.Bt = (const char*)(ws + WS_WRG1); S.nN = 8;
            pg8::EpiPair<1> E{(bf16_t*)(ws + WS_S0), (bf16_t*)(ws + WS_S1), (const float*)(ws + WS_RSTD)};
            pg8::gemm_phase<DM, DM>(lds, S, E, tid);
            convert_in_slack(p, ws, lds, 2, 68 * 8, vcu, G, tid); } break;
        case OP_RGCONV: rgconv_phase(p, vcu, G, tid); break;
        case OP_RGGATES: { S.A = (const char*)(ws + WS_S3); S.Bt = (const char*)(ws + WS_WRG2); S.ldb = 256; S.nN = 8; S.nt = 4; S.mode = 2;
            pg8::EpiRgGates E{(const bf16_t*)(ws + WS_S3), (bf16_t*)(ws + WS_S1), (bf16_t*)(ws + WS_S2), p.in[20], p.in[22], (const float*)(ws + WS_C8)};
            pg8::gemm_phase<DM, 256>(lds, S, E, tid);
            convert_in_slack(p, ws, lds, 3, 68 * 8, vcu, G, tid); } break;
        case OP_RGSCAN: rgscan_phase(p, lds, vcu, G, tid); break;
        case OP_SC1: { S.Bt = (const char*)(ws + WS_WSC1); S.nN = 12;
            pg8::EpiPair<2> E{(bf16_t*)(ws + WS_S0), (bf16_t*)(ws + WS_S1), (const float*)(ws + WS_RSTD)};
            pg8::gemm_phase<DM, DM>(lds, S, E, tid);
            convert_in_slack(p, ws, lds, 4, 68 * 12, vcu, G, tid); } break;
        case OP_SCCONV: scconv_phase(p, vcu, G, tid); break;
        case OP_RESID_MIX: {
            const float* bias = (const float*)(ws + WS_ZB); S.nN = 4; S.mode = 1;
            if (kind == 0) { S.A = (const char*)(ws + WS_S2); S.Bt = (const char*)(ws + WS_WO + (size_t)j * 1024 * 1024 * 2); bias = p.in[13] + j * DM; }
            else if (kind == 1) { S.A = (const char*)(ws + WS_S0); S.Bt = (const char*)(ws + WS_WRG3); }
            else { S.A = (const char*)(ws + WS_S2); S.Bt = (const char*)(ws + WS_WSC2); }
            if (layer == 0) { pg8::EpiResid<true> E{p.in[0], PART, bias, XN, (float*)(ws + WS_SS)}; pg8::gemm_phase<DM, DM>(lds, S, E, tid); }
            else { pg8::EpiResid<false> E{nullptr, PART, bias, XN, (float*)(ws + WS_SS)}; pg8::gemm_phase<DM, DM>(lds, S, E, tid); }
            } break;
        case OP_RESID_FFN: {
            S.nN = 4; S.mode = 1; S.nsplit = NSPLIT_FFN; S.A = (const char*)(ws + WS_S0); S.lda = DFF; S.ldb = DFF; S.nt = 44; S.Bt = (const char*)(ws + WS_WFD + (size_t)layer * 1024 * DFF * 2);
            pg8::EpiResid<false> E{nullptr, PART, (const float*)(ws + WS_ZB), XN, (float*)(ws + WS_SS)};
            pg8::gemm_phase<DFF, DFF>(lds, S, E, tid); } break;
        case OP_NORM_F: fin_phase(layer == 0 ? p.in[1] : X + (size_t)MP * DM, X, PART, NSPLIT_MIX, kind == 0 ? p.in[13] + j * DM : nullptr, XN, (const float*)(ws + WS_SS), (float*)(ws + WS_RSTD), vcu, G, tid); break;
        case OP_FFNUP: { S.Bt = (const char*)(ws + WS_WFU + (size_t)layer * 5632 * 1024 * 2); S.nN = 22;
            pg8::EpiPair<0> E{(bf16_t*)(ws + WS_S0), nullptr, (const float*)(ws + WS_RSTD)};
            pg8::gemm_phase<DM, DM>(lds, S, E, tid); } break;
        case OP_NORM_M: if (layer == 3) norm_phase(X, PART, NSPLIT_FFN, nullptr, p.in[9], XN, true, vcu, G, tid);
                        else fin_phase(X + (size_t)MP * DM, X, PART, NSPLIT_FFN, nullptr, XN, (const float*)(ws + WS_SS), (float*)(ws + WS_RSTD), vcu, G, tid);
                        break;
        }
#if REP_MASK
        xcd_barrier(bar);
#else
        if (step + 1 < p.ph_hi) xcd_barrier(bar);
#endif
#if EXTRA_SYNC
        xcd_barrier(bar);
#endif
    }
}

#ifndef MK_N_LAUNCHES
#define MK_N_LAUNCHES 1
#endif
extern "C" void kernel_launch(void* const* d_in, const int* in_sizes, int n_in, void* d_out, int out_size, void* d_ws, size_t ws_size, hipStream_t stream) {
    static int grid = 0;
    if (grid == 0) {
        int dev = 0, cus = 0, per_cu = 0;
        hipGetDevice(&dev);
        hipDeviceGetAttribute(&cus, hipDeviceAttributeMultiprocessorCount, dev);
        hipFuncSetAttribute((const void*)mega_fwd, hipFuncAttributeMaxDynamicSharedMemorySize, LDS_BYTES);
        hipOccupancyMaxActiveBlocksPerMultiprocessor(&per_cu, (const void*)mega_fwd, 512, LDS_BYTES);
        if (per_cu < 1) { fprintf(stderr, "kernel_launch: occupancy query reports %d blocks per CU\n", per_cu); per_cu = 1; }
        if (per_cu > 1) per_cu = 1;
        grid = cus * per_cu;
        if (n_in != 31 || ws_size < 268 * MiB) fprintf(stderr, "kernel_launch: unexpected n_in %d / ws_size %zu\n", n_in, ws_size);
    }
    hipMemsetAsync(d_ws, 0, 16384, stream);
    Params p{};
    for (int i = 0; i < 31; ++i) p.in[i] = (const float*)d_in[i];
    p.out = (float*)d_out; p.ws = (unsigned char*)d_ws;
    const int nl = MK_N_LAUNCHES;
    for (int li = 0; li < nl; ++li) {
        p.ph_lo = (int)((long)NSTEPS * li / nl); p.ph_hi = (int)((long)NSTEPS * (li + 1) / nl);
        void* args[] = {&p};
        hipError_t e = hipLaunchCooperativeKernel((const void*)mega_fwd, dim3(grid), dim3(512), args, LDS_BYTES, stream);
        if (e != hipSuccess) fprintf(stderr, "cooperative launch failed: %s (grid %d)\n", hipGetErrorString(e), grid);
    }
}
```

```cpp
#include <hip/hip_runtime.h>
#include <hip/hip_cooperative_groups.h>
#include <cstdint>
#include <cstdio>
namespace cg = cooperative_groups;
#ifndef REP_MASK
#define REP_MASK 0
#endif
constexpr int NSPLIT_MIX = 4, NSPLIT_FFN = 8;
#ifndef EXTRA_SYNC
#define EXTRA_SYNC 0
#endif

#define LAS __attribute__((address_space(3)))
typedef unsigned short bf16_t;
typedef short bf16x8 __attribute__((ext_vector_type(8)));
typedef short s16x4 __attribute__((ext_vector_type(4)));
typedef float f32x4 __attribute__((ext_vector_type(4)));
typedef float f32x2 __attribute__((ext_vector_type(2)));
typedef float f32x16 __attribute__((ext_vector_type(16)));
typedef unsigned u32x4 __attribute__((ext_vector_type(4)));
typedef unsigned u32x2 __attribute__((ext_vector_type(2)));

constexpr int DM = 1024, MP = 16384, MS = 1024, M = MP + MS, SEQ = 4096, DFF = 2816, NQKV = 1280;
constexpr float EPS = 1e-6f, LOG2E = 1.4426950408889634f;
constexpr size_t MiB = 1u << 20;
constexpr size_t WS_ROPE = 1 * MiB;
constexpr size_t WS_RSTD = 4 * MiB;
constexpr size_t WS_SS = 5 * MiB;
constexpr size_t WS_ZB = 3 * MiB + 65536;
constexpr size_t WS_C8 = 3 * MiB;
constexpr size_t WS_WQKV = 8 * MiB;
constexpr size_t WS_WO = 13 * MiB;
constexpr size_t WS_WFU = 17 * MiB;
constexpr size_t WS_WFD = 61 * MiB;
constexpr size_t WS_WRG1 = 83 * MiB, WS_WRG2 = 87 * MiB, WS_WRG3 = 88 * MiB, WS_WSC1 = 90 * MiB, WS_WSC2 = 96 * MiB;
constexpr size_t WS_XN = 98 * MiB;
constexpr size_t SLOT = 34 * MiB;
constexpr size_t WS_S0 = 132 * MiB, WS_S1 = WS_S0 + SLOT, WS_S2 = WS_S1 + SLOT, WS_S3 = WS_S2 + SLOT;
constexpr size_t O_KP = 17825792, O_VP = 17956864, O_KS = 18087936, O_VS = 22282240, O_HP = 26476544, O_HS = 26480640,
                 O_RCP = 26611712, O_RCS = 26624000, O_SCP = 27017216, O_SCS = 27025408;

constexpr int LDS_BYTES = 131072 + 1024;

__device__ __forceinline__ unsigned cvt_pk_bf16(float lo, float hi) { unsigned r; asm volatile("v_cvt_pk_bf16_f32 %0, %1, %2" : "=v"(r) : "v"(lo), "v"(hi)); return r; }
__device__ __forceinline__ float bf2f(unsigned short v) { return __uint_as_float(((unsigned)v) << 16); }
__device__ __forceinline__ float bflo(unsigned w) { return __uint_as_float(w << 16); }
__device__ __forceinline__ float bfhi(unsigned w) { return __uint_as_float(w & 0xffff0000u); }
__device__ __forceinline__ float fast_sigmoid(float x) { return __builtin_amdgcn_rcpf(1.0f + __builtin_amdgcn_exp2f(-x * LOG2E)); }
__device__ __forceinline__ float wave_sum(float v) {
#pragma unroll
    for (int o = 1; o < 64; o <<= 1) v += __shfl_xor(v, o);
    return v;
}

__device__ __forceinline__ float xor16_add(float v) { const auto r = __builtin_amdgcn_permlane16_swap(__float_as_uint(v), __float_as_uint(v), false, false); return __uint_as_float(r[0]) + __uint_as_float(r[1]); }
__device__ __forceinline__ float xor32_add(float v) { const auto r = __builtin_amdgcn_permlane32_swap(__float_as_uint(v), __float_as_uint(v), false, false); return __uint_as_float(r[0]) + __uint_as_float(r[1]); }
namespace pg8 {
constexpr int BM = 256, BK = 64, HALF = 128, HTB = HALF * BK * 2, STAGE_BYTES = 8 * HTB;
__device__ __forceinline__ int lds_byte(int r, int c) { const int st = (r >> 4) * 2 + (c >> 5), rr = r & 15, cc = c & 31, ob = rr * 64 + cc * 2; return st * 1024 + (ob ^ (((ob >> 9) & 1) << 5)); }
__device__ __forceinline__ void stage_rc(int b, int& R, int& C) { const int st = b / 1024, sb = b % 1024, swz = sb ^ (((sb >> 9) & 1) << 5); R = (st >> 1) * 16 + swz / 64; C = (st & 1) * 32 + (swz % 64) / 2; }
__device__ __forceinline__ int perm32(int rho) { const int n = rho >> 4, i = rho & 15; return 8 * (i >> 2) + 4 * n + (i & 3); }

struct Unit { int pm, pn, nt, aux; const char* a; const char* b; };

struct GSched {
    const char* A; const char* Bt; int lda, ldb, nN, nt, mode, G, c, nsplit, c2;
    __device__ __forceinline__ bool next(int i, Unit& u) const {
        int L = i * G + c; const int nP = 64 * nN; int kt0 = 0; u.nt = nt; u.aux = 0;
        if (mode == 1) {
            const int nS = 4 * nsplit * nN;
            const bool hasS = (nS <= G) && (c2 < nS);
            if (nS <= G) {
                if (hasS && i == 0) L = c2; else L = nS + (i - (hasS ? 1 : 0)) * G + c;
            }
            if (L < nS) {
                const int sl = L % nsplit; u.pn = (L / nsplit) % nN; u.pm = 64 + (L / nsplit) / nN; u.aux = 1 + sl;
                const int q = (nt / (2 * nsplit)) * 2, extra = (nt - nsplit * q) >> 1;
                u.nt = sl < extra ? q + 2 : q; kt0 = sl < extra ? sl * (q + 2) : extra * (q + 2) + (sl - extra) * q;
            } else {
                L -= nS; if (L >= nP) return false;
                const int g = L / (8 * nN), r = L - g * 8 * nN; u.pm = 8 * g + (r & 7); u.pn = r >> 3;
            }
        } else if (L < nP) { const int g = L / (8 * nN), r = L - g * 8 * nN; u.pm = 8 * g + (r & 7); u.pn = r >> 3; }
        else { L -= nP; if (L >= 4 * nN) return false; u.pm = 64 + (L & 3); u.pn = L >> 2; }
        u.a = A + ((size_t)u.pm * 256 * lda + (size_t)kt0 * 64 + (mode == 2 ? 256 * (u.pn >> 1) : 0)) * 2;
        u.b = Bt + ((size_t)u.pn * 256 * ldb + (size_t)kt0 * 64) * 2;
        return true;
    }
};

template <int LDA, int LDB, class Epi>
__device__ __forceinline__ void gemm_phase(LAS unsigned char* lds, const GSched& S, const Epi& E, const int tid) {
    const int wid = __builtin_amdgcn_readfirstlane(tid >> 6), lane = tid & 63, wr = wid >> 2, wc = wid & 3, fr = lane & 15, fq = lane >> 4;
    constexpr int lda = LDA, ldb = LDB;
    unsigned voffA[2], voffB[2];
#pragma unroll
    for (int i = 0; i < 2; ++i) { int R, C; stage_rc(tid * 16 + i * 8192, R, C); const int Rb = Epi::PERM ? ((R & ~31) + perm32(R & 31)) : R;
        voffA[i] = (unsigned)(R * lda + C) * 2u; voffB[i] = (unsigned)(Rb * ldb + C) * 2u; }
    const size_t kstep = (size_t)(BK * 2);
    const size_t hstepA = (size_t)HALF * lda * 2, hstepB = (size_t)HALF * ldb * 2;
    const unsigned ldsw = (unsigned)wid * 1024u;
    const int aoff = lds_byte(wr * 64 + fr, fq * 8), boff = lds_byte(wc * 32 + fr, fq * 8);
#define PG8_SA(b, h) (((b) * 2 + (h)) * HTB)
#define PG8_SB(b, h) ((4 + (b) * 2 + (h)) * HTB)
#define PG8_STAGE(bufoff, gbase, voff) do { _Pragma("unroll") for (int _i = 0; _i < 2; ++_i) \
        __builtin_amdgcn_global_load_lds((const unsigned*)((const char*)(gbase) + (voff)[_i]), (LAS unsigned*)(lds + (bufoff) + ldsw + _i * 8192), 16, 0, 0); } while (0)
#define PG8_LDA(dst, b, h) do { _Pragma("unroll") for (int m = 0; m < 4; ++m) _Pragma("unroll") for (int k = 0; k < 2; ++k) dst[m][k] = *(const LAS bf16x8*)(lds + PG8_SA(b, h) + aoff + m * 2048 + k * 1024); } while (0)
#define PG8_LDB(dst, b, h) do { _Pragma("unroll") for (int n = 0; n < 2; ++n) _Pragma("unroll") for (int k = 0; k < 2; ++k) dst[n][k] = *(const LAS bf16x8*)(lds + PG8_SB(b, h) + boff + n * 2048 + k * 1024); } while (0)
#define PG8_MMA(ai, bj, At, Bt) do { __builtin_amdgcn_s_setprio(1); _Pragma("unroll") for (int m = 0; m < 4; ++m) _Pragma("unroll") for (int n = 0; n < 2; ++n) _Pragma("unroll") for (int k = 0; k < 2; ++k) \
        acc[ai][bj][m][n] = __builtin_amdgcn_mfma_f32_16x16x32_bf16(Bt[n][k], At[m][k], acc[ai][bj][m][n], 0, 0, 0); __builtin_amdgcn_s_setprio(0); } while (0)
#define PG8_WAIT_V(n) asm volatile("s_waitcnt vmcnt(" #n ")" ::: "memory")
#define PG8_WAIT_L(n) asm volatile("s_waitcnt lgkmcnt(" #n ")" ::: "memory")
#define PG8_BAR __builtin_amdgcn_s_barrier()
#define PG8_SCHED __builtin_amdgcn_sched_barrier(0)
    Unit cur, nxt; int ui = 0;
    if (!S.next(0, cur)) return;
    f32x4 acc[2][2][4][2];
#pragma unroll
    for (int a = 0; a < 2; ++a)
#pragma unroll
        for (int b = 0; b < 2; ++b)
#pragma unroll
            for (int m = 0; m < 4; ++m)
#pragma unroll
                for (int n = 0; n < 2; ++n) acc[a][b][m][n] = (f32x4){0.f, 0.f, 0.f, 0.f};
    bf16x8 At[4][2], B0[2][2], B1[2][2];
    const char* cA = cur.a; const char* cB = cur.b;
    PG8_STAGE(PG8_SB(0, 0), cB, voffB); PG8_STAGE(PG8_SB(0, 1), cB + hstepB, voffB); PG8_STAGE(PG8_SA(0, 0), cA, voffA); PG8_STAGE(PG8_SA(0, 1), cA + hstepA, voffA);
    if (wr == 1) PG8_BAR;
    PG8_WAIT_V(2); PG8_BAR;
    PG8_STAGE(PG8_SB(1, 0), cB + kstep, voffB); PG8_STAGE(PG8_SA(1, 0), cA + kstep, voffA); PG8_STAGE(PG8_SB(1, 1), cB + hstepB + kstep, voffB);
    PG8_WAIT_V(6); PG8_BAR;
    for (;;) {
        const bool has_next = S.next(ui + 1, nxt);
        const char* nA = has_next ? nxt.a : cA; const char* nB = has_next ? nxt.b : cB;
        const int nt = cur.nt;
        for (int t = 0; t < nt; t += 2) {
            const bool last = (t == nt - 2);
            const char* a1 = cA + (size_t)(t + 1) * kstep;
            const char* a2 = last ? nA : cA + (size_t)(t + 2) * kstep; const char* b2 = last ? nB : cB + (size_t)(t + 2) * kstep;
            const char* a3 = a2 + kstep; const char* b3 = b2 + kstep;
            PG8_LDB(B0, 0, 0); PG8_LDB(B1, 0, 1); PG8_SCHED; PG8_LDA(At, 0, 0); PG8_STAGE(PG8_SA(1, 1), a1 + hstepA, voffA);
            PG8_WAIT_V(8); PG8_WAIT_L(0); PG8_BAR; PG8_MMA(0, 0, At, B0); PG8_MMA(0, 1, At, B1); PG8_BAR; PG8_SCHED;
            PG8_LDA(At, 0, 1); PG8_STAGE(PG8_SB(0, 0), b2, voffB); PG8_STAGE(PG8_SB(0, 1), b2 + hstepB, voffB); PG8_STAGE(PG8_SA(0, 0), a2, voffA);
            PG8_WAIT_V(8); PG8_WAIT_L(0); PG8_BAR; PG8_MMA(1, 0, At, B0); PG8_MMA(1, 1, At, B1); PG8_BAR; PG8_SCHED;
            PG8_LDB(B0, 1, 0); PG8_LDB(B1, 1, 1); PG8_SCHED; PG8_LDA(At, 1, 0); PG8_STAGE(PG8_SA(0, 1), a2 + hstepA, voffA);
            PG8_WAIT_V(8); PG8_WAIT_L(0); PG8_BAR; PG8_MMA(0, 0, At, B0); PG8_MMA(0, 1, At, B1); PG8_BAR; PG8_SCHED;
            PG8_LDA(At, 1, 1); PG8_STAGE(PG8_SB(1, 0), b3, voffB); PG8_STAGE(PG8_SB(1, 1), b3 + hstepB, voffB); PG8_STAGE(PG8_SA(1, 0), a3, voffA);
            PG8_WAIT_V(8); PG8_WAIT_L(0); PG8_BAR; PG8_MMA(1, 0, At, B0); PG8_MMA(1, 1, At, B1); PG8_BAR; PG8_SCHED;
        }
        if (wr == 0) PG8_BAR;
        E(acc, cur, wr, wc, fr, fq);
        if (!has_next) break;
#pragma unroll
        for (int a = 0; a < 2; ++a)
#pragma unroll
            for (int b = 0; b < 2; ++b)
#pragma unroll
                for (int m = 0; m < 4; ++m)
#pragma unroll
                    for (int n = 0; n < 2; ++n) acc[a][b][m][n] = (f32x4){0.f, 0.f, 0.f, 0.f};
        cur = nxt; cA = nA; cB = nB; ++ui;
        if (wr == 1) PG8_BAR;
    }
    PG8_WAIT_V(0);
    PG8_BAR;
#undef PG8_SA
#undef PG8_SB
#undef PG8_STAGE
#undef PG8_LDA
#undef PG8_LDB
#undef PG8_MMA
#undef PG8_WAIT_V
#undef PG8_WAIT_L
#undef PG8_BAR
#undef PG8_SCHED
}

struct EpiQKV {
    static constexpr bool PERM = true;
    bf16_t* O; const float* bias; const float* rope; const float* rstd;
    __device__ __forceinline__ void operator()(const f32x4 (&acc)[2][2][4][2], const Unit& u, int wr, int wc, int fr, int fq) const {
        const int H = 4 * u.pn + wc, colb = H * 64 + 8 * fq;
        const f32x4 bl0 = *(const f32x4*)(bias + colb), bl1 = *(const f32x4*)(bias + colb + 4), bh0 = *(const f32x4*)(bias + colb + 32), bh1 = *(const f32x4*)(bias + colb + 36);
        const bool rot = H < 18;
        const int row0 = u.pm * 256 + wr * 64 + fr;
        float rs[8];
#pragma unroll
        for (int g = 0; g < 8; ++g) rs[g] = rstd[row0 + (g >> 2) * 128 + (g & 3) * 16];
        f32x4 cs[2][4];
#define QKV_LOADCS(g, b) do { const int row_ = row0 + ((g) >> 2) * 128 + ((g) & 3) * 16; const int pidx_ = row_ < MP ? (row_ & (SEQ - 1)) : SEQ + ((row_ - MP) & 7); \
            const float* rp_ = rope + (size_t)pidx_ * 64 + 8 * fq; cs[b][0] = *(const f32x4*)(rp_); cs[b][1] = *(const f32x4*)(rp_ + 4); cs[b][2] = *(const f32x4*)(rp_ + 32); cs[b][3] = *(const f32x4*)(rp_ + 36); } while (0)
        QKV_LOADCS(0, 0);
#pragma unroll
        for (int g = 0; g < 8; ++g) {
            const int ai = g >> 2, m = g & 3, b = g & 1;
            if (g + 1 < 8) QKV_LOADCS(g + 1, b ^ 1);
            const int row = row0 + ai * 128 + m * 16;
            f32x4 c0 = cs[b][0], c1 = cs[b][1], s0 = cs[b][2], s1 = cs[b][3];
            if (!rot) { c0 = (f32x4){1.f, 1.f, 1.f, 1.f}; c1 = c0; s0 = (f32x4){0.f, 0.f, 0.f, 0.f}; s1 = s0; }
            const float r = rs[g];
            const f32x4 l0 = acc[ai][0][m][0] * r + bl0, l1 = acc[ai][0][m][1] * r + bl1, h0 = acc[ai][1][m][0] * r + bh0, h1 = acc[ai][1][m][1] * r + bh1;
            const f32x4 ol0 = l0 * c0 - h0 * s0, ol1 = l1 * c1 - h1 * s1, oh0 = h0 * c0 + l0 * s0, oh1 = h1 * c1 + l1 * s1;
            bf16_t* op = O + (size_t)row * NQKV + colb;
            u32x4 w; w.x = cvt_pk_bf16(ol0[0], ol0[1]); w.y = cvt_pk_bf16(ol0[2], ol0[3]); w.z = cvt_pk_bf16(ol1[0], ol1[1]); w.w = cvt_pk_bf16(ol1[2], ol1[3]);
            *(u32x4*)op = w;
            w.x = cvt_pk_bf16(oh0[0], oh0[1]); w.y = cvt_pk_bf16(oh0[2], oh0[3]); w.z = cvt_pk_bf16(oh1[0], oh1[1]); w.w = cvt_pk_bf16(oh1[2], oh1[3]);
            *(u32x4*)(op + 32) = w;
        }
#undef QKV_LOADCS
    }
};
template <int MODE> struct EpiPair {
    static constexpr bool PERM = true;
    bf16_t* O0; bf16_t* O1; const float* rstd;
    __device__ __forceinline__ void operator()(const f32x4 (&acc)[2][2][4][2], const Unit& u, int wr, int wc, int fr, int fq) const {
        const int cc = 32 * wc + 8 * fq;
        float rsv[8];
#pragma unroll
        for (int g = 0; g < 8; ++g) rsv[g] = rstd[u.pm * 256 + wr * 64 + fr + (g >> 2) * 128 + (g & 3) * 16];
#pragma unroll
        for (int ai = 0; ai < 2; ++ai)
#pragma unroll
            for (int m = 0; m < 4; ++m) {
                const size_t row = (size_t)(u.pm * 256 + ai * 128 + wr * 64 + m * 16 + fr);
                const float rs = rsv[ai * 4 + m];
                f32x4 p0 = acc[ai][0][m][0] * rs, p1 = acc[ai][0][m][1] * rs, q0 = acc[ai][1][m][0] * rs, q1 = acc[ai][1][m][1] * rs;
                u32x4 w;
                if (MODE == 0) {
                    const float c1 = -rs * LOG2E, c2 = rs * rs;
                    const f32x4 a0 = acc[ai][0][m][0], a1 = acc[ai][0][m][1], b0 = acc[ai][1][m][0], b1 = acc[ai][1][m][1];
                    f32x4 t0 = a0 * c1, t1 = a1 * c1;
#pragma unroll
                    for (int j = 0; j < 4; ++j) { t0[j] = __builtin_amdgcn_exp2f(t0[j]); t1[j] = __builtin_amdgcn_exp2f(t1[j]); }
                    t0 = t0 + 1.0f; t1 = t1 + 1.0f;
#pragma unroll
                    for (int j = 0; j < 4; ++j) { t0[j] = __builtin_amdgcn_rcpf(t0[j]); t1[j] = __builtin_amdgcn_rcpf(t1[j]); }
                    p0 = (a0 * b0) * c2 * t0; p1 = (a1 * b1) * c2 * t1;
                    w.x = cvt_pk_bf16(p0[0], p0[1]); w.y = cvt_pk_bf16(p0[2], p0[3]); w.z = cvt_pk_bf16(p1[0], p1[1]); w.w = cvt_pk_bf16(p1[2], p1[3]);
                    *(u32x4*)(O0 + row * DFF + 128 * u.pn + cc) = w;
                } else if (MODE == 1) {
#pragma unroll
                    for (int j = 0; j < 4; ++j) { float x = p0[j]; p0[j] = x * fast_sigmoid(1.5957691216f * (x + 0.044715f * x * x * x)); x = p1[j]; p1[j] = x * fast_sigmoid(1.5957691216f * (x + 0.044715f * x * x * x)); }
                    w.x = cvt_pk_bf16(p0[0], p0[1]); w.y = cvt_pk_bf16(p0[2], p0[3]); w.z = cvt_pk_bf16(p1[0], p1[1]); w.w = cvt_pk_bf16(p1[2], p1[3]);
                    *(u32x4*)(O0 + row * DM + 128 * u.pn + cc) = w;
                    w.x = cvt_pk_bf16(q0[0], q0[1]); w.y = cvt_pk_bf16(q0[2], q0[3]); w.z = cvt_pk_bf16(q1[0], q1[1]); w.w = cvt_pk_bf16(q1[2], q1[3]);
                    *(u32x4*)(O1 + row * DM + 128 * u.pn + cc) = w;
                } else {
                    if (u.pn < 8) {
                        p0 = p0 * q0; p1 = p1 * q1;
                        w.x = cvt_pk_bf16(p0[0], p0[1]); w.y = cvt_pk_bf16(p0[2], p0[3]); w.z = cvt_pk_bf16(p1[0], p1[1]); w.w = cvt_pk_bf16(p1[2], p1[3]);
                        *(u32x4*)(O0 + row * DM + 128 * u.pn + cc) = w;
                    } else {
                        w.x = cvt_pk_bf16(p0[0], p0[1]); w.y = cvt_pk_bf16(p0[2], p0[3]); w.z = cvt_pk_bf16(p1[0], p1[1]); w.w = cvt_pk_bf16(p1[2], p1[3]);
                        *(u32x4*)(O1 + row * DM + 256 * (u.pn - 8) + cc) = w;
                        w.x = cvt_pk_bf16(q0[0], q0[1]); w.y = cvt_pk_bf16(q0[2], q0[3]); w.z = cvt_pk_bf16(q1[0], q1[1]); w.w = cvt_pk_bf16(q1[2], q1[3]);
                        *(u32x4*)(O1 + row * DM + 256 * (u.pn - 8) + 128 + cc) = w;
                    }
                }
            }
    }
};
struct EpiRgGates {
    static constexpr bool PERM = true;
    const bf16_t* U; bf16_t* LA; bf16_t* Bv; const float* ba; const float* bx; const float* c8;
    __device__ __forceinline__ void operator()(const f32x4 (&acc)[2][2][4][2], const Unit& u, int wr, int wc, int fr, int fq) const {
        const int ch = 128 * u.pn + 32 * wc + 8 * fq;
        f32x4 vba[2], vbx[2], vc8[2];
#pragma unroll
        for (int n = 0; n < 2; ++n) { vba[n] = *(const f32x4*)(ba + ch + 4 * n); vbx[n] = *(const f32x4*)(bx + ch + 4 * n); vc8[n] = *(const f32x4*)(c8 + ch + 4 * n); }
        u32x4 uws[8];
#pragma unroll
        for (int g = 0; g < 8; ++g) uws[g] = *(const u32x4*)(U + (size_t)(u.pm * 256 + (g >> 2) * 128 + wr * 64 + (g & 3) * 16 + fr) * DM + ch);
#pragma unroll
        for (int ai = 0; ai < 2; ++ai)
#pragma unroll
            for (int m = 0; m < 4; ++m) {
                const size_t off = (size_t)(u.pm * 256 + ai * 128 + wr * 64 + m * 16 + fr) * DM + ch;
                const u32x4 uw = uws[ai * 4 + m];
                float la[8], bb[8];
#pragma unroll
                for (int n = 0; n < 2; ++n)
#pragma unroll
                    for (int j = 0; j < 4; ++j) {
                        const float r = fast_sigmoid(acc[ai][0][m][n][j] + vba[n][j]), ig = fast_sigmoid(acc[ai][1][m][n][j] + vbx[n][j]);
                        const float l2 = vc8[n][j] * r; const float a2 = __builtin_amdgcn_exp2f(2.f * l2);
                        const unsigned uu = uw[n * 2 + (j >> 1)]; const float uv = (j & 1) ? bfhi(uu) : bflo(uu);
                        la[n * 4 + j] = l2; bb[n * 4 + j] = __builtin_sqrtf(fmaxf(1.f - a2, 0.f)) * ig * uv;
                    }
                u32x4 w; w.x = cvt_pk_bf16(la[0], la[1]); w.y = cvt_pk_bf16(la[2], la[3]); w.z = cvt_pk_bf16(la[4], la[5]); w.w = cvt_pk_bf16(la[6], la[7]);
                *(u32x4*)(LA + off) = w;
                w.x = cvt_pk_bf16(bb[0], bb[1]); w.y = cvt_pk_bf16(bb[2], bb[3]); w.z = cvt_pk_bf16(bb[4], bb[5]); w.w = cvt_pk_bf16(bb[6], bb[7]);
                *(u32x4*)(Bv + off) = w;
            }
    }
};
template <bool FIRST> struct EpiResid {
    static constexpr bool PERM = true;
    const float* Xin; float* PART; const float* bias; bf16_t* XB; float* SS;
    __device__ __forceinline__ void operator()(const f32x4 (&acc)[2][2][4][2], const Unit& u, int wr, int wc, int fr, int fq) const {
        const int col0 = u.pn * 256 + wc * 32 + 8 * fq;
        if (u.aux == 0) {
            f32x4 bv[2][2];
#pragma unroll
            for (int bj = 0; bj < 2; ++bj)
#pragma unroll
                for (int n = 0; n < 2; ++n) bv[bj][n] = *(const f32x4*)(bias + col0 + bj * 128 + 4 * n);
            const size_t row0 = (size_t)(u.pm * 256 + wr * 64 + fr);
            f32x4 xin[2][4];
#define RES_LOAD(g, b) do { if (FIRST) { const float* xp_ = Xin + (row0 + ((g) >> 2) * 128 + ((g) & 3) * 16) * DM + col0; \
                    xin[b][0] = __builtin_nontemporal_load((const f32x4*)(xp_)); xin[b][1] = __builtin_nontemporal_load((const f32x4*)(xp_ + 4)); xin[b][2] = __builtin_nontemporal_load((const f32x4*)(xp_ + 128)); xin[b][3] = __builtin_nontemporal_load((const f32x4*)(xp_ + 132)); } \
                else { const bf16_t* xp_ = XB + (row0 + ((g) >> 2) * 128 + ((g) & 3) * 16) * DM + col0; \
                    _Pragma("unroll") for (int q_ = 0; q_ < 2; ++q_) { const u32x4 w_ = *(const u32x4*)(xp_ + q_ * 128); \
                        xin[b][2 * q_] = (f32x4){bflo(w_.x), bfhi(w_.x), bflo(w_.y), bfhi(w_.y)}; xin[b][2 * q_ + 1] = (f32x4){bflo(w_.z), bfhi(w_.z), bflo(w_.w), bfhi(w_.w)}; } } } while (0)
            RES_LOAD(0, 0);
#pragma unroll
            for (int g = 0; g < 8; ++g) {
                const int ai = g >> 2, m = g & 3, b = g & 1;
                if (g + 1 < 8) RES_LOAD(g + 1, b ^ 1);
                const size_t row = row0 + ai * 128 + m * 16;
                bf16_t* bp = XB + row * DM + col0;
                float ss = 0.f;
#pragma unroll
                for (int bj = 0; bj < 2; ++bj) {
                    const f32x4 v0 = xin[b][bj * 2] + acc[ai][bj][m][0] + bv[bj][0], v1 = xin[b][bj * 2 + 1] + acc[ai][bj][m][1] + bv[bj][1];
                    u32x4 w; w.x = cvt_pk_bf16(v0[0], v0[1]); w.y = cvt_pk_bf16(v0[2], v0[3]); w.z = cvt_pk_bf16(v1[0], v1[1]); w.w = cvt_pk_bf16(v1[2], v1[3]);
                    *(u32x4*)(bp + bj * 128) = w;
                    ss += ((v0[0] * v0[0] + v0[1] * v0[1]) + (v0[2] * v0[2] + v0[3] * v0[3])) + ((v1[0] * v1[0] + v1[1] * v1[1]) + (v1[2] * v1[2] + v1[3] * v1[3]));
                }
                ss = xor16_add(ss); ss = xor32_add(ss);
                if (fq == 0) SS[row * 16 + u.pn * 4 + wc] = ss;
            }
#undef RES_LOAD
        } else {
            bf16_t* pp = (bf16_t*)PART + (size_t)(u.aux - 1) * MS * DM;
#pragma unroll
            for (int ai = 0; ai < 2; ++ai)
#pragma unroll
                for (int m = 0; m < 4; ++m) {
                    bf16_t* xp = pp + (size_t)(u.pm * 256 - MP + ai * 128 + wr * 64 + m * 16 + fr) * DM + col0;
#pragma unroll
                    for (int bj = 0; bj < 2; ++bj) {
                        const f32x4 v0 = acc[ai][bj][m][0], v1 = acc[ai][bj][m][1];
                        u32x4 w; w.x = cvt_pk_bf16(v0[0], v0[1]); w.y = cvt_pk_bf16(v0[2], v0[3]); w.z = cvt_pk_bf16(v1[0], v1[1]); w.w = cvt_pk_bf16(v1[2], v1[3]);
                        *(u32x4*)(xp + bj * 128) = w;
                    }
                }
        }
    }
};
}

struct Params { const float* in[31]; float* out; unsigned char* ws; int ph_lo, ph_hi; };

__device__ __forceinline__ unsigned f2bf(float f) { unsigned u = __builtin_bit_cast(unsigned, f); return (u + 0x7fffu + ((u >> 16) & 1u)) >> 16; }
__device__ __forceinline__ unsigned pk2(float lo, float hi) { return f2bf(lo) | (f2bf(hi) << 16); }

struct TItem { const float* S; int Ns, K, n0, k0; bf16_t* WT; const float* gk; };
__device__ __forceinline__ void titem_load(const TItem& t, float (&tv)[32], int lane) {
#pragma unroll
    for (int i = 0; i < 32; ++i) tv[i] = __builtin_nontemporal_load(t.S + (size_t)(t.k0 + 2 * i + (lane >> 5)) * t.Ns + (lane & 31));
}
__device__ __forceinline__ void titem_finish(const TItem& t, const float (&tv)[32], LAS float* scr, int lane) {
    const int c = lane & 7;
    f32x4 g0 = (f32x4){1.f, 1.f, 1.f, 1.f}, g1 = g0;
    if (t.gk) { g0 = *(const f32x4*)(t.gk + t.k0 + 8 * c); g1 = *(const f32x4*)(t.gk + t.k0 + 8 * c + 4); }
#pragma unroll
    for (int i = 0; i < 32; ++i) scr[(2 * i + (lane >> 5)) * 33 + (lane & 31)] = tv[i];
    asm volatile("s_waitcnt lgkmcnt(0)" ::: "memory");
#pragma unroll
    for (int j = 0; j < 4; ++j) { const int n = (lane >> 3) + 8 * j; const LAS float* s = scr + (8 * c) * 33 + n;
        u32x4 o; o.x = pk2(s[0 * 33] * g0.x, s[1 * 33] * g0.y); o.y = pk2(s[2 * 33] * g0.z, s[3 * 33] * g0.w); o.z = pk2(s[4 * 33] * g1.x, s[5 * 33] * g1.y); o.w = pk2(s[6 * 33] * g1.z, s[7 * 33] * g1.w);
        *(u32x4*)(t.WT + (size_t)(t.n0 + n) * t.K + t.k0 + 8 * c) = o; }
    asm volatile("s_waitcnt lgkmcnt(0)" ::: "memory");
}

__device__ __forceinline__ bool titem_decode(const Params& p, unsigned char* ws, int it, TItem& t) {
    constexpr int I_QKV = 16 * 40, I_SQ = 16 * 32, I_FU = 16 * 176, I_FD = 44 * 32, I_RG1 = 16 * 64, I_RG2 = 4 * 64, I_SC1 = 16 * 96;
    constexpr int NITEMS = 2 * I_QKV + 2 * I_SQ + 4 * I_FU + 4 * I_FD + I_RG1 + I_RG2 + I_SQ + I_SC1 + I_SQ;
    if (it >= NITEMS) return false;
        int r = it;
        const float* S; int Ns, K, n0, k0; bf16_t* WT; const float* gk = nullptr;
        if (r < 2 * I_QKV) { const int j = r / I_QKV; r -= j * I_QKV; K = 1024; const int nb = r % 40, kb = r / 40; k0 = 64 * kb; n0 = 32 * nb;
            const int pn = nb >> 3, bj = (nb >> 2) & 1, hh = nb & 3; Ns = NQKV; S = p.in[10] + (size_t)j * 1024 * NQKV + (4 * pn + hh) * 64 + 32 * bj; WT = (bf16_t*)(ws + WS_WQKV) + (size_t)j * NQKV * 1024; gk = p.in[7] + 3 * j * DM; }
        else if ((r -= 2 * I_QKV) < 2 * I_SQ) { const int j = r / I_SQ; r -= j * I_SQ; K = 1024; const int nb = r % 32, kb = r / 32; k0 = 64 * kb; n0 = 32 * nb; Ns = 1024; S = p.in[12] + (size_t)j * 1024 * 1024 + n0; WT = (bf16_t*)(ws + WS_WO) + (size_t)j * 1024 * 1024; }
        else if ((r -= 2 * I_SQ) < 4 * I_FU) { const int i = r / I_FU; r -= i * I_FU; K = 1024; const int nb = r % 176, kb = r / 176; k0 = 64 * kb; n0 = 32 * nb;
            const int pn = nb >> 3, bj = (nb >> 2) & 1, c32 = nb & 3; Ns = DFF; S = (bj ? p.in[29] : p.in[28]) + (size_t)i * 1024 * DFF + 128 * pn + 32 * c32; WT = (bf16_t*)(ws + WS_WFU) + (size_t)i * 5632 * 1024; gk = p.in[8] + i * DM; }
        else if ((r -= 4 * I_FU) < 4 * I_FD) { const int i = r / I_FD; r -= i * I_FD; K = DFF; const int nb = r % 32, kb = r / 32; k0 = 64 * kb; n0 = 32 * nb; Ns = 1024; S = p.in[30] + (size_t)i * DFF * 1024 + n0; WT = (bf16_t*)(ws + WS_WFD) + (size_t)i * 1024 * DFF; }
        else if ((r -= 4 * I_FD) < I_RG1) { K = 1024; const int nb = r % 64, kb = r / 64; k0 = 64 * kb; n0 = 32 * nb;
            const int pn = nb >> 3, bj = (nb >> 2) & 1, c32 = nb & 3; Ns = 1024; S = (bj ? p.in[16] : p.in[15]) + 128 * pn + 32 * c32; WT = (bf16_t*)(ws + WS_WRG1); gk = p.in[7] + 1 * DM; }
        else if ((r -= I_RG1) < I_RG2) { K = 256; const int nb = r % 64, kb = r / 64; k0 = 64 * kb; n0 = 32 * nb;
            const int pn = nb >> 3, bj = (nb >> 2) & 1, c32 = nb & 3; Ns = 256; S = (bj ? p.in[21] : p.in[19]) + (size_t)(pn >> 1) * 65536 + 128 * (pn & 1) + 32 * c32; WT = (bf16_t*)(ws + WS_WRG2); }
        else if ((r -= I_RG2) < I_SQ) { K = 1024; const int nb = r % 32, kb = r / 32; k0 = 64 * kb; n0 = 32 * nb; Ns = 1024; S = p.in[24] + n0; WT = (bf16_t*)(ws + WS_WRG3); }
        else if ((r -= I_SQ) < I_SC1) { K = 1024; const int nb = r % 96, kb = r / 96; k0 = 64 * kb; n0 = 32 * nb;
            const int pn = nb >> 3, bj = (nb >> 2) & 1, c32 = nb & 3; Ns = 3072;
            const int col = pn < 8 ? (bj ? 2048 : 1024) + 128 * pn + 32 * c32 : 256 * (pn - 8) + 128 * bj + 32 * c32; S = p.in[25] + col; WT = (bf16_t*)(ws + WS_WSC1); gk = p.in[7] + 2 * DM; }
        else { r -= I_SC1; K = 1024; const int nb = r % 32, kb = r / 32; k0 = 64 * kb; n0 = 32 * nb; Ns = 1024; S = p.in[27] + n0; WT = (bf16_t*)(ws + WS_WSC2); }
        t.S = S; t.Ns = Ns; t.K = K; t.n0 = n0; t.k0 = k0; t.WT = WT; t.gk = gk;
    return true;
}

__device__ __forceinline__ int set_size(int s) { return s == 0 ? 640 : s == 1 ? 6528 : s == 2 ? 6272 : s == 3 ? 4224 : 5376; }
__device__ __forceinline__ int set_item(int s, int k) {
    if (s == 0) return k;
    if (s == 1) { if (k < 512) return 1280 + k; k -= 512; if (k < 2816) return 2304 + k; k -= 2816; if (k < 1408) return 13568 + k; k -= 1408; return 19200 + k; }
    if (s == 2) { if (k < 2816) return 5120 + k; k -= 2816; if (k < 1408) return 14976 + k; k -= 1408; return 20992 + k; }
    if (s == 3) { if (k < 2816) return 7936 + k; k -= 2816; return 16384 + k; }
    if (k < 640) return 640 + k; k -= 640; if (k < 512) return 1792 + k; k -= 512; if (k < 2816) return 10752 + k; k -= 2816; return 17792 + k;
}
__device__ __forceinline__ void convert_set(const Params& p, unsigned char* ws, LAS float* scr, int set, int widx, int nw, int lane) {
    const int n = set_size(set);
    TItem cur, nxt; float tv[32], tn[32];
    int k = widx;
    bool has = k < n;
    if (has) { titem_decode(p, ws, set_item(set, k), cur); titem_load(cur, tv, lane); }
    while (has) {
        k += nw;
        const bool hn = k < n;
        if (hn) { titem_decode(p, ws, set_item(set, k), nxt); titem_load(nxt, tn, lane); }
        titem_finish(cur, tv, scr, lane);
#pragma unroll
        for (int i = 0; i < 32; ++i) tv[i] = tn[i];
        cur = nxt; has = hn;
    }
}
__device__ __forceinline__ void convert_in_slack(const Params& p, unsigned char* ws, LAS unsigned char* lds, int set, int nU, int vcu, int G, const int tid) {
    const int first = nU % G, nidle = first == 0 ? G : G - first;
    const int k0 = first == 0 ? 0 : first;
    if (vcu < k0) return;
    const int lane = tid & 63, wave = __builtin_amdgcn_readfirstlane(tid >> 6);
    convert_set(p, ws, (LAS float*)(lds + wave * 16384), set, (vcu - k0) * 8 + wave, nidle * 8, lane);
}

__device__ __forceinline__ void prep_phase(const Params& p, LAS unsigned char* lds, int vcu, int G, const int tid) {
    const int lane = tid & 63, wave = __builtin_amdgcn_readfirstlane(tid >> 6);
    LAS float* scr = (LAS float*)(lds + wave * 16384);
    const int gw = vcu * 8 + wave, NGW = G * 8;
    unsigned char* ws = p.ws;
    convert_set(p, ws, scr, 0, gw, NGW, lane);
    {
        float* rstd = (float*)(ws + WS_RSTD);
        for (int m = gw; m < M; m += NGW) {
            const float* src = m < MP ? p.in[0] + (size_t)m * DM : p.in[1] + (size_t)(m - MP) * DM;
            f32x4 v[4]; float s = 0.f;
#pragma unroll
            for (int j = 0; j < 4; ++j) { v[j] = __builtin_nontemporal_load((const f32x4*)src + lane + 64 * j); s += (v[j].x * v[j].x + v[j].y * v[j].y) + (v[j].z * v[j].z + v[j].w * v[j].w); }
            s = wave_sum(s);
            if (lane == 0) rstd[m] = 1.0f / sqrtf(s * (1.f / DM) + EPS);
            u32x2* no = (u32x2*)((bf16_t*)(ws + WS_XN) + (size_t)m * DM) + lane;
#pragma unroll
            for (int j = 0; j < 4; ++j) { u32x2 w; w.x = cvt_pk_bf16(v[j].x, v[j].y); w.y = cvt_pk_bf16(v[j].z, v[j].w); no[64 * j] = w; }
        }
    }
    {
        const int gt = vcu * 512 + tid, NGT = G * 512;
        float* rope = (float*)(ws + WS_ROPE);
        for (int e = gt; e < 4104 * 32; e += NGT) {
            const int pi = e >> 5, d = e & 31; const int pos = pi < SEQ ? pi : 8192 + (pi - SEQ);
            double inv = 1.0; for (int k = 0; k < d; ++k) inv *= 0.7498942093324559;
            const float ang = (float)pos * (float)inv;
            const double rev = (double)ang * 0.15915494309189535; const double fr = rev - __builtin_rint(rev);
            rope[(size_t)pi * 64 + d] = __builtin_amdgcn_cosf((float)fr); rope[(size_t)pi * 64 + 32 + d] = __builtin_amdgcn_sinf((float)fr);
        }
        float* c8 = (float*)(ws + WS_C8);
        for (int e = gt; e < 1024; e += NGT) { const float lam = p.in[23][e]; c8[e] = -8.0f * log1pf(__expf(-lam)) * LOG2E; ((float*)(ws + WS_ZB))[e] = 0.f; }
    }
}

__device__ __forceinline__ void norm_phase(float* X, const float* PART, int nsplit, const float* bias, const float* g, bf16_t* XN, bool final_, int vcu, int G, const int tid) {
    const int lane = tid & 63, wave = tid >> 6;
    const int gw = vcu * 8 + wave, NGW = G * 8;
    f32x4 gv[4];
#pragma unroll
    for (int j = 0; j < 4; ++j) gv[j] = *((const f32x4*)g + lane + 64 * j);
    for (int m = gw; m < M; m += NGW) {
        f32x4* xr = (f32x4*)(X + (size_t)m * DM) + lane;
        f32x4 v[4]; float s = 0.f;
        if (m >= MP) {
#pragma unroll
            for (int j = 0; j < 4; ++j) v[j] = xr[64 * j];
        } else {
            const u32x2* br = (const u32x2*)(XN + (size_t)m * DM) + lane;
#pragma unroll
            for (int j = 0; j < 4; ++j) { const u32x2 w = __builtin_nontemporal_load(br + 64 * j); v[j] = (f32x4){bflo(w.x), bfhi(w.x), bflo(w.y), bfhi(w.y)}; }
        }
        if (m >= MP) {
#pragma unroll 4
            for (int sl = 0; sl < nsplit; ++sl) { const u32x2* pr = (const u32x2*)((const bf16_t*)PART + ((size_t)sl * MS + (m - MP)) * DM) + lane;
#pragma unroll
                for (int j = 0; j < 4; ++j) { const u32x2 w = pr[64 * j]; v[j] += (f32x4){bflo(w.x), bfhi(w.x), bflo(w.y), bfhi(w.y)}; } }
            if (bias) {
#pragma unroll
                for (int j = 0; j < 4; ++j) v[j] += *((const f32x4*)bias + lane + 64 * j); }
            if (!final_) {
#pragma unroll
                for (int j = 0; j < 4; ++j) xr[64 * j] = v[j]; }
        }
#pragma unroll
        for (int j = 0; j < 4; ++j) s += (v[j].x * v[j].x + v[j].y * v[j].y) + (v[j].z * v[j].z + v[j].w * v[j].w);
        const float rstd = 1.0f / sqrtf(wave_sum(s) * (1.f / DM) + EPS);
        if (final_) {
#pragma unroll
            for (int j = 0; j < 4; ++j) __builtin_nontemporal_store(v[j] * rstd * gv[j], xr + 64 * j);
        } else {
            u32x2* no = (u32x2*)(XN + (size_t)m * DM) + lane;
#pragma unroll
            for (int j = 0; j < 4; ++j) { const f32x4 y = v[j] * rstd * gv[j]; u32x2 w; w.x = cvt_pk_bf16(y.x, y.y); w.y = cvt_pk_bf16(y.z, y.w); no[64 * j] = w; }
        }
    }
}

__device__ __forceinline__ void fin_phase(const float* Xin, float* X, const float* PART, int nsplit, const float* bias, bf16_t* XB, const float* SS, float* rstd, int vcu, int G, const int tid) {
    const int lane = tid & 63, wave = tid >> 6;
    const int gw = vcu * 8 + wave, NGW = G * 8;
    for (int r = gw; r < MS; r += NGW) {
        const int m = MP + r;
        f32x4* xr = (f32x4*)(X + (size_t)m * DM) + lane;
        const f32x4* xi = (const f32x4*)(Xin + (size_t)r * DM) + lane;
        f32x4 v[4]; float s = 0.f;
#pragma unroll
        for (int j = 0; j < 4; ++j) v[j] = xi[64 * j];
#pragma unroll 4
        for (int sl = 0; sl < nsplit; ++sl) { const u32x2* pr = (const u32x2*)((const bf16_t*)PART + ((size_t)sl * MS + r) * DM) + lane;
#pragma unroll
            for (int j = 0; j < 4; ++j) { const u32x2 w = pr[64 * j]; v[j] += (f32x4){bflo(w.x), bfhi(w.x), bflo(w.y), bfhi(w.y)}; } }
        if (bias) {
#pragma unroll
            for (int j = 0; j < 4; ++j) v[j] += *((const f32x4*)bias + lane + 64 * j); }
        u32x2* no = (u32x2*)(XB + (size_t)m * DM) + lane;
#pragma unroll
        for (int j = 0; j < 4; ++j) { xr[64 * j] = v[j]; u32x2 w; w.x = cvt_pk_bf16(v[j].x, v[j].y); w.y = cvt_pk_bf16(v[j].z, v[j].w); no[64 * j] = w;
            s += (v[j].x * v[j].x + v[j].y * v[j].y) + (v[j].z * v[j].z + v[j].w * v[j].w); }
        s = wave_sum(s);
        if (lane == 0) rstd[m] = 1.0f / sqrtf(s * (1.f / DM) + EPS);
    }
    const int gt = vcu * 512 + tid, NGT = G * 512;
    for (int m = NGT - 1 - gt; m < MP; m += NGT) {
        const f32x4* sp = (const f32x4*)(SS + (size_t)m * 16);
        const f32x4 a = sp[0], b = sp[1], c = sp[2], d = sp[3];
        const float s = ((a.x + a.y) + (a.z + a.w)) + ((b.x + b.y) + (b.z + b.w)) + ((c.x + c.y) + (c.z + c.w)) + ((d.x + d.y) + (d.z + d.w));
        rstd[m] = 1.0f / sqrtf(s * (1.f / DM) + EPS);
    }
}

constexpr int KS_PITCH = 72, VT_PITCH = 260;
constexpr int ATT_KS = 0, ATT_VT = 256 * KS_PITCH * 2;
__device__ __forceinline__ void attn_phase(const Params& p, LAS unsigned char* lds, int j, int vcu, int G, const int tid) {
    const int lane = tid & 63, wave = __builtin_amdgcn_readfirstlane(tid >> 6), l31 = lane & 31, hi = lane >> 5;
    const bf16_t* QKV = (const bf16_t*)(p.ws + WS_S0);
    bf16_t* O = (bf16_t*)(p.ws + WS_S2);
    LAS bf16_t* Ks = (LAS bf16_t*)(lds + ATT_KS);
    LAS bf16_t* Vt = (LAS bf16_t*)(lds + ATT_VT);
    const float* ck = p.in[2] + (size_t)j * 128 * 128 * 128;
    const float* cv = p.in[3] + (size_t)j * 128 * 128 * 128;
    {
        const int gt = vcu * 512 + tid, NGT = G * 512;
        float* kp = p.out + O_KP + (size_t)j * 65536; float* vp = p.out + O_VP + (size_t)j * 65536;
        for (int e = gt; e < 65536; e += NGT) { const int d = e & 127, t = (e >> 7) & 127, b = e >> 14; const size_t src = (size_t)(b * SEQ + SEQ - 128 + t) * NQKV + 1024 + d;
            kp[e] = bf2f(QKV[src]); vp[e] = bf2f(QKV[src + 128]); }
        float* ksn = p.out + O_KS + (size_t)j * 2097152; float* vsn = p.out + O_VS + (size_t)j * 2097152;
        f32x4 kv4[4], vv4[4];
#pragma unroll
        for (int it = 0; it < 4; ++it) {
            const int e4 = gt + it * NGT;
            if (e4 < 524288) { const int e = e4 * 4, d = e & 127, c = (e >> 7) & 127, b = e >> 14;
                if (c < 120) { kv4[it] = __builtin_nontemporal_load((const f32x4*)(ck + e + 8 * 128)); vv4[it] = __builtin_nontemporal_load((const f32x4*)(cv + e + 8 * 128)); }
                else { const size_t src = (size_t)(MP + b * 8 + c - 120) * NQKV + 1024 + d; const u32x2 kw = *(const u32x2*)(QKV + src), vw = *(const u32x2*)(QKV + src + 128);
                    kv4[it] = (f32x4){bflo(kw.x), bfhi(kw.x), bflo(kw.y), bfhi(kw.y)}; vv4[it] = (f32x4){bflo(vw.x), bfhi(vw.x), bflo(vw.y), bfhi(vw.y)}; } }
        }
#pragma unroll
        for (int it = 0; it < 4; ++it) { const int e4 = gt + it * NGT; if (e4 < 524288) { __builtin_nontemporal_store(kv4[it], (f32x4*)(ksn + (size_t)e4 * 4)); __builtin_nontemporal_store(vv4[it], (f32x4*)(vsn + (size_t)e4 * 4)); } }
        for (int e4 = gt + 4 * NGT; e4 < 524288; e4 += NGT) {
            const int e = e4 * 4, d = e & 127, c = (e >> 7) & 127, b = e >> 14;
            if (c < 120) { *(f32x4*)(ksn + e) = *(const f32x4*)(ck + e + 8 * 128); *(f32x4*)(vsn + e) = *(const f32x4*)(cv + e + 8 * 128); }
            else { const size_t src = (size_t)(MP + b * 8 + c - 120) * NQKV + 1024 + d; const u32x2 kw = *(const u32x2*)(QKV + src), vw = *(const u32x2*)(QKV + src + 128);
                *(f32x4*)(ksn + e) = (f32x4){bflo(kw.x), bfhi(kw.x), bflo(kw.y), bfhi(kw.y)}; *(f32x4*)(vsn + e) = (f32x4){bflo(vw.x), bfhi(vw.x), bflo(vw.y), bfhi(vw.y)}; }
        }
    }
    for (int un = vcu; un < 512; un += G) {
        const bool prompt = un < 256;
        int b, kvh, nb = 0;
        if (prompt) { b = un >> 6; kvh = (un >> 5) & 1; nb = un & 31; } else { const int s = un - 256; b = s >> 1; kvh = s & 1; }
        const int nkeys = prompt ? 256 : 160;
        for (int id = tid; id < nkeys * 8; id += 512) {
            const int key = id >> 3, ch = id & 7;
            u32x4 w = (u32x4){0u, 0u, 0u, 0u};
            if (prompt) { if (!(nb == 0 && key < 128)) w = *(const u32x4*)(QKV + (size_t)(b * SEQ + 128 * (nb - 1) + key) * NQKV + 1024 + kvh * 64 + 8 * ch); }
            else if (key < 128) { const float* s = ck + ((size_t)(b * 128 + key) * 2 + kvh) * 64 + 8 * ch; const f32x4 a = *(const f32x4*)s, c = *(const f32x4*)(s + 4);
                w.x = cvt_pk_bf16(a.x, a.y); w.y = cvt_pk_bf16(a.z, a.w); w.z = cvt_pk_bf16(c.x, c.y); w.w = cvt_pk_bf16(c.z, c.w); }
            else if (key < 136) w = *(const u32x4*)(QKV + (size_t)(MP + b * 8 + key - 128) * NQKV + 1024 + kvh * 64 + 8 * ch);
            *(LAS u32x4*)(Ks + key * KS_PITCH + 8 * ch) = w;
        }
        for (int id = tid; id < nkeys * 8; id += 512) {
            const int key = id % nkeys, ch = id / nkeys;
            u32x4 w = (u32x4){0u, 0u, 0u, 0u};
            if (prompt) { if (!(nb == 0 && key < 128)) w = *(const u32x4*)(QKV + (size_t)(b * SEQ + 128 * (nb - 1) + key) * NQKV + 1152 + kvh * 64 + 8 * ch); }
            else if (key < 128) { const float* s = cv + ((size_t)(b * 128 + key) * 2 + kvh) * 64 + 8 * ch; const f32x4 a = *(const f32x4*)s, c = *(const f32x4*)(s + 4);
                w.x = cvt_pk_bf16(a.x, a.y); w.y = cvt_pk_bf16(a.z, a.w); w.z = cvt_pk_bf16(c.x, c.y); w.w = cvt_pk_bf16(c.z, c.w); }
            else if (key < 136) w = *(const u32x4*)(QKV + (size_t)(MP + b * 8 + key - 128) * NQKV + 1152 + kvh * 64 + 8 * ch);
            LAS bf16_t* vd = Vt + (8 * ch) * VT_PITCH + key;
            vd[0 * VT_PITCH] = (bf16_t)(w.x & 0xffff); vd[1 * VT_PITCH] = (bf16_t)(w.x >> 16); vd[2 * VT_PITCH] = (bf16_t)(w.y & 0xffff); vd[3 * VT_PITCH] = (bf16_t)(w.y >> 16);
            vd[4 * VT_PITCH] = (bf16_t)(w.z & 0xffff); vd[5 * VT_PITCH] = (bf16_t)(w.z >> 16); vd[6 * VT_PITCH] = (bf16_t)(w.w & 0xffff); vd[7 * VT_PITCH] = (bf16_t)(w.w >> 16);
        }
        __syncthreads();
        const int h = kvh * 8 + wave;
        const float sink8 = p.in[14][j * 16 + h] * 8.0f;
        const int nqs = prompt ? 4 : 1;
        for (int qs = 0; qs < nqs; ++qs) {
            const int qi = 32 * qs + l31;
            const bool qvalid = prompt || l31 < 8;
            const size_t qrow = prompt ? (size_t)(b * SEQ + 128 * nb + qi) : (size_t)(MP + b * 8 + (l31 < 8 ? l31 : 7));
            bf16x8 qf[4];
#pragma unroll
            for (int d0 = 0; d0 < 4; ++d0) qf[d0] = *(const bf16x8*)(QKV + qrow * NQKV + h * 64 + 16 * d0 + 8 * hi);
            constexpr float CS = 0.125f * LOG2E;
            float mrun = sink8, lrun = hi == 0 ? 1.f : 0.f;
            f32x16 o0 = {}, o1 = {};
            const int kt_lo = (prompt && nb == 0 && qs < 4) ? 4 : qs;
            for (int kt = kt_lo; kt < qs + 5; ++kt) {
                f32x16 s = {};
#pragma unroll
                for (int d0 = 0; d0 < 4; ++d0) { const bf16x8 kf = *(const LAS bf16x8*)(Ks + (32 * kt + l31) * KS_PITCH + 16 * d0 + 8 * hi); s = __builtin_amdgcn_mfma_f32_32x32x16_bf16(kf, qf[d0], s, 0, 0, 0); }
                if (kt == qs || kt == qs + 4) {
#pragma unroll
                    for (int r = 0; r < 16; ++r) { const int c = 32 * kt + (r & 3) + 8 * (r >> 2) + 4 * hi; const bool ok = (c > qi) && (c <= qi + 128); s[r] = ok ? s[r] : -1e30f; }
                }
                float mx = fmaxf(fmaxf(s[0], s[1]), fmaxf(s[2], s[3]));
#pragma unroll
                for (int r = 4; r < 16; r += 4) mx = fmaxf(mx, fmaxf(fmaxf(s[r], s[r + 1]), fmaxf(s[r + 2], s[r + 3])));
                mx = fmaxf(mx, __shfl_xor(mx, 32));
                if (__any(mx > mrun)) {
                    const float mnew = fmaxf(mrun, mx), alpha = __builtin_amdgcn_exp2f((mrun - mnew) * CS);
                    lrun *= alpha; mrun = mnew;
#pragma unroll
                    for (int r = 0; r < 16; ++r) { o0[r] *= alpha; o1[r] *= alpha; }
                }
                const float mc = -mrun * CS;
                float ps = 0.f;
#pragma unroll
                for (int r = 0; r < 16; ++r) { s[r] = __builtin_amdgcn_exp2f(__builtin_fmaf(s[r], CS, mc)); ps += s[r]; }
                lrun += ps;
#pragma unroll
                for (int ss = 0; ss < 2; ++ss) {
                    u32x4 pw; pw.x = cvt_pk_bf16(s[8 * ss + 0], s[8 * ss + 1]); pw.y = cvt_pk_bf16(s[8 * ss + 2], s[8 * ss + 3]); pw.z = cvt_pk_bf16(s[8 * ss + 4], s[8 * ss + 5]); pw.w = cvt_pk_bf16(s[8 * ss + 6], s[8 * ss + 7]);
                    const bf16x8 pb = __builtin_bit_cast(bf16x8, pw);
                    const LAS bf16_t* vb = Vt + l31 * VT_PITCH + 32 * kt + 16 * ss + 4 * hi;
                    const s16x4 a0 = *(const LAS s16x4*)(vb), a1 = *(const LAS s16x4*)(vb + 8);
                    const s16x4 c0 = *(const LAS s16x4*)(vb + 32 * VT_PITCH), c1 = *(const LAS s16x4*)(vb + 32 * VT_PITCH + 8);
                    const bf16x8 v0 = (bf16x8){a0[0], a0[1], a0[2], a0[3], a1[0], a1[1], a1[2], a1[3]};
                    const bf16x8 v1 = (bf16x8){c0[0], c0[1], c0[2], c0[3], c1[0], c1[1], c1[2], c1[3]};
                    o0 = __builtin_amdgcn_mfma_f32_32x32x16_bf16(v0, pb, o0, 0, 0, 0);
                    o1 = __builtin_amdgcn_mfma_f32_32x32x16_bf16(v1, pb, o1, 0, 0, 0);
                }
            }
            const float ltot = lrun + __shfl_xor(lrun, 32);
            const float inv = 1.0f / ltot;
            if (qvalid) {
                const size_t orow = prompt ? (size_t)(b * SEQ + 128 * nb + qi) : (size_t)(MP + b * 8 + l31);
                bf16_t* op = O + orow * DM + h * 64 + 4 * hi;
#pragma unroll
                for (int r4 = 0; r4 < 4; ++r4) {
                    u32x2 w; w.x = cvt_pk_bf16(o0[4 * r4] * inv, o0[4 * r4 + 1] * inv); w.y = cvt_pk_bf16(o0[4 * r4 + 2] * inv, o0[4 * r4 + 3] * inv); *(u32x2*)(op + 8 * r4) = w;
                    w.x = cvt_pk_bf16(o1[4 * r4] * inv, o1[4 * r4 + 1] * inv); w.y = cvt_pk_bf16(o1[4 * r4 + 2] * inv, o1[4 * r4 + 3] * inv); *(u32x2*)(op + 32 + 8 * r4) = w;
                }
            }
        }
        __syncthreads();
    }
}

__device__ __forceinline__ void rgconv_phase(const Params& p, int vcu, int G, const int tid) {
    const int gt = vcu * 512 + tid, NGT = G * 512;
    const bf16_t* __restrict__ V = (const bf16_t*)(p.ws + WS_S1); bf16_t* __restrict__ U = (bf16_t*)(p.ws + WS_S3);
    const float* __restrict__ cw = p.in[17]; const float* __restrict__ cb = p.in[18]; const float* __restrict__ buf = p.in[5];
#pragma unroll 2
    for (int e = gt; e < M * 128; e += NGT) {
        const int row = e >> 7, ch = (e & 127) * 8;
        int t, T; const float* sb = nullptr;
        if (row < MP) { t = row & (SEQ - 1); T = SEQ; } else { t = (row - MP) & 7; T = 8; sb = buf + (size_t)((row - MP) >> 3) * 3 * DM; }
        float accv[8];
        { const f32x4 b0 = *(const f32x4*)(cb + ch), b1 = *(const f32x4*)(cb + ch + 4);
#pragma unroll
          for (int k = 0; k < 4; ++k) { accv[k] = b0[k]; accv[4 + k] = b1[k]; } }
#pragma unroll
        for (int jj = 0; jj < 4; ++jj) {
            const int tt = t - 3 + jj;
            float xv[8];
            if (tt >= 0) { const u32x4 w = *(const u32x4*)(V + (size_t)(row - 3 + jj) * DM + ch);
                xv[0] = bflo(w.x); xv[1] = bfhi(w.x); xv[2] = bflo(w.y); xv[3] = bfhi(w.y); xv[4] = bflo(w.z); xv[5] = bfhi(w.z); xv[6] = bflo(w.w); xv[7] = bfhi(w.w); }
            else if (sb) { const f32x4 a = *(const f32x4*)(sb + (size_t)(tt + 3) * DM + ch), c = *(const f32x4*)(sb + (size_t)(tt + 3) * DM + ch + 4);
#pragma unroll
                for (int k = 0; k < 4; ++k) { xv[k] = a[k]; xv[4 + k] = c[k]; } }
            else {
#pragma unroll
                for (int k = 0; k < 8; ++k) xv[k] = 0.f; }
            const f32x4 w0 = *(const f32x4*)(cw + jj * DM + ch), w1 = *(const f32x4*)(cw + jj * DM + ch + 4);
#pragma unroll
            for (int k = 0; k < 4; ++k) { accv[k] += xv[k] * w0[k]; accv[4 + k] += xv[4 + k] * w1[k]; }
        }
        u32x4 w; w.x = cvt_pk_bf16(accv[0], accv[1]); w.y = cvt_pk_bf16(accv[2], accv[3]); w.z = cvt_pk_bf16(accv[4], accv[5]); w.w = cvt_pk_bf16(accv[6], accv[7]);
        *(u32x4*)(U + (size_t)row * DM + ch) = w;
        if (t >= T - 3) {
            const u32x4 vw = *(const u32x4*)(V + (size_t)row * DM + ch);
            float* dst = row < MP ? p.out + O_RCP + ((size_t)(row >> 12) * 3 + (t - (T - 3))) * DM + ch : p.out + O_RCS + ((size_t)((row - MP) >> 3) * 3 + (t - (T - 3))) * DM + ch;
            *(f32x4*)dst = (f32x4){bflo(vw.x), bfhi(vw.x), bflo(vw.y), bfhi(vw.y)}; *(f32x4*)(dst + 4) = (f32x4){bflo(vw.z), bfhi(vw.z), bflo(vw.w), bfhi(vw.w)};
        }
    }
}
__device__ __forceinline__ void rgscan_phase(const Params& p, LAS unsigned char* lds, int vcu, int G, const int tid) {
    const int lane = tid & 63, wave = tid >> 6;
    bf16_t* GATE = (bf16_t*)(p.ws + WS_S0); const bf16_t* LA = (const bf16_t*)(p.ws + WS_S1); const bf16_t* Bv = (const bf16_t*)(p.ws + WS_S2);
    LAS float* sm = (LAS float*)lds;
    for (int un = vcu; un < 256; un += G) {
        const int b = un >> 6, ch = (un & 63) * 16 + (lane & 15), chunk = wave * 4 + (lane >> 4);
        const size_t base = (size_t)(b * SEQ + chunk * 128) * DM + ch;
        float Ap = 0.f, Bp = 0.f;
        for (int t0 = 0; t0 < 128; t0 += 32) {
            unsigned short lv[32], bv_[32];
#pragma unroll
            for (int t = 0; t < 32; ++t) { lv[t] = LA[base + (size_t)(t0 + t) * DM]; bv_[t] = Bv[base + (size_t)(t0 + t) * DM]; }
#pragma unroll
            for (int t = 0; t < 32; ++t) { const float l2 = bf2f(lv[t]); Ap += l2; Bp = __builtin_amdgcn_exp2f(l2) * Bp + bf2f(bv_[t]); }
        }
        sm[(chunk * 16 + (lane & 15)) * 2] = __builtin_amdgcn_exp2f(Ap); sm[(chunk * 16 + (lane & 15)) * 2 + 1] = Bp;
        __syncthreads();
        float hcur = 0.f;
        for (int c = 0; c < chunk; ++c) hcur = sm[(c * 16 + (lane & 15)) * 2] * hcur + sm[(c * 16 + (lane & 15)) * 2 + 1];
        for (int t0 = 0; t0 < 128; t0 += 32) {
            unsigned short lv[32], bv_[32], gv_[32];
#pragma unroll
            for (int t = 0; t < 32; ++t) { lv[t] = LA[base + (size_t)(t0 + t) * DM]; bv_[t] = Bv[base + (size_t)(t0 + t) * DM]; gv_[t] = GATE[base + (size_t)(t0 + t) * DM]; }
#pragma unroll
            for (int t = 0; t < 32; ++t) { hcur = __builtin_amdgcn_exp2f(bf2f(lv[t])) * hcur + bf2f(bv_[t]); GATE[base + (size_t)(t0 + t) * DM] = (bf16_t)f2bf(hcur * bf2f(gv_[t])); }
        }
        if (chunk == 31) p.out[O_HP + (size_t)b * DM + ch] = hcur;
        __syncthreads();
    }
    const int gt = vcu * 512 + tid, NGT = G * 512;
    for (int e = gt; e < 128 * DM; e += NGT) {
        const int sq = e >> 10, ch = e & 1023; float hcur = p.in[4][e];
        const size_t base = (size_t)(MP + sq * 8) * DM + ch;
#pragma unroll
        for (int t = 0; t < 8; ++t) { const float l2 = bf2f(LA[base + (size_t)t * DM]); const float bb = bf2f(Bv[base + (size_t)t * DM]);
            hcur = __builtin_amdgcn_exp2f(l2) * hcur + bb; const float gt_ = bf2f(GATE[base + (size_t)t * DM]); GATE[base + (size_t)t * DM] = (bf16_t)f2bf(hcur * gt_); }
        p.out[O_HS + e] = hcur;
    }
}
__device__ __forceinline__ void scconv_phase(const Params& p, int vcu, int G, const int tid) {
    const int gt = vcu * 512 + tid, NGT = G * 512;
    const bf16_t* __restrict__ CX = (const bf16_t*)(p.ws + WS_S0); const bf16_t* __restrict__ BG = (const bf16_t*)(p.ws + WS_S1); bf16_t* __restrict__ YG = (bf16_t*)(p.ws + WS_S2);
    const float* __restrict__ cw = p.in[26]; const float* __restrict__ buf = p.in[6];
#pragma unroll 2
    for (int e = gt; e < M * 128; e += NGT) {
        const int row = e >> 7, ch = (e & 127) * 8;
        int t, T; const float* sb = nullptr;
        if (row < MP) { t = row & (SEQ - 1); T = SEQ; } else { t = (row - MP) & 7; T = 8; sb = buf + (size_t)((row - MP) >> 3) * 2 * DM; }
        float accv[8];
#pragma unroll
        for (int k = 0; k < 8; ++k) accv[k] = 0.f;
        u32x4 cur = (u32x4){0u, 0u, 0u, 0u};
#pragma unroll
        for (int jj = 0; jj < 3; ++jj) {
            const int tt = t - 2 + jj;
            float xv[8];
            if (tt >= 0) { const u32x4 w = *(const u32x4*)(CX + (size_t)(row - 2 + jj) * DM + ch); if (jj == 2) cur = w;
                xv[0] = bflo(w.x); xv[1] = bfhi(w.x); xv[2] = bflo(w.y); xv[3] = bfhi(w.y); xv[4] = bflo(w.z); xv[5] = bfhi(w.z); xv[6] = bflo(w.w); xv[7] = bfhi(w.w); }
            else if (sb) { const f32x4 a = *(const f32x4*)(sb + (size_t)(tt + 2) * DM + ch), c = *(const f32x4*)(sb + (size_t)(tt + 2) * DM + ch + 4);
#pragma unroll
                for (int k = 0; k < 4; ++k) { xv[k] = a[k]; xv[4 + k] = c[k]; } }
            else {
#pragma unroll
                for (int k = 0; k < 8; ++k) xv[k] = 0.f; }
            const f32x4 w0 = *(const f32x4*)(cw + jj * DM + ch), w1 = *(const f32x4*)(cw + jj * DM + ch + 4);
#pragma unroll
            for (int k = 0; k < 4; ++k) { accv[k] += xv[k] * w0[k]; accv[4 + k] += xv[4 + k] * w1[k]; }
        }
        const u32x4 g = *(const u32x4*)(BG + (size_t)row * DM + ch);
        u32x4 w; w.x = cvt_pk_bf16(accv[0] * bflo(g.x), accv[1] * bfhi(g.x)); w.y = cvt_pk_bf16(accv[2] * bflo(g.y), accv[3] * bfhi(g.y));
        w.z = cvt_pk_bf16(accv[4] * bflo(g.z), accv[5] * bfhi(g.z)); w.w = cvt_pk_bf16(accv[6] * bflo(g.w), accv[7] * bfhi(g.w));
        *(u32x4*)(YG + (size_t)row * DM + ch) = w;
        if (t >= T - 2) {
            float* dst = row < MP ? p.out + O_SCP + ((size_t)(row >> 12) * 2 + (t - (T - 2))) * DM + ch : p.out + O_SCS + ((size_t)((row - MP) >> 3) * 2 + (t - (T - 2))) * DM + ch;
            *(f32x4*)dst = (f32x4){bflo(cur.x), bfhi(cur.x), bflo(cur.y), bfhi(cur.y)}; *(f32x4*)(dst + 4) = (f32x4){bflo(cur.z), bfhi(cur.z), bflo(cur.w), bfhi(cur.w)};
        }
    }
}

#define XB_TMO      128
#define XB_XCNT(j)  (256  + 64 * (j))
#define XB_XSUB(j)  (1280 + 64 * (j))
#define XB_XGEN(j)  (2304 + 64 * (j))
#define XB_TOP      3328
#define XB_TOPGEN   3392
#define XCD_BAR_WORDS 3456
#define XB_SPIN_CAP (1u << 18)
__device__ __forceinline__ unsigned xb_ld(unsigned* p)              { return __hip_atomic_load(p, __ATOMIC_RELAXED, __HIP_MEMORY_SCOPE_AGENT); }
__device__ __forceinline__ unsigned xb_add(unsigned* p, unsigned v) { return __hip_atomic_fetch_add(p, v, __ATOMIC_RELAXED, __HIP_MEMORY_SCOPE_AGENT); }
__device__ __forceinline__ unsigned xb_xcc_id() { return (unsigned)__builtin_amdgcn_s_getreg((3 << 11) | 20) & 0xFu; }
#define XB_SPIN(cond, bar) do { unsigned _sp = 0; while (cond) { __builtin_amdgcn_s_sleep(1); \
    if ((++_sp & 255u) == 0u) { if (xb_ld(&(bar)[XB_TMO])) break; if (_sp > XB_SPIN_CAP) { atomicAdd(&(bar)[XB_TMO], 1u); break; } } } } while (0)
struct XcdBarrier { unsigned* bar; unsigned x; volatile LAS unsigned* st; };
__device__ __forceinline__ XcdBarrier xcd_barrier_post(unsigned* bar, volatile LAS unsigned* st) {
    XcdBarrier b; b.bar = bar; b.x = xb_xcc_id(); b.st = st;
    if (threadIdx.x == 0) (void)xb_add(&bar[XB_XCNT(b.x)], 1u);
    return b;
}
__device__ __forceinline__ void xcd_barrier_complete(unsigned* bar, unsigned x, unsigned& nloc, unsigned& nx) {
    const unsigned G = gridDim.x * gridDim.y * gridDim.z;
    unsigned sum, cnt, mine, sp = 0u;
    for (;;) {
        sum = 0u; cnt = 0u; mine = 0u;
#pragma unroll
        for (unsigned j = 0; j < 16; ++j) { const unsigned c = xb_ld(&bar[XB_XCNT(j)]); sum += c; cnt += (c > 0u) ? 1u : 0u; mine = (j == x) ? c : mine; }
        if (sum == G) break;
        __builtin_amdgcn_s_sleep(1);
        if ((++sp & 255u) == 0u) { if (xb_ld(&bar[XB_TMO])) break; if (sp > XB_SPIN_CAP) { atomicAdd(&bar[XB_TMO], 1u); break; } }
    }
    nloc = mine > 0u ? mine : 1u; nx = cnt > 0u ? cnt : 1u;
}
__device__ __forceinline__ void xcd_barrier(const XcdBarrier& b) {
    asm volatile("s_waitcnt vmcnt(0)" ::: "memory");
    __syncthreads();
    if (threadIdx.x == 0) {
        unsigned* bar = b.bar;
        __builtin_amdgcn_s_waitcnt(0);
        unsigned nloc = b.st[0], nx = b.st[1];
        if (nloc == 0u) { xcd_barrier_complete(bar, b.x, nloc, nx); b.st[0] = nloc; b.st[1] = nx; }
        const unsigned old = xb_add(&bar[XB_XSUB(b.x)], 1u);
        const unsigned gen = old / nloc;
        if (old + 1u == (gen + 1u) * nloc) {
            __builtin_amdgcn_fence(__ATOMIC_RELEASE, "agent");
            asm volatile("s_waitcnt vmcnt(0)" ::: "memory");
            const unsigned og = xb_add(&bar[XB_TOP], 1u);
            const unsigned tg = og / nx;
            if (og + 1u == (tg + 1u) * nx) xb_add(&bar[XB_TOPGEN], 1u);
            else XB_SPIN(xb_ld(&bar[XB_TOPGEN]) == tg, bar);
            __builtin_amdgcn_fence(__ATOMIC_ACQUIRE, "agent");
            xb_add(&bar[XB_XGEN(b.x)], 1u);
            asm volatile("s_waitcnt vmcnt(0)" ::: "memory");
        } else {
            XB_SPIN(xb_ld(&bar[XB_XGEN(b.x)]) == gen, bar);
            __builtin_amdgcn_fence(__ATOMIC_ACQUIRE, "agent");
            asm volatile("s_waitcnt vmcnt(0)" ::: "memory");
        }
    }
    __syncthreads();
}

enum Op { OP_PREP, OP_QKV, OP_ATTN, OP_RG1, OP_RGCONV, OP_RGGATES, OP_RGSCAN, OP_SC1, OP_SCCONV, OP_RESID_MIX, OP_NORM_F, OP_FFNUP, OP_RESID_FFN, OP_NORM_M };
constexpr int NSTEPS = 31;

__global__ void __launch_bounds__(512, 2) mega_fwd(Params p) {
    extern __shared__ __attribute__((aligned(16))) unsigned char lds_raw[];
    LAS unsigned char* lds = (LAS unsigned char*)lds_raw;
    const int G0 = gridDim.x, bx = blockIdx.x;
    volatile LAS unsigned* MISC = (volatile LAS unsigned*)(lds + 131072);
    if (threadIdx.x < 32) MISC[threadIdx.x] = 0u;
    __syncthreads();
    XcdBarrier bar = xcd_barrier_post((unsigned*)p.ws, MISC + 8);
    const int vcu0 = (G0 % 8 == 0) ? (bx % 8) * (G0 / 8) + bx / 8 : bx;
#if REP_MASK
    for (int it_ = 2 * p.ph_lo; it_ < 2 * p.ph_hi; ++it_) { const int step = it_ >> 1;
#else
    for (int step = p.ph_lo; step < p.ph_hi; ++step) {
#endif
        int tid = threadIdx.x, G = G0, vcu = vcu0; unsigned char* ws = p.ws; float* X = p.out;
        asm volatile("" : "+v"(tid)); asm volatile("" : "+s"(G)); asm volatile("" : "+s"(vcu)); asm volatile("" : "+s"(ws)); asm volatile("" : "+s"(X));
        bf16_t* XN = (bf16_t*)(ws + WS_XN);
        float* PART = (float*)(ws + WS_S3);
        int op, layer = 0;
        if (step == 0) op = OP_PREP;
        else {
            int s = step - 1, li;
            if (s < 7) { layer = 0; li = s; } else if (s < 16) { layer = 1; li = s - 7; } else if (s < 23) { layer = 2; li = s - 16; } else { layer = 3; li = s - 23; }
            const int kind = layer % 3, nmix = kind == 1 ? 4 : 2;
            if (li < nmix) op = kind == 0 ? (li == 0 ? OP_QKV : OP_ATTN) : kind == 1 ? (OP_RG1 + li) : (li == 0 ? OP_SC1 : OP_SCCONV);
            else op = OP_RESID_MIX + (li - nmix);
        }
        const int kind = layer % 3, j = layer / 3;
#if REP_MASK
        if ((it_ & 1) && !((REP_MASK >> op) & 1)) continue;
#endif
        pg8::GSched S; S.G = G; S.c = vcu; S.c2 = (int)blockIdx.x; S.mode = 0; S.nsplit = NSPLIT_MIX; S.lda = DM; S.ldb = DM; S.nt = 16; S.A = (const char*)XN;
        switch (op) {
        case OP_PREP: prep_phase(p, lds, vcu, G, tid); break;
        case OP_QKV: { S.Bt = (const char*)(ws + WS_WQKV + (size_t)j * NQKV * 1024 * 2); S.nN = 5;
            pg8::EpiQKV E{(bf16_t*)(ws + WS_S0), p.in[11] + j * NQKV, (const float*)(ws + WS_ROPE), (const float*)(ws + WS_RSTD)};
            pg8::gemm_phase<DM, DM>(lds, S, E, tid);
            if (layer == 0) convert_in_slack(p, ws, lds, 1, 68 * 5, vcu, G, tid); } break;
        case OP_ATTN: attn_phase(p, lds, j, vcu, G, tid); break;
        case OP_RG1: { S.Bt = (const char*)(ws + WS_WRG1); S.nN = 8;
            pg8::EpiPair<1> E{(bf16_t*)(ws + WS_S0), (bf16_t*)(ws + WS_S1), (const float*)(ws + WS_RSTD)};
            pg8::gemm_phase<DM, DM>(lds, S, E, tid);
            convert_in_slack(p, ws, lds, 2, 68 * 8, vcu, G, tid); } break;
        case OP_RGCONV: rgconv_phase(p, vcu, G, tid); break;
        case OP_RGGATES: { S.A = (const char*)(ws + WS_S3); S.Bt = (const char*)(ws + WS_WRG2); S.ldb = 256; S.nN = 8; S.nt = 4; S.mode = 2;
            pg8::EpiRgGates E{(const bf16_t*)(ws + WS_S3), (bf16_t*)(ws + WS_S1), (bf16_t*)(ws + WS_S2), p.in[20], p.in[22], (const float*)(ws + WS_C8)};
            pg8::gemm_phase<DM, 256>(lds, S, E, tid);
            convert_in_slack(p, ws, lds, 3, 68 * 8, vcu, G, tid); } break;
        case OP_RGSCAN: rgscan_phase(p, lds, vcu, G, tid); break;
        case OP_SC1: { S.Bt = (const char*)(ws + WS_WSC1); S.nN = 12;
            pg8::EpiPair<2> E{(bf16_t*)(ws + WS_S0), (bf16_t*)(ws + WS_S1), (const float*)(ws + WS_RSTD)};
            pg8::gemm_phase<DM, DM>(lds, S, E, tid);
            convert_in_slack(p, ws, lds, 4, 68 * 12, vcu, G, tid); } break;
        case OP_SCCONV: scconv_phase(p, vcu, G, tid); break;
        case OP_RESID_MIX: {
            const float* bias = (const float*)(ws + WS_ZB); S.nN = 4; S.mode = 1;
            if (kind == 0) { S.A = (const char*)(ws + WS_S2); S.Bt = (const char*)(ws + WS_WO + (size_t)j * 1024 * 1024 * 2); bias = p.in[13] + j * DM; }
            else if (kind == 1) { S.A = (const char*)(ws + WS_S0); S.Bt = (const char*)(ws + WS_WRG3); }
            else { S.A = (const char*)(ws + WS_S2); S.Bt = (const char*)(ws + WS_WSC2); }
            if (layer == 0) { pg8::EpiResid<true> E{p.in[0], PART, bias, XN, (float*)(ws + WS_SS)}; pg8::gemm_phase<DM, DM>(lds, S, E, tid); }
            else { pg8::EpiResid<false> E{nullptr, PART, bias, XN, (float*)(ws + WS_SS)}; pg8::gemm_phase<DM, DM>(lds, S, E, tid); }
            } break;
        case OP_RESID_FFN: {
            S.nN = 4; S.mode = 1; S.nsplit = NSPLIT_FFN; S.A = (const char*)(ws + WS_S0); S.lda = DFF; S.ldb = DFF; S.nt = 44; S.Bt = (const char*)(ws + WS_WFD + (size_t)layer * 1024 * DFF * 2);
            pg8::EpiResid<false> E{nullptr, PART, (const float*)(ws + WS_ZB), XN, (float*)(ws + WS_SS)};
            pg8::gemm_phase<DFF, DFF>(lds, S, E, tid); } break;
        case OP_NORM_F: fin_phase(layer == 0 ? p.in[1] : X + (size_t)MP * DM, X, PART, NSPLIT_MIX, kind == 0 ? p.in[13] + j * DM : nullptr, XN, (const float*)(ws + WS_SS), (float*)(ws + WS_RSTD), vcu, G, tid); break;
        case OP_FFNUP: { S.Bt = (const char*)(ws + WS_WFU + (size_t)layer * 5632 * 1024 * 2); S.nN = 22;
            pg8::EpiPair<0> E{(bf16_t*)(ws + WS_S0), nullptr, (const float*)(ws + WS_RSTD)};
            pg8::gemm_phase<DM, DM>(lds, S, E, tid); } break;
        case OP_NORM_M: if (layer == 3) norm_phase(X, PART, NSPLIT_FFN, nullptr, p.in[9], XN, true, vcu, G, tid);
                        else fin_phase(X + (size_t)MP * DM, X, PART, NSPLIT_FFN, nullptr, XN, (const float*)(ws + WS_SS), (float*)(ws + WS_RSTD), vcu, G, tid);
                        break;
        }
#if REP_MASK
        xcd_barrier(bar);
#else
        if (step + 1 < p.ph_hi) xcd_barrier(bar);
#endif
#if EXTRA_SYNC
        xcd_barrier(bar);
#endif
    }
}

#ifndef MK_N_LAUNCHES
#define MK_N_LAUNCHES 1
#endif
extern "C" void kernel_launch(void* const* d_in, const int* in_sizes, int n_in, void* d_out, int out_size, void* d_ws, size_t ws_size, hipStream_t stream) {
    static int grid = 0;
    if (grid == 0) {
        int dev = 0, cus = 0, per_cu = 0;
        hipGetDevice(&dev);
        hipDeviceGetAttribute(&cus, hipDeviceAttributeMultiprocessorCount, dev);
        hipFuncSetAttribute((const void*)mega_fwd, hipFuncAttributeMaxDynamicSharedMemorySize, LDS_BYTES);
        hipOccupancyMaxActiveBlocksPerMultiprocessor(&per_cu, (const void*)mega_fwd, 512, LDS_BYTES);
        if (per_cu < 1) { fprintf(stderr, "kernel_launch: occupancy query reports %d blocks per CU\n", per_cu); per_cu = 1; }
        if (per_cu > 1) per_cu = 1;
        grid = cus * per_cu;
        if (n_in != 31 || ws_size < 268 * MiB) fprintf(stderr, "kernel_launch: unexpected n_in %d / ws_size %zu\n", n_in, ws_size);
    }
    hipMemsetAsync(d_ws, 0, 16384, stream);
    Params p{};
    for (int i = 0; i < 31; ++i) p.in[i] = (const float*)d_in[i];
    p.out = (float*)d_out; p.ws = (unsigned char*)d_ws;
    const int nl = MK_N_LAUNCHES;
    for (int li = 0; li < nl; ++li) {
        p.ph_lo = (int)((long)NSTEPS * li / nl); p.ph_hi = (int)((long)NSTEPS * (li + 1) / nl);
        void* args[] = {&p};
        hipError_t e = hipLaunchCooperativeKernel((const void*)mega_fwd, dim3(grid), dim3(512), args, LDS_BYTES, stream);
        if (e != hipSuccess) fprintf(stderr, "cooperative launch failed: %s (grid %d)\n", hipGetErrorString(e), grid);
    }
}
```

```cpp
#include <hip/hip_runtime.h>
#include <hip/hip_cooperative_groups.h>
#include <cstdint>
#include <cstdio>
namespace cg = cooperative_groups;
#ifndef REP_MASK
#define REP_MASK 0
#endif
constexpr int NSPLIT_MIX = 4, NSPLIT_FFN = 8;
#ifndef EXTRA_SYNC
#define EXTRA_SYNC 0
#endif

#define LAS __attribute__((address_space(3)))
typedef unsigned short bf16_t;
typedef short bf16x8 __attribute__((ext_vector_type(8)));
typedef short s16x4 __attribute__((ext_vector_type(4)));
typedef float f32x4 __attribute__((ext_vector_type(4)));
typedef float f32x2 __attribute__((ext_vector_type(2)));
typedef float f32x16 __attribute__((ext_vector_type(16)));
typedef unsigned u32x4 __attribute__((ext_vector_type(4)));
typedef unsigned u32x2 __attribute__((ext_vector_type(2)));

constexpr int DM = 1024, MP = 16384, MS = 1024, M = MP + MS, SEQ = 4096, DFF = 2816, NQKV = 1280;
constexpr float EPS = 1e-6f, LOG2E = 1.4426950408889634f;
constexpr size_t MiB = 1u << 20;
constexpr size_t WS_ROPE = 1 * MiB;
constexpr size_t WS_RSTD = 4 * MiB;
constexpr size_t WS_SS = 5 * MiB;
constexpr size_t WS_ZB = 3 * MiB + 65536;
constexpr size_t WS_C8 = 3 * MiB;
constexpr size_t WS_WQKV = 8 * MiB;
constexpr size_t WS_WO = 13 * MiB;
constexpr size_t WS_WFU = 17 * MiB;
constexpr size_t WS_WFD = 61 * MiB;
constexpr size_t WS_WRG1 = 83 * MiB, WS_WRG2 = 87 * MiB, WS_WRG3 = 88 * MiB, WS_WSC1 = 90 * MiB, WS_WSC2 = 96 * MiB;
constexpr size_t WS_XN = 98 * MiB;
constexpr size_t SLOT = 34 * MiB;
constexpr size_t WS_S0 = 132 * MiB, WS_S1 = WS_S0 + SLOT, WS_S2 = WS_S1 + SLOT, WS_S3 = WS_S2 + SLOT;
constexpr size_t O_KP = 17825792, O_VP = 17956864, O_KS = 18087936, O_VS = 22282240, O_HP = 26476544, O_HS = 26480640,
                 O_RCP = 26611712, O_RCS = 26624000, O_SCP = 27017216, O_SCS = 27025408;

constexpr int LDS_BYTES = 131072 + 1024;

__device__ __forceinline__ unsigned cvt_pk_bf16(float lo, float hi) { unsigned r; asm volatile("v_cvt_pk_bf16_f32 %0, %1, %2" : "=v"(r) : "v"(lo), "v"(hi)); return r; }
__device__ __forceinline__ float bf2f(unsigned short v) { return __uint_as_float(((unsigned)v) << 16); }
__device__ __forceinline__ float bflo(unsigned w) { return __uint_as_float(w << 16); }
__device__ __forceinline__ float bfhi(unsigned w) { return __uint_as_float(w & 0xffff0000u); }
__device__ __forceinline__ float fast_sigmoid(float x) { return __builtin_amdgcn_rcpf(1.0f + __builtin_amdgcn_exp2f(-x * LOG2E)); }
__device__ __forceinline__ float wave_sum(float v) {
#pragma unroll
    for (int o = 1; o < 64; o <<= 1) v += __shfl_xor(v, o);
    return v;
}

__device__ __forceinline__ float xor16_add(float v) { const auto r = __builtin_amdgcn_permlane16_swap(__float_as_uint(v), __float_as_uint(v), false, false); return __uint_as_float(r[0]) + __uint_as_float(r[1]); }
__device__ __forceinline__ float xor32_add(float v) { const auto r = __builtin_amdgcn_permlane32_swap(__float_as_uint(v), __float_as_uint(v), false, false); return __uint_as_float(r[0]) + __uint_as_float(r[1]); }
namespace pg8 {
constexpr int BM = 256, BK = 64, HALF = 128, HTB = HALF * BK * 2, STAGE_BYTES = 8 * HTB;
__device__ __forceinline__ int lds_byte(int r, int c) { const int st = (r >> 4) * 2 + (c >> 5), rr = r & 15, cc = c & 31, ob = rr * 64 + cc * 2; return st * 1024 + (ob ^ (((ob >> 9) & 1) << 5)); }
__device__ __forceinline__ void stage_rc(int b, int& R, int& C) { const int st = b / 1024, sb = b % 1024, swz = sb ^ (((sb >> 9) & 1) << 5); R = (st >> 1) * 16 + swz / 64; C = (st & 1) * 32 + (swz % 64) / 2; }
__device__ __forceinline__ int perm32(int rho) { const int n = rho >> 4, i = rho & 15; return 8 * (i >> 2) + 4 * n + (i & 3); }

struct Unit { int pm, pn, nt, aux; const char* a; const char* b; };

struct GSched {
    const char* A; const char* Bt; int lda, ldb, nN, nt, mode, G, c, nsplit, c2;
    __device__ __forceinline__ bool next(int i, Unit& u) const {
        int L = i * G + c; const int nP = 64 * nN; int kt0 = 0; u.nt = nt; u.aux = 0;
        if (mode == 1) {
            const int nS = 4 * nsplit * nN;
            const bool hasS = (nS <= G) && (c2 < nS);
            if (nS <= G) {
                if (hasS && i == 0) L = c2; else L = nS + (i - (hasS ? 1 : 0)) * G + c;
            }
            if (L < nS) {
                const int sl = L % nsplit; u.pn = (L / nsplit) % nN; u.pm = 64 + (L / nsplit) / nN; u.aux = 1 + sl;
                const int q = (nt / (2 * nsplit)) * 2, extra = (nt - nsplit * q) >> 1;
                u.nt = sl < extra ? q + 2 : q; kt0 = sl < extra ? sl * (q + 2) : extra * (q + 2) + (sl - extra) * q;
            } else {
                L -= nS; if (L >= nP) return false;
                const int g = L / (8 * nN), r = L - g * 8 * nN; u.pm = 8 * g + (r & 7); u.pn = r >> 3;
            }
        } else if (L < nP) { const int g = L / (8 * nN), r = L - g * 8 * nN; u.pm = 8 * g + (r & 7); u.pn = r >> 3; }
        else { L -= nP; if (L >= 4 * nN) return false; u.pm = 64 + (L & 3); u.pn = L >> 2; }
        u.a = A + ((size_t)u.pm * 256 * lda + (size_t)kt0 * 64 + (mode == 2 ? 256 * (u.pn >> 1) : 0)) * 2;
        u.b = Bt + ((size_t)u.pn * 256 * ldb + (size_t)kt0 * 64) * 2;
        return true;
    }
};

template <int LDA, int LDB, class Epi>
__device__ __forceinline__ void gemm_phase(LAS unsigned char* lds, const GSched& S, const Epi& E, const int tid) {
    const int wid = __builtin_amdgcn_readfirstlane(tid >> 6), lane = tid & 63, wr = wid >> 2, wc = wid & 3, fr = lane & 15, fq = lane >> 4;
    constexpr int lda = LDA, ldb = LDB;
    unsigned voffA[2], voffB[2];
#pragma unroll
    for (int i = 0; i < 2; ++i) { int R, C; stage_rc(tid * 16 + i * 8192, R, C); const int Rb = Epi::PERM ? ((R & ~31) + perm32(R & 31)) : R;
        voffA[i] = (unsigned)(R * lda + C) * 2u; voffB[i] = (unsigned)(Rb * ldb + C) * 2u; }
    const size_t kstep = (size_t)(BK * 2);
    const size_t hstepA = (size_t)HALF * lda * 2, hstepB = (size_t)HALF * ldb * 2;
    const unsigned ldsw = (unsigned)wid * 1024u;
    const int aoff = lds_byte(wr * 64 + fr, fq * 8), boff = lds_byte(wc * 32 + fr, fq * 8);
#define PG8_SA(b, h) (((b) * 2 + (h)) * HTB)
#define PG8_SB(b, h) ((4 + (b) * 2 + (h)) * HTB)
#define PG8_STAGE(bufoff, gbase, voff) do { _Pragma("unroll") for (int _i = 0; _i < 2; ++_i) \
        __builtin_amdgcn_global_load_lds((const unsigned*)((const char*)(gbase) + (voff)[_i]), (LAS unsigned*)(lds + (bufoff) + ldsw + _i * 8192), 16, 0, 0); } while (0)
#define PG8_LDA(dst, b, h) do { _Pragma("unroll") for (int m = 0; m < 4; ++m) _Pragma("unroll") for (int k = 0; k < 2; ++k) dst[m][k] = *(const LAS bf16x8*)(lds + PG8_SA(b, h) + aoff + m * 2048 + k * 1024); } while (0)
#define PG8_LDB(dst, b, h) do { _Pragma("unroll") for (int n = 0; n < 2; ++n) _Pragma("unroll") for (int k = 0; k < 2; ++k) dst[n][k] = *(const LAS bf16x8*)(lds + PG8_SB(b, h) + boff + n * 2048 + k * 1024); } while (0)
#define PG8_MMA(ai, bj, At, Bt) do { __builtin_amdgcn_s_setprio(1); _Pragma("unroll") for (int m = 0; m < 4; ++m) _Pragma("unroll") for (int n = 0; n < 2; ++n) _Pragma("unroll") for (int k = 0; k < 2; ++k) \
        acc[ai][bj][m][n] = __builtin_amdgcn_mfma_f32_16x16x32_bf16(Bt[n][k], At[m][k], acc[ai][bj][m][n], 0, 0, 0); __builtin_amdgcn_s_setprio(0); } while (0)
#define PG8_WAIT_V(n) asm volatile("s_waitcnt vmcnt(" #n ")" ::: "memory")
#define PG8_WAIT_L(n) asm volatile("s_waitcnt lgkmcnt(" #n ")" ::: "memory")
#define PG8_BAR __builtin_amdgcn_s_barrier()
#define PG8_SCHED __builtin_amdgcn_sched_barrier(0)
    Unit cur, nxt; int ui = 0;
    if (!S.next(0, cur)) return;
    f32x4 acc[2][2][4][2];
#pragma unroll
    for (int a = 0; a < 2; ++a)
#pragma unroll
        for (int b = 0; b < 2; ++b)
#pragma unroll
            for (int m = 0; m < 4; ++m)
#pragma unroll
                for (int n = 0; n < 2; ++n) acc[a][b][m][n] = (f32x4){0.f, 0.f, 0.f, 0.f};
    bf16x8 At[4][2], B0[2][2], B1[2][2];
    const char* cA = cur.a; const char* cB = cur.b;
    PG8_STAGE(PG8_SB(0, 0), cB, voffB); PG8_STAGE(PG8_SB(0, 1), cB + hstepB, voffB); PG8_STAGE(PG8_SA(0, 0), cA, voffA); PG8_STAGE(PG8_SA(0, 1), cA + hstepA, voffA);
    if (wr == 1) PG8_BAR;
    PG8_WAIT_V(2); PG8_BAR;
    PG8_STAGE(PG8_SB(1, 0), cB + kstep, voffB); PG8_STAGE(PG8_SA(1, 0), cA + kstep, voffA); PG8_STAGE(PG8_SB(1, 1), cB + hstepB + kstep, voffB);
    PG8_WAIT_V(6); PG8_BAR;
    for (;;) {
        const bool has_next = S.next(ui + 1, nxt);
        const char* nA = has_next ? nxt.a : cA; const char* nB = has_next ? nxt.b : cB;
        const int nt = cur.nt;
        for (int t = 0; t < nt; t += 2) {
            const bool last = (t == nt - 2);
            const char* a1 = cA + (size_t)(t + 1) * kstep;
            const char* a2 = last ? nA : cA + (size_t)(t + 2) * kstep; const char* b2 = last ? nB : cB + (size_t)(t + 2) * kstep;
            const char* a3 = a2 + kstep; const char* b3 = b2 + kstep;
            PG8_LDB(B0, 0, 0); PG8_LDB(B1, 0, 1); PG8_SCHED; PG8_LDA(At, 0, 0); PG8_STAGE(PG8_SA(1, 1), a1 + hstepA, voffA);
            PG8_WAIT_V(8); PG8_WAIT_L(0); PG8_BAR; PG8_MMA(0, 0, At, B0); PG8_MMA(0, 1, At, B1); PG8_BAR; PG8_SCHED;
            PG8_LDA(At, 0, 1); PG8_STAGE(PG8_SB(0, 0), b2, voffB); PG8_STAGE(PG8_SB(0, 1), b2 + hstepB, voffB); PG8_STAGE(PG8_SA(0, 0), a2, voffA);
            PG8_WAIT_V(8); PG8_WAIT_L(0); PG8_BAR; PG8_MMA(1, 0, At, B0); PG8_MMA(1, 1, At, B1); PG8_BAR; PG8_SCHED;
            PG8_LDB(B0, 1, 0); PG8_LDB(B1, 1, 1); PG8_SCHED; PG8_LDA(At, 1, 0); PG8_STAGE(PG8_SA(0, 1), a2 + hstepA, voffA);
            PG8_WAIT_V(8); PG8_WAIT_L(0); PG8_BAR; PG8_MMA(0, 0, At, B0); PG8_MMA(0, 1, At, B1); PG8_BAR; PG8_SCHED;
            PG8_LDA(At, 1, 1); PG8_STAGE(PG8_SB(1, 0), b3, voffB); PG8_STAGE(PG8_SB(1, 1), b3 + hstepB, voffB); PG8_STAGE(PG8_SA(1, 0), a3, voffA);
            PG8_WAIT_V(8); PG8_WAIT_L(0); PG8_BAR; PG8_MMA(1, 0, At, B0); PG8_MMA(1, 1, At, B1); PG8_BAR; PG8_SCHED;
        }
        if (wr == 0) PG8_BAR;
        E(acc, cur, wr, wc, fr, fq);
        if (!has_next) break;
#pragma unroll
        for (int a = 0; a < 2; ++a)
#pragma unroll
            for (int b = 0; b < 2; ++b)
#pragma unroll
                for (int m = 0; m < 4; ++m)
#pragma unroll
                    for (int n = 0; n < 2; ++n) acc[a][b][m][n] = (f32x4){0.f, 0.f, 0.f, 0.f};
        cur = nxt; cA = nA; cB = nB; ++ui;
        if (wr == 1) PG8_BAR;
    }
    PG8_WAIT_V(0);
    PG8_BAR;
#undef PG8_SA
#undef PG8_SB
#undef PG8_STAGE
#undef PG8_LDA
#undef PG8_LDB
#undef PG8_MMA
#undef PG8_WAIT_V
#undef PG8_WAIT_L
#undef PG8_BAR
#undef PG8_SCHED
}

struct EpiQKV {
    static constexpr bool PERM = true;
    bf16_t* O; const float* bias; const float* rope; const float* rstd;
    __device__ __forceinline__ void operator()(const f32x4 (&acc)[2][2][4][2], const Unit& u, int wr, int wc, int fr, int fq) const {
        const int H = 4 * u.pn + wc, colb = H * 64 + 8 * fq;
        const f32x4 bl0 = *(const f32x4*)(bias + colb), bl1 = *(const f32x4*)(bias + colb + 4), bh0 = *(const f32x4*)(bias + colb + 32), bh1 = *(const f32x4*)(bias + colb + 36);
        const bool rot = H < 18;
        const int row0 = u.pm * 256 + wr * 64 + fr;
        float rs[8];
#pragma unroll
        for (int g = 0; g < 8; ++g) rs[g] = rstd[row0 + (g >> 2) * 128 + (g & 3) * 16];
        f32x4 cs[2][4];
#define QKV_LOADCS(g, b) do { const int row_ = row0 + ((g) >> 2) * 128 + ((g) & 3) * 16; const int pidx_ = row_ < MP ? (row_ & (SEQ - 1)) : SEQ + ((row_ - MP) & 7); \
            const float* rp_ = rope + (size_t)pidx_ * 64 + 8 * fq; cs[b][0] = *(const f32x4*)(rp_); cs[b][1] = *(const f32x4*)(rp_ + 4); cs[b][2] = *(const f32x4*)(rp_ + 32); cs[b][3] = *(const f32x4*)(rp_ + 36); } while (0)
        QKV_LOADCS(0, 0);
#pragma unroll
        for (int g = 0; g < 8; ++g) {
            const int ai = g >> 2, m = g & 3, b = g & 1;
            if (g + 1 < 8) QKV_LOADCS(g + 1, b ^ 1);
            const int row = row0 + ai * 128 + m * 16;
            f32x4 c0 = cs[b][0], c1 = cs[b][1], s0 = cs[b][2], s1 = cs[b][3];
            if (!rot) { c0 = (f32x4){1.f, 1.f, 1.f, 1.f}; c1 = c0; s0 = (f32x4){0.f, 0.f, 0.f, 0.f}; s1 = s0; }
            const float r = rs[g];
            const f32x4 l0 = acc[ai][0][m][0] * r + bl0, l1 = acc[ai][0][m][1] * r + bl1, h0 = acc[ai][1][m][0] * r + bh0, h1 = acc[ai][1][m][1] * r + bh1;
            const f32x4 ol0 = l0 * c0 - h0 * s0, ol1 = l1 * c1 - h1 * s1, oh0 = h0 * c0 + l0 * s0, oh1 = h1 * c1 + l1 * s1;
            bf16_t* op = O + (size_t)row * NQKV + colb;
            u32x4 w; w.x = cvt_pk_bf16(ol0[0], ol0[1]); w.y = cvt_pk_bf16(ol0[2], ol0[3]); w.z = cvt_pk_bf16(ol1[0], ol1[1]); w.w = cvt_pk_bf16(ol1[2], ol1[3]);
            *(u32x4*)op = w;
            w.x = cvt_pk_bf16(oh0[0], oh0[1]); w.y = cvt_pk_bf16(oh0[2], oh0[3]); w.z = cvt_pk_bf16(oh1[0], oh1[1]); w.w = cvt_pk_bf16(oh1[2], oh1[3]);
            *(u32x4*)(op + 32) = w;
        }
#undef QKV_LOADCS
    }
};
template <int MODE> struct EpiPair {
    static constexpr bool PERM = true;
    bf16_t* O0; bf16_t* O1; const float* rstd;
    __device__ __forceinline__ void operator()(const f32x4 (&acc)[2][2][4][2], const Unit& u, int wr, int wc, int fr, int fq) const {
        const int cc = 32 * wc + 8 * fq;
        float rsv[8];
#pragma unroll
        for (int g = 0; g < 8; ++g) rsv[g] = rstd[u.pm * 256 + wr * 64 + fr + (g >> 2) * 128 + (g & 3) * 16];
#pragma unroll
        for (int ai = 0; ai < 2; ++ai)
#pragma unroll
            for (int m = 0; m < 4; ++m) {
                const size_t row = (size_t)(u.pm * 256 + ai * 128 + wr * 64 + m * 16 + fr);
                const float rs = rsv[ai * 4 + m];
                f32x4 p0 = acc[ai][0][m][0] * rs, p1 = acc[ai][0][m][1] * rs, q0 = acc[ai][1][m][0] * rs, q1 = acc[ai][1][m][1] * rs;
                u32x4 w;
                if (MODE == 0) {
                    const float c1 = -rs * LOG2E, c2 = rs * rs;
                    const f32x4 a0 = acc[ai][0][m][0], a1 = acc[ai][0][m][1], b0 = acc[ai][1][m][0], b1 = acc[ai][1][m][1];
                    f32x4 t0 = a0 * c1, t1 = a1 * c1;
#pragma unroll
                    for (int j = 0; j < 4; ++j) { t0[j] = __builtin_amdgcn_exp2f(t0[j]); t1[j] = __builtin_amdgcn_exp2f(t1[j]); }
                    t0 = t0 + 1.0f; t1 = t1 + 1.0f;
#pragma unroll
                    for (int j = 0; j < 4; ++j) { t0[j] = __builtin_amdgcn_rcpf(t0[j]); t1[j] = __builtin_amdgcn_rcpf(t1[j]); }
                    p0 = (a0 * b0) * c2 * t0; p1 = (a1 * b1) * c2 * t1;
                    w.x = cvt_pk_bf16(p0[0], p0[1]); w.y = cvt_pk_bf16(p0[2], p0[3]); w.z = cvt_pk_bf16(p1[0], p1[1]); w.w = cvt_pk_bf16(p1[2], p1[3]);
                    { const bf16_t* q_ = O0 + row * DFF + 128 * u.pn + cc; asm volatile("global_store_dwordx4 %0, %1, off sc1\n\ts_nop 1" :: "v"(q_), "v"(w) : "memory"); }
                } else if (MODE == 1) {
#pragma unroll
                    for (int j = 0; j < 4; ++j) { float x = p0[j]; p0[j] = x * fast_sigmoid(1.5957691216f * (x + 0.044715f * x * x * x)); x = p1[j]; p1[j] = x * fast_sigmoid(1.5957691216f * (x + 0.044715f * x * x * x)); }
                    w.x = cvt_pk_bf16(p0[0], p0[1]); w.y = cvt_pk_bf16(p0[2], p0[3]); w.z = cvt_pk_bf16(p1[0], p1[1]); w.w = cvt_pk_bf16(p1[2], p1[3]);
                    *(u32x4*)(O0 + row * DM + 128 * u.pn + cc) = w;
                    w.x = cvt_pk_bf16(q0[0], q0[1]); w.y = cvt_pk_bf16(q0[2], q0[3]); w.z = cvt_pk_bf16(q1[0], q1[1]); w.w = cvt_pk_bf16(q1[2], q1[3]);
                    *(u32x4*)(O1 + row * DM + 128 * u.pn + cc) = w;
                } else {
                    if (u.pn < 8) {
                        p0 = p0 * q0; p1 = p1 * q1;
                        w.x = cvt_pk_bf16(p0[0], p0[1]); w.y = cvt_pk_bf16(p0[2], p0[3]); w.z = cvt_pk_bf16(p1[0], p1[1]); w.w = cvt_pk_bf16(p1[2], p1[3]);
                        *(u32x4*)(O0 + row * DM + 128 * u.pn + cc) = w;
                    } else {
                        w.x = cvt_pk_bf16(p0[0], p0[1]); w.y = cvt_pk_bf16(p0[2], p0[3]); w.z = cvt_pk_bf16(p1[0], p1[1]); w.w = cvt_pk_bf16(p1[2], p1[3]);
                        *(u32x4*)(O1 + row * DM + 256 * (u.pn - 8) + cc) = w;
                        w.x = cvt_pk_bf16(q0[0], q0[1]); w.y = cvt_pk_bf16(q0[2], q0[3]); w.z = cvt_pk_bf16(q1[0], q1[1]); w.w = cvt_pk_bf16(q1[2], q1[3]);
                        *(u32x4*)(O1 + row * DM + 256 * (u.pn - 8) + 128 + cc) = w;
                    }
                }
            }
    }
};
struct EpiRgGates {
    static constexpr bool PERM = true;
    const bf16_t* U; bf16_t* LA; bf16_t* Bv; const float* ba; const float* bx; const float* c8;
    __device__ __forceinline__ void operator()(const f32x4 (&acc)[2][2][4][2], const Unit& u, int wr, int wc, int fr, int fq) const {
        const int ch = 128 * u.pn + 32 * wc + 8 * fq;
        f32x4 vba[2], vbx[2], vc8[2];
#pragma unroll
        for (int n = 0; n < 2; ++n) { vba[n] = *(const f32x4*)(ba + ch + 4 * n); vbx[n] = *(const f32x4*)(bx + ch + 4 * n); vc8[n] = *(const f32x4*)(c8 + ch + 4 * n); }
        u32x4 uws[8];
#pragma unroll
        for (int g = 0; g < 8; ++g) uws[g] = *(const u32x4*)(U + (size_t)(u.pm * 256 + (g >> 2) * 128 + wr * 64 + (g & 3) * 16 + fr) * DM + ch);
#pragma unroll
        for (int ai = 0; ai < 2; ++ai)
#pragma unroll
            for (int m = 0; m < 4; ++m) {
                const size_t off = (size_t)(u.pm * 256 + ai * 128 + wr * 64 + m * 16 + fr) * DM + ch;
                const u32x4 uw = uws[ai * 4 + m];
                float la[8], bb[8];
#pragma unroll
                for (int n = 0; n < 2; ++n)
#pragma unroll
                    for (int j = 0; j < 4; ++j) {
                        const float r = fast_sigmoid(acc[ai][0][m][n][j] + vba[n][j]), ig = fast_sigmoid(acc[ai][1][m][n][j] + vbx[n][j]);
                        const float l2 = vc8[n][j] * r; const float a2 = __builtin_amdgcn_exp2f(2.f * l2);
                        const unsigned uu = uw[n * 2 + (j >> 1)]; const float uv = (j & 1) ? bfhi(uu) : bflo(uu);
                        la[n * 4 + j] = l2; bb[n * 4 + j] = __builtin_sqrtf(fmaxf(1.f - a2, 0.f)) * ig * uv;
                    }
                u32x4 w; w.x = cvt_pk_bf16(la[0], la[1]); w.y = cvt_pk_bf16(la[2], la[3]); w.z = cvt_pk_bf16(la[4], la[5]); w.w = cvt_pk_bf16(la[6], la[7]);
                *(u32x4*)(LA + off) = w;
                w.x = cvt_pk_bf16(bb[0], bb[1]); w.y = cvt_pk_bf16(bb[2], bb[3]); w.z = cvt_pk_bf16(bb[4], bb[5]); w.w = cvt_pk_bf16(bb[6], bb[7]);
                *(u32x4*)(Bv + off) = w;
            }
    }
};
template <bool FIRST> struct EpiResid {
    static constexpr bool PERM = true;
    const float* Xin; float* PART; const float* bias; bf16_t* XB; float* SS;
    __device__ __forceinline__ void operator()(const f32x4 (&acc)[2][2][4][2], const Unit& u, int wr, int wc, int fr, int fq) const {
        const int col0 = u.pn * 256 + wc * 32 + 8 * fq;
        if (u.aux == 0) {
            f32x4 bv[2][2];
#pragma unroll
            for (int bj = 0; bj < 2; ++bj)
#pragma unroll
                for (int n = 0; n < 2; ++n) bv[bj][n] = *(const f32x4*)(bias + col0 + bj * 128 + 4 * n);
            const size_t row0 = (size_t)(u.pm * 256 + wr * 64 + fr);
            f32x4 xin[2][4];
#define RES_LOAD(g, b) do { if (FIRST) { const float* xp_ = Xin + (row0 + ((g) >> 2) * 128 + ((g) & 3) * 16) * DM + col0; \
                    xin[b][0] = __builtin_nontemporal_load((const f32x4*)(xp_)); xin[b][1] = __builtin_nontemporal_load((const f32x4*)(xp_ + 4)); xin[b][2] = __builtin_nontemporal_load((const f32x4*)(xp_ + 128)); xin[b][3] = __builtin_nontemporal_load((const f32x4*)(xp_ + 132)); } \
                else { const bf16_t* xp_ = XB + (row0 + ((g) >> 2) * 128 + ((g) & 3) * 16) * DM + col0; \
                    _Pragma("unroll") for (int q_ = 0; q_ < 2; ++q_) { const u32x4 w_ = *(const u32x4*)(xp_ + q_ * 128); \
                        xin[b][2 * q_] = (f32x4){bflo(w_.x), bfhi(w_.x), bflo(w_.y), bfhi(w_.y)}; xin[b][2 * q_ + 1] = (f32x4){bflo(w_.z), bfhi(w_.z), bflo(w_.w), bfhi(w_.w)}; } } } while (0)
            RES_LOAD(0, 0);
#pragma unroll
            for (int g = 0; g < 8; ++g) {
                const int ai = g >> 2, m = g & 3, b = g & 1;
                if (g + 1 < 8) RES_LOAD(g + 1, b ^ 1);
                const size_t row = row0 + ai * 128 + m * 16;
                bf16_t* bp = XB + row * DM + col0;
                float ss = 0.f;
#pragma unroll
                for (int bj = 0; bj < 2; ++bj) {
                    const f32x4 v0 = xin[b][bj * 2] + acc[ai][bj][m][0] + bv[bj][0], v1 = xin[b][bj * 2 + 1] + acc[ai][bj][m][1] + bv[bj][1];
                    u32x4 w; w.x = cvt_pk_bf16(v0[0], v0[1]); w.y = cvt_pk_bf16(v0[2], v0[3]); w.z = cvt_pk_bf16(v1[0], v1[1]); w.w = cvt_pk_bf16(v1[2], v1[3]);
                    *(u32x4*)(bp + bj * 128) = w;
                    ss += ((v0[0] * v0[0] + v0[1] * v0[1]) + (v0[2] * v0[2] + v0[3] * v0[3])) + ((v1[0] * v1[0] + v1[1] * v1[1]) + (v1[2] * v1[2] + v1[3] * v1[3]));
                }
                ss = xor16_add(ss); ss = xor32_add(ss);
                if (fq == 0) SS[row * 16 + u.pn * 4 + wc] = ss;
            }
#undef RES_LOAD
        } else {
            bf16_t* pp = (bf16_t*)PART + (size_t)(u.aux - 1) * MS * DM;
#pragma unroll
            for (int ai = 0; ai < 2; ++ai)
#pragma unroll
                for (int m = 0; m < 4; ++m) {
                    bf16_t* xp = pp + (size_t)(u.pm * 256 - MP + ai * 128 + wr * 64 + m * 16 + fr) * DM + col0;
#pragma unroll
                    for (int bj = 0; bj < 2; ++bj) {
                        const f32x4 v0 = acc[ai][bj][m][0], v1 = acc[ai][bj][m][1];
                        u32x4 w; w.x = cvt_pk_bf16(v0[0], v0[1]); w.y = cvt_pk_bf16(v0[2], v0[3]); w.z = cvt_pk_bf16(v1[0], v1[1]); w.w = cvt_pk_bf16(v1[2], v1[3]);
                        *(u32x4*)(xp + bj * 128) = w;
                    }
                }
        }
    }
};
}

struct Params { const float* in[31]; float* out; unsigned char* ws; int ph_lo, ph_hi; };

__device__ __forceinline__ unsigned f2bf(float f) { unsigned u = __builtin_bit_cast(unsigned, f); return (u + 0x7fffu + ((u >> 16) & 1u)) >> 16; }
__device__ __forceinline__ unsigned pk2(float lo, float hi) { return f2bf(lo) | (f2bf(hi) << 16); }

struct TItem { const float* S; int Ns, K, n0, k0; bf16_t* WT; const float* gk; };
__device__ __forceinline__ void titem_load(const TItem& t, float (&tv)[32], int lane) {
#pragma unroll
    for (int i = 0; i < 32; ++i) tv[i] = __builtin_nontemporal_load(t.S + (size_t)(t.k0 + 2 * i + (lane >> 5)) * t.Ns + (lane & 31));
}
__device__ __forceinline__ void titem_finish(const TItem& t, const float (&tv)[32], LAS float* scr, int lane) {
    const int c = lane & 7;
    f32x4 g0 = (f32x4){1.f, 1.f, 1.f, 1.f}, g1 = g0;
    if (t.gk) { g0 = *(const f32x4*)(t.gk + t.k0 + 8 * c); g1 = *(const f32x4*)(t.gk + t.k0 + 8 * c + 4); }
#pragma unroll
    for (int i = 0; i < 32; ++i) scr[(2 * i + (lane >> 5)) * 33 + (lane & 31)] = tv[i];
    asm volatile("s_waitcnt lgkmcnt(0)" ::: "memory");
#pragma unroll
    for (int j = 0; j < 4; ++j) { const int n = (lane >> 3) + 8 * j; const LAS float* s = scr + (8 * c) * 33 + n;
        u32x4 o; o.x = pk2(s[0 * 33] * g0.x, s[1 * 33] * g0.y); o.y = pk2(s[2 * 33] * g0.z, s[3 * 33] * g0.w); o.z = pk2(s[4 * 33] * g1.x, s[5 * 33] * g1.y); o.w = pk2(s[6 * 33] * g1.z, s[7 * 33] * g1.w);
        *(u32x4*)(t.WT + (size_t)(t.n0 + n) * t.K + t.k0 + 8 * c) = o; }
    asm volatile("s_waitcnt lgkmcnt(0)" ::: "memory");
}

__device__ __forceinline__ bool titem_decode(const Params& p, unsigned char* ws, int it, TItem& t) {
    constexpr int I_QKV = 16 * 40, I_SQ = 16 * 32, I_FU = 16 * 176, I_FD = 44 * 32, I_RG1 = 16 * 64, I_RG2 = 4 * 64, I_SC1 = 16 * 96;
    constexpr int NITEMS = 2 * I_QKV + 2 * I_SQ + 4 * I_FU + 4 * I_FD + I_RG1 + I_RG2 + I_SQ + I_SC1 + I_SQ;
    if (it >= NITEMS) return false;
        int r = it;
        const float* S; int Ns, K, n0, k0; bf16_t* WT; const float* gk = nullptr;
        if (r < 2 * I_QKV) { const int j = r / I_QKV; r -= j * I_QKV; K = 1024; const int nb = r % 40, kb = r / 40; k0 = 64 * kb; n0 = 32 * nb;
            const int pn = nb >> 3, bj = (nb >> 2) & 1, hh = nb & 3; Ns = NQKV; S = p.in[10] + (size_t)j * 1024 * NQKV + (4 * pn + hh) * 64 + 32 * bj; WT = (bf16_t*)(ws + WS_WQKV) + (size_t)j * NQKV * 1024; gk = p.in[7] + 3 * j * DM; }
        else if ((r -= 2 * I_QKV) < 2 * I_SQ) { const int j = r / I_SQ; r -= j * I_SQ; K = 1024; const int nb = r % 32, kb = r / 32; k0 = 64 * kb; n0 = 32 * nb; Ns = 1024; S = p.in[12] + (size_t)j * 1024 * 1024 + n0; WT = (bf16_t*)(ws + WS_WO) + (size_t)j * 1024 * 1024; }
        else if ((r -= 2 * I_SQ) < 4 * I_FU) { const int i = r / I_FU; r -= i * I_FU; K = 1024; const int nb = r % 176, kb = r / 176; k0 = 64 * kb; n0 = 32 * nb;
            const int pn = nb >> 3, bj = (nb >> 2) & 1, c32 = nb & 3; Ns = DFF; S = (bj ? p.in[29] : p.in[28]) + (size_t)i * 1024 * DFF + 128 * pn + 32 * c32; WT = (bf16_t*)(ws + WS_WFU) + (size_t)i * 5632 * 1024; gk = p.in[8] + i * DM; }
        else if ((r -= 4 * I_FU) < 4 * I_FD) { const int i = r / I_FD; r -= i * I_FD; K = DFF; const int nb = r % 32, kb = r / 32; k0 = 64 * kb; n0 = 32 * nb; Ns = 1024; S = p.in[30] + (size_t)i * DFF * 1024 + n0; WT = (bf16_t*)(ws + WS_WFD) + (size_t)i * 1024 * DFF; }
        else if ((r -= 4 * I_FD) < I_RG1) { K = 1024; const int nb = r % 64, kb = r / 64; k0 = 64 * kb; n0 = 32 * nb;
            const int pn = nb >> 3, bj = (nb >> 2) & 1, c32 = nb & 3; Ns = 1024; S = (bj ? p.in[16] : p.in[15]) + 128 * pn + 32 * c32; WT = (bf16_t*)(ws + WS_WRG1); gk = p.in[7] + 1 * DM; }
        else if ((r -= I_RG1) < I_RG2) { K = 256; const int nb = r % 64, kb = r / 64; k0 = 64 * kb; n0 = 32 * nb;
            const int pn = nb >> 3, bj = (nb >> 2) & 1, c32 = nb & 3; Ns = 256; S = (bj ? p.in[21] : p.in[19]) + (size_t)(pn >> 1) * 65536 + 128 * (pn & 1) + 32 * c32; WT = (bf16_t*)(ws + WS_WRG2); }
        else if ((r -= I_RG2) < I_SQ) { K = 1024; const int nb = r % 32, kb = r / 32; k0 = 64 * kb; n0 = 32 * nb; Ns = 1024; S = p.in[24] + n0; WT = (bf16_t*)(ws + WS_WRG3); }
        else if ((r -= I_SQ) < I_SC1) { K = 1024; const int nb = r % 96, kb = r / 96; k0 = 64 * kb; n0 = 32 * nb;
            const int pn = nb >> 3, bj = (nb >> 2) & 1, c32 = nb & 3; Ns = 3072;
            const int col = pn < 8 ? (bj ? 2048 : 1024) + 128 * pn + 32 * c32 : 256 * (pn - 8) + 128 * bj + 32 * c32; S = p.in[25] + col; WT = (bf16_t*)(ws + WS_WSC1); gk = p.in[7] + 2 * DM; }
        else { r -= I_SC1; K = 1024; const int nb = r % 32, kb = r / 32; k0 = 64 * kb; n0 = 32 * nb; Ns = 1024; S = p.in[27] + n0; WT = (bf16_t*)(ws + WS_WSC2); }
        t.S = S; t.Ns = Ns; t.K = K; t.n0 = n0; t.k0 = k0; t.WT = WT; t.gk = gk;
    return true;
}

__device__ __forceinline__ int set_size(int s) { return s == 0 ? 640 : s == 1 ? 6528 : s == 2 ? 6272 : s == 3 ? 4224 : 5376; }
__device__ __forceinline__ int set_item(int s, int k) {
    if (s == 0) return k;
    if (s == 1) { if (k < 512) return 1280 + k; k -= 512; if (k < 2816) return 2304 + k; k -= 2816; if (k < 1408) return 13568 + k; k -= 1408; return 19200 + k; }
    if (s == 2) { if (k < 2816) return 5120 + k; k -= 2816; if (k < 1408) return 14976 + k; k -= 1408; return 20992 + k; }
    if (s == 3) { if (k < 2816) return 7936 + k; k -= 2816; return 16384 + k; }
    if (k < 640) return 640 + k; k -= 640; if (k < 512) return 1792 + k; k -= 512; if (k < 2816) return 10752 + k; k -= 2816; return 17792 + k;
}
__device__ __forceinline__ void convert_set(const Params& p, unsigned char* ws, LAS float* scr, int set, int widx, int nw, int lane) {
    const int n = set_size(set);
    TItem cur, nxt; float tv[32], tn[32];
    int k = widx;
    bool has = k < n;
    if (has) { titem_decode(p, ws, set_item(set, k), cur); titem_load(cur, tv, lane); }
    while (has) {
        k += nw;
        const bool hn = k < n;
        if (hn) { titem_decode(p, ws, set_item(set, k), nxt); titem_load(nxt, tn, lane); }
        titem_finish(cur, tv, scr, lane);
#pragma unroll
        for (int i = 0; i < 32; ++i) tv[i] = tn[i];
        cur = nxt; has = hn;
    }
}
__device__ __forceinline__ void convert_in_slack(const Params& p, unsigned char* ws, LAS unsigned char* lds, int set, int nU, int vcu, int G, const int tid) {
    const int first = nU % G, nidle = first == 0 ? G : G - first;
    const int k0 = first == 0 ? 0 : first;
    if (vcu < k0) return;
    const int lane = tid & 63, wave = __builtin_amdgcn_readfirstlane(tid >> 6);
    convert_set(p, ws, (LAS float*)(lds + wave * 16384), set, (vcu - k0) * 8 + wave, nidle * 8, lane);
}

__device__ __forceinline__ void prep_phase(const Params& p, LAS unsigned char* lds, int vcu, int G, const int tid) {
    const int lane = tid & 63, wave = __builtin_amdgcn_readfirstlane(tid >> 6);
    LAS float* scr = (LAS float*)(lds + wave * 16384);
    const int gw = vcu * 8 + wave, NGW = G * 8;
    unsigned char* ws = p.ws;
    convert_set(p, ws, scr, 0, gw, NGW, lane);
    {
        float* rstd = (float*)(ws + WS_RSTD);
        for (int m = gw; m < M; m += NGW) {
            const float* src = m < MP ? p.in[0] + (size_t)m * DM : p.in[1] + (size_t)(m - MP) * DM;
            f32x4 v[4]; float s = 0.f;
#pragma unroll
            for (int j = 0; j < 4; ++j) { v[j] = __builtin_nontemporal_load((const f32x4*)src + lane + 64 * j); s += (v[j].x * v[j].x + v[j].y * v[j].y) + (v[j].z * v[j].z + v[j].w * v[j].w); }
            s = wave_sum(s);
            if (lane == 0) rstd[m] = 1.0f / sqrtf(s * (1.f / DM) + EPS);
            u32x2* no = (u32x2*)((bf16_t*)(ws + WS_XN) + (size_t)m * DM) + lane;
#pragma unroll
            for (int j = 0; j < 4; ++j) { u32x2 w; w.x = cvt_pk_bf16(v[j].x, v[j].y); w.y = cvt_pk_bf16(v[j].z, v[j].w); no[64 * j] = w; }
        }
    }
    {
        const int gt = vcu * 512 + tid, NGT = G * 512;
        float* rope = (float*)(ws + WS_ROPE);
        for (int e = gt; e < 4104 * 32; e += NGT) {
            const int pi = e >> 5, d = e & 31; const int pos = pi < SEQ ? pi : 8192 + (pi - SEQ);
            double inv = 1.0; for (int k = 0; k < d; ++k) inv *= 0.7498942093324559;
            const float ang = (float)pos * (float)inv;
            const double rev = (double)ang * 0.15915494309189535; const double fr = rev - __builtin_rint(rev);
            rope[(size_t)pi * 64 + d] = __builtin_amdgcn_cosf((float)fr); rope[(size_t)pi * 64 + 32 + d] = __builtin_amdgcn_sinf((float)fr);
        }
        float* c8 = (float*)(ws + WS_C8);
        for (int e = gt; e < 1024; e += NGT) { const float lam = p.in[23][e]; c8[e] = -8.0f * log1pf(__expf(-lam)) * LOG2E; ((float*)(ws + WS_ZB))[e] = 0.f; }
    }
}

__device__ __forceinline__ void norm_phase(float* X, const float* PART, int nsplit, const float* bias, const float* g, bf16_t* XN, bool final_, int vcu, int G, const int tid) {
    const int lane = tid & 63, wave = tid >> 6;
    const int gw = vcu * 8 + wave, NGW = G * 8;
    f32x4 gv[4];
#pragma unroll
    for (int j = 0; j < 4; ++j) gv[j] = *((const f32x4*)g + lane + 64 * j);
    for (int m = gw; m < M; m += NGW) {
        f32x4* xr = (f32x4*)(X + (size_t)m * DM) + lane;
        f32x4 v[4]; float s = 0.f;
        if (m >= MP) {
#pragma unroll
            for (int j = 0; j < 4; ++j) v[j] = xr[64 * j];
        } else {
            const u32x2* br = (const u32x2*)(XN + (size_t)m * DM) + lane;
#pragma unroll
            for (int j = 0; j < 4; ++j) { const u32x2 w = __builtin_nontemporal_load(br + 64 * j); v[j] = (f32x4){bflo(w.x), bfhi(w.x), bflo(w.y), bfhi(w.y)}; }
        }
        if (m >= MP) {
#pragma unroll 4
            for (int sl = 0; sl < nsplit; ++sl) { const u32x2* pr = (const u32x2*)((const bf16_t*)PART + ((size_t)sl * MS + (m - MP)) * DM) + lane;
#pragma unroll
                for (int j = 0; j < 4; ++j) { const u32x2 w = pr[64 * j]; v[j] += (f32x4){bflo(w.x), bfhi(w.x), bflo(w.y), bfhi(w.y)}; } }
            if (bias) {
#pragma unroll
                for (int j = 0; j < 4; ++j) v[j] += *((const f32x4*)bias + lane + 64 * j); }
            if (!final_) {
#pragma unroll
                for (int j = 0; j < 4; ++j) xr[64 * j] = v[j]; }
        }
#pragma unroll
        for (int j = 0; j < 4; ++j) s += (v[j].x * v[j].x + v[j].y * v[j].y) + (v[j].z * v[j].z + v[j].w * v[j].w);
        const float rstd = 1.0f / sqrtf(wave_sum(s) * (1.f / DM) + EPS);
        if (final_) {
#pragma unroll
            for (int j = 0; j < 4; ++j) __builtin_nontemporal_store(v[j] * rstd * gv[j], xr + 64 * j);
        } else {
            u32x2* no = (u32x2*)(XN + (size_t)m * DM) + lane;
#pragma unroll
            for (int j = 0; j < 4; ++j) { const f32x4 y = v[j] * rstd * gv[j]; u32x2 w; w.x = cvt_pk_bf16(y.x, y.y); w.y = cvt_pk_bf16(y.z, y.w); no[64 * j] = w; }
        }
    }
}

__device__ __forceinline__ void fin_phase(const float* Xin, float* X, const float* PART, int nsplit, const float* bias, bf16_t* XB, const float* SS, float* rstd, int vcu, int G, const int tid) {
    const int lane = tid & 63, wave = tid >> 6;
    const int gw = vcu * 8 + wave, NGW = G * 8;
    for (int r = gw; r < MS; r += NGW) {
        const int m = MP + r;
        f32x4* xr = (f32x4*)(X + (size_t)m * DM) + lane;
        const f32x4* xi = (const f32x4*)(Xin + (size_t)r * DM) + lane;
        f32x4 v[4]; float s = 0.f;
#pragma unroll
        for (int j = 0; j < 4; ++j) v[j] = xi[64 * j];
#pragma unroll 4
        for (int sl = 0; sl < nsplit; ++sl) { const u32x2* pr = (const u32x2*)((const bf16_t*)PART + ((size_t)sl * MS + r) * DM) + lane;
#pragma unroll
            for (int j = 0; j < 4; ++j) { const u32x2 w = pr[64 * j]; v[j] += (f32x4){bflo(w.x), bfhi(w.x), bflo(w.y), bfhi(w.y)}; } }
        if (bias) {
#pragma unroll
            for (int j = 0; j < 4; ++j) v[j] += *((const f32x4*)bias + lane + 64 * j); }
        u32x2* no = (u32x2*)(XB + (size_t)m * DM) + lane;
#pragma unroll
        for (int j = 0; j < 4; ++j) { xr[64 * j] = v[j]; u32x2 w; w.x = cvt_pk_bf16(v[j].x, v[j].y); w.y = cvt_pk_bf16(v[j].z, v[j].w); no[64 * j] = w;
            s += (v[j].x * v[j].x + v[j].y * v[j].y) + (v[j].z * v[j].z + v[j].w * v[j].w); }
        s = wave_sum(s);
        if (lane == 0) rstd[m] = 1.0f / sqrtf(s * (1.f / DM) + EPS);
    }
    const int gt = vcu * 512 + tid, NGT = G * 512;
    for (int m = NGT - 1 - gt; m < MP; m += NGT) {
        const f32x4* sp = (const f32x4*)(SS + (size_t)m * 16);
        const f32x4 a = sp[0], b = sp[1], c = sp[2], d = sp[3];
        const float s = ((a.x + a.y) + (a.z + a.w)) + ((b.x + b.y) + (b.z + b.w)) + ((c.x + c.y) + (c.z + c.w)) + ((d.x + d.y) + (d.z + d.w));
        rstd[m] = 1.0f / sqrtf(s * (1.f / DM) + EPS);
    }
}

constexpr int KS_PITCH = 72, VT_PITCH = 260;
constexpr int ATT_KS = 0, ATT_VT = 256 * KS_PITCH * 2;
__device__ __forceinline__ void attn_phase(const Params& p, LAS unsigned char* lds, int j, int vcu, int G, const int tid) {
    const int lane = tid & 63, wave = __builtin_amdgcn_readfirstlane(tid >> 6), l31 = lane & 31, hi = lane >> 5;
    const bf16_t* QKV = (const bf16_t*)(p.ws + WS_S0);
    bf16_t* O = (bf16_t*)(p.ws + WS_S2);
    LAS bf16_t* Ks = (LAS bf16_t*)(lds + ATT_KS);
    LAS bf16_t* Vt = (LAS bf16_t*)(lds + ATT_VT);
    const float* ck = p.in[2] + (size_t)j * 128 * 128 * 128;
    const float* cv = p.in[3] + (size_t)j * 128 * 128 * 128;
    {
        const int gt = vcu * 512 + tid, NGT = G * 512;
        float* kp = p.out + O_KP + (size_t)j * 65536; float* vp = p.out + O_VP + (size_t)j * 65536;
        for (int e = gt; e < 65536; e += NGT) { const int d = e & 127, t = (e >> 7) & 127, b = e >> 14; const size_t src = (size_t)(b * SEQ + SEQ - 128 + t) * NQKV + 1024 + d;
            kp[e] = bf2f(QKV[src]); vp[e] = bf2f(QKV[src + 128]); }
        float* ksn = p.out + O_KS + (size_t)j * 2097152; float* vsn = p.out + O_VS + (size_t)j * 2097152;
        f32x4 kv4[4], vv4[4];
#pragma unroll
        for (int it = 0; it < 4; ++it) {
            const int e4 = gt + it * NGT;
            if (e4 < 524288) { const int e = e4 * 4, d = e & 127, c = (e >> 7) & 127, b = e >> 14;
                if (c < 120) { kv4[it] = __builtin_nontemporal_load((const f32x4*)(ck + e + 8 * 128)); vv4[it] = __builtin_nontemporal_load((const f32x4*)(cv + e + 8 * 128)); }
                else { const size_t src = (size_t)(MP + b * 8 + c - 120) * NQKV + 1024 + d; const u32x2 kw = *(const u32x2*)(QKV + src), vw = *(const u32x2*)(QKV + src + 128);
                    kv4[it] = (f32x4){bflo(kw.x), bfhi(kw.x), bflo(kw.y), bfhi(kw.y)}; vv4[it] = (f32x4){bflo(vw.x), bfhi(vw.x), bflo(vw.y), bfhi(vw.y)}; } }
        }
#pragma unroll
        for (int it = 0; it < 4; ++it) { const int e4 = gt + it * NGT; if (e4 < 524288) { __builtin_nontemporal_store(kv4[it], (f32x4*)(ksn + (size_t)e4 * 4)); __builtin_nontemporal_store(vv4[it], (f32x4*)(vsn + (size_t)e4 * 4)); } }
        for (int e4 = gt + 4 * NGT; e4 < 524288; e4 += NGT) {
            const int e = e4 * 4, d = e & 127, c = (e >> 7) & 127, b = e >> 14;
            if (c < 120) { *(f32x4*)(ksn + e) = *(const f32x4*)(ck + e + 8 * 128); *(f32x4*)(vsn + e) = *(const f32x4*)(cv + e + 8 * 128); }
            else { const size_t src = (size_t)(MP + b * 8 + c - 120) * NQKV + 1024 + d; const u32x2 kw = *(const u32x2*)(QKV + src), vw = *(const u32x2*)(QKV + src + 128);
                *(f32x4*)(ksn + e) = (f32x4){bflo(kw.x), bfhi(kw.x), bflo(kw.y), bfhi(kw.y)}; *(f32x4*)(vsn + e) = (f32x4){bflo(vw.x), bfhi(vw.x), bflo(vw.y), bfhi(vw.y)}; }
        }
    }
    for (int un = vcu; un < 512; un += G) {
        const bool prompt = un < 256;
        int b, kvh, nb = 0;
        if (prompt) { b = un >> 6; kvh = (un >> 5) & 1; nb = un & 31; } else { const int s = un - 256; b = s >> 1; kvh = s & 1; }
        const int nkeys = prompt ? 256 : 160;
        for (int id = tid; id < nkeys * 8; id += 512) {
            const int key = id >> 3, ch = id & 7;
            u32x4 w = (u32x4){0u, 0u, 0u, 0u};
            if (prompt) { if (!(nb == 0 && key < 128)) w = *(const u32x4*)(QKV + (size_t)(b * SEQ + 128 * (nb - 1) + key) * NQKV + 1024 + kvh * 64 + 8 * ch); }
            else if (key < 128) { const float* s = ck + ((size_t)(b * 128 + key) * 2 + kvh) * 64 + 8 * ch; const f32x4 a = *(const f32x4*)s, c = *(const f32x4*)(s + 4);
                w.x = cvt_pk_bf16(a.x, a.y); w.y = cvt_pk_bf16(a.z, a.w); w.z = cvt_pk_bf16(c.x, c.y); w.w = cvt_pk_bf16(c.z, c.w); }
            else if (key < 136) w = *(const u32x4*)(QKV + (size_t)(MP + b * 8 + key - 128) * NQKV + 1024 + kvh * 64 + 8 * ch);
            *(LAS u32x4*)(Ks + key * KS_PITCH + 8 * ch) = w;
        }
        for (int id = tid; id < nkeys * 8; id += 512) {
            const int key = id % nkeys, ch = id / nkeys;
            u32x4 w = (u32x4){0u, 0u, 0u, 0u};
            if (prompt) { if (!(nb == 0 && key < 128)) w = *(const u32x4*)(QKV + (size_t)(b * SEQ + 128 * (nb - 1) + key) * NQKV + 1152 + kvh * 64 + 8 * ch); }
            else if (key < 128) { const float* s = cv + ((size_t)(b * 128 + key) * 2 + kvh) * 64 + 8 * ch; const f32x4 a = *(const f32x4*)s, c = *(const f32x4*)(s + 4);
                w.x = cvt_pk_bf16(a.x, a.y); w.y = cvt_pk_bf16(a.z, a.w); w.z = cvt_pk_bf16(c.x, c.y); w.w = cvt_pk_bf16(c.z, c.w); }
            else if (key < 136) w = *(const u32x4*)(QKV + (size_t)(MP + b * 8 + key - 128) * NQKV + 1152 + kvh * 64 + 8 * ch);
            LAS bf16_t* vd = Vt + (8 * ch) * VT_PITCH + key;
            vd[0 * VT_PITCH] = (bf16_t)(w.x & 0xffff); vd[1 * VT_PITCH] = (bf16_t)(w.x >> 16); vd[2 * VT_PITCH] = (bf16_t)(w.y & 0xffff); vd[3 * VT_PITCH] = (bf16_t)(w.y >> 16);
            vd[4 * VT_PITCH] = (bf16_t)(w.z & 0xffff); vd[5 * VT_PITCH] = (bf16_t)(w.z >> 16); vd[6 * VT_PITCH] = (bf16_t)(w.w & 0xffff); vd[7 * VT_PITCH] = (bf16_t)(w.w >> 16);
        }
        __syncthreads();
        const int h = kvh * 8 + wave;
        const float sink8 = p.in[14][j * 16 + h] * 8.0f;
        const int nqs = prompt ? 4 : 1;
        for (int qs = 0; qs < nqs; ++qs) {
            const int qi = 32 * qs + l31;
            const bool qvalid = prompt || l31 < 8;
            const size_t qrow = prompt ? (size_t)(b * SEQ + 128 * nb + qi) : (size_t)(MP + b * 8 + (l31 < 8 ? l31 : 7));
            bf16x8 qf[4];
#pragma unroll
            for (int d0 = 0; d0 < 4; ++d0) qf[d0] = *(const bf16x8*)(QKV + qrow * NQKV + h * 64 + 16 * d0 + 8 * hi);
            constexpr float CS = 0.125f * LOG2E;
            float mrun = sink8, lrun = hi == 0 ? 1.f : 0.f;
            f32x16 o0 = {}, o1 = {};
            const int kt_lo = (prompt && nb == 0 && qs < 4) ? 4 : qs;
            for (int kt = kt_lo; kt < qs + 5; ++kt) {
                f32x16 s = {};
#pragma unroll
                for (int d0 = 0; d0 < 4; ++d0) { const bf16x8 kf = *(const LAS bf16x8*)(Ks + (32 * kt + l31) * KS_PITCH + 16 * d0 + 8 * hi); s = __builtin_amdgcn_mfma_f32_32x32x16_bf16(kf, qf[d0], s, 0, 0, 0); }
                if (kt == qs || kt == qs + 4) {
#pragma unroll
                    for (int r = 0; r < 16; ++r) { const int c = 32 * kt + (r & 3) + 8 * (r >> 2) + 4 * hi; const bool ok = (c > qi) && (c <= qi + 128); s[r] = ok ? s[r] : -1e30f; }
                }
                float mx = fmaxf(fmaxf(s[0], s[1]), fmaxf(s[2], s[3]));
#pragma unroll
                for (int r = 4; r < 16; r += 4) mx = fmaxf(mx, fmaxf(fmaxf(s[r], s[r + 1]), fmaxf(s[r + 2], s[r + 3])));
                mx = fmaxf(mx, __shfl_xor(mx, 32));
                if (__any(mx > mrun)) {
                    const float mnew = fmaxf(mrun, mx), alpha = __builtin_amdgcn_exp2f((mrun - mnew) * CS);
                    lrun *= alpha; mrun = mnew;
#pragma unroll
                    for (int r = 0; r < 16; ++r) { o0[r] *= alpha; o1[r] *= alpha; }
                }
                const float mc = -mrun * CS;
                float ps = 0.f;
#pragma unroll
                for (int r = 0; r < 16; ++r) { s[r] = __builtin_amdgcn_exp2f(__builtin_fmaf(s[r], CS, mc)); ps += s[r]; }
                lrun += ps;
#pragma unroll
                for (int ss = 0; ss < 2; ++ss) {
                    u32x4 pw; pw.x = cvt_pk_bf16(s[8 * ss + 0], s[8 * ss + 1]); pw.y = cvt_pk_bf16(s[8 * ss + 2], s[8 * ss + 3]); pw.z = cvt_pk_bf16(s[8 * ss + 4], s[8 * ss + 5]); pw.w = cvt_pk_bf16(s[8 * ss + 6], s[8 * ss + 7]);
                    const bf16x8 pb = __builtin_bit_cast(bf16x8, pw);
                    const LAS bf16_t* vb = Vt + l31 * VT_PITCH + 32 * kt + 16 * ss + 4 * hi;
                    const s16x4 a0 = *(const LAS s16x4*)(vb), a1 = *(const LAS s16x4*)(vb + 8);
                    const s16x4 c0 = *(const LAS s16x4*)(vb + 32 * VT_PITCH), c1 = *(const LAS s16x4*)(vb + 32 * VT_PITCH + 8);
                    const bf16x8 v0 = (bf16x8){a0[0], a0[1], a0[2], a0[3], a1[0], a1[1], a1[2], a1[3]};
                    const bf16x8 v1 = (bf16x8){c0[0], c0[1], c0[2], c0[3], c1[0], c1[1], c1[2], c1[3]};
                    o0 = __builtin_amdgcn_mfma_f32_32x32x16_bf16(v0, pb, o0, 0, 0, 0);
                    o1 = __builtin_amdgcn_mfma_f32_32x32x16_bf16(v1, pb, o1, 0, 0, 0);
                }
            }
            const float ltot = lrun + __shfl_xor(lrun, 32);
            const float inv = 1.0f / ltot;
            if (qvalid) {
                const size_t orow = prompt ? (size_t)(b * SEQ + 128 * nb + qi) : (size_t)(MP + b * 8 + l31);
                bf16_t* op = O + orow * DM + h * 64 + 4 * hi;
#pragma unroll
                for (int r4 = 0; r4 < 4; ++r4) {
                    u32x2 w; w.x = cvt_pk_bf16(o0[4 * r4] * inv, o0[4 * r4 + 1] * inv); w.y = cvt_pk_bf16(o0[4 * r4 + 2] * inv, o0[4 * r4 + 3] * inv); *(u32x2*)(op + 8 * r4) = w;
                    w.x = cvt_pk_bf16(o1[4 * r4] * inv, o1[4 * r4 + 1] * inv); w.y = cvt_pk_bf16(o1[4 * r4 + 2] * inv, o1[4 * r4 + 3] * inv); *(u32x2*)(op + 32 + 8 * r4) = w;
                }
            }
        }
        __syncthreads();
    }
}

__device__ __forceinline__ void rgconv_phase(const Params& p, int vcu, int G, const int tid) {
    const int gt = vcu * 512 + tid, NGT = G * 512;
    const bf16_t* __restrict__ V = (const bf16_t*)(p.ws + WS_S1); bf16_t* __restrict__ U = (bf16_t*)(p.ws + WS_S3);
    const float* __restrict__ cw = p.in[17]; const float* __restrict__ cb = p.in[18]; const float* __restrict__ buf = p.in[5];
#pragma unroll 2
    for (int e = gt; e < M * 128; e += NGT) {
        const int row = e >> 7, ch = (e & 127) * 8;
        int t, T; const float* sb = nullptr;
        if (row < MP) { t = row & (SEQ - 1); T = SEQ; } else { t = (row - MP) & 7; T = 8; sb = buf + (size_t)((row - MP) >> 3) * 3 * DM; }
        float accv[8];
        { const f32x4 b0 = *(const f32x4*)(cb + ch), b1 = *(const f32x4*)(cb + ch + 4);
#pragma unroll
          for (int k = 0; k < 4; ++k) { accv[k] = b0[k]; accv[4 + k] = b1[k]; } }
#pragma unroll
        for (int jj = 0; jj < 4; ++jj) {
            const int tt = t - 3 + jj;
            float xv[8];
            if (tt >= 0) { const u32x4 w = *(const u32x4*)(V + (size_t)(row - 3 + jj) * DM + ch);
                xv[0] = bflo(w.x); xv[1] = bfhi(w.x); xv[2] = bflo(w.y); xv[3] = bfhi(w.y); xv[4] = bflo(w.z); xv[5] = bfhi(w.z); xv[6] = bflo(w.w); xv[7] = bfhi(w.w); }
            else if (sb) { const f32x4 a = *(const f32x4*)(sb + (size_t)(tt + 3) * DM + ch), c = *(const f32x4*)(sb + (size_t)(tt + 3) * DM + ch + 4);
#pragma unroll
                for (int k = 0; k < 4; ++k) { xv[k] = a[k]; xv[4 + k] = c[k]; } }
            else {
#pragma unroll
                for (int k = 0; k < 8; ++k) xv[k] = 0.f; }
            const f32x4 w0 = *(const f32x4*)(cw + jj * DM + ch), w1 = *(const f32x4*)(cw + jj * DM + ch + 4);
#pragma unroll
            for (int k = 0; k < 4; ++k) { accv[k] += xv[k] * w0[k]; accv[4 + k] += xv[4 + k] * w1[k]; }
        }
        u32x4 w; w.x = cvt_pk_bf16(accv[0], accv[1]); w.y = cvt_pk_bf16(accv[2], accv[3]); w.z = cvt_pk_bf16(accv[4], accv[5]); w.w = cvt_pk_bf16(accv[6], accv[7]);
        *(u32x4*)(U + (size_t)row * DM + ch) = w;
        if (t >= T - 3) {
            const u32x4 vw = *(const u32x4*)(V + (size_t)row * DM + ch);
            float* dst = row < MP ? p.out + O_RCP + ((size_t)(row >> 12) * 3 + (t - (T - 3))) * DM + ch : p.out + O_RCS + ((size_t)((row - MP) >> 3) * 3 + (t - (T - 3))) * DM + ch;
            *(f32x4*)dst = (f32x4){bflo(vw.x), bfhi(vw.x), bflo(vw.y), bfhi(vw.y)}; *(f32x4*)(dst + 4) = (f32x4){bflo(vw.z), bfhi(vw.z), bflo(vw.w), bfhi(vw.w)};
        }
    }
}
__device__ __forceinline__ void rgscan_phase(const Params& p, LAS unsigned char* lds, int vcu, int G, const int tid) {
    const int lane = tid & 63, wave = tid >> 6;
    bf16_t* GATE = (bf16_t*)(p.ws + WS_S0); const bf16_t* LA = (const bf16_t*)(p.ws + WS_S1); const bf16_t* Bv = (const bf16_t*)(p.ws + WS_S2);
    LAS float* sm = (LAS float*)lds;
    for (int un = vcu; un < 256; un += G) {
        const int b = un >> 6, ch = (un & 63) * 16 + (lane & 15), chunk = wave * 4 + (lane >> 4);
        const size_t base = (size_t)(b * SEQ + chunk * 128) * DM + ch;
        float Ap = 0.f, Bp = 0.f;
        for (int t0 = 0; t0 < 128; t0 += 32) {
            unsigned short lv[32], bv_[32];
#pragma unroll
            for (int t = 0; t < 32; ++t) { lv[t] = LA[base + (size_t)(t0 + t) * DM]; bv_[t] = Bv[base + (size_t)(t0 + t) * DM]; }
#pragma unroll
            for (int t = 0; t < 32; ++t) { const float l2 = bf2f(lv[t]); Ap += l2; Bp = __builtin_amdgcn_exp2f(l2) * Bp + bf2f(bv_[t]); }
        }
        sm[(chunk * 16 + (lane & 15)) * 2] = __builtin_amdgcn_exp2f(Ap); sm[(chunk * 16 + (lane & 15)) * 2 + 1] = Bp;
        __syncthreads();
        float hcur = 0.f;
        for (int c = 0; c < chunk; ++c) hcur = sm[(c * 16 + (lane & 15)) * 2] * hcur + sm[(c * 16 + (lane & 15)) * 2 + 1];
        for (int t0 = 0; t0 < 128; t0 += 32) {
            unsigned short lv[32], bv_[32], gv_[32];
#pragma unroll
            for (int t = 0; t < 32; ++t) { lv[t] = LA[base + (size_t)(t0 + t) * DM]; bv_[t] = Bv[base + (size_t)(t0 + t) * DM]; gv_[t] = GATE[base + (size_t)(t0 + t) * DM]; }
#pragma unroll
            for (int t = 0; t < 32; ++t) { hcur = __builtin_amdgcn_exp2f(bf2f(lv[t])) * hcur + bf2f(bv_[t]); GATE[base + (size_t)(t0 + t) * DM] = (bf16_t)f2bf(hcur * bf2f(gv_[t])); }
        }
        if (chunk == 31) p.out[O_HP + (size_t)b * DM + ch] = hcur;
        __syncthreads();
    }
    const int gt = vcu * 512 + tid, NGT = G * 512;
    for (int e = gt; e < 128 * DM; e += NGT) {
        const int sq = e >> 10, ch = e & 1023; float hcur = p.in[4][e];
        const size_t base = (size_t)(MP + sq * 8) * DM + ch;
#pragma unroll
        for (int t = 0; t < 8; ++t) { const float l2 = bf2f(LA[base + (size_t)t * DM]); const float bb = bf2f(Bv[base + (size_t)t * DM]);
            hcur = __builtin_amdgcn_exp2f(l2) * hcur + bb; const float gt_ = bf2f(GATE[base + (size_t)t * DM]); GATE[base + (size_t)t * DM] = (bf16_t)f2bf(hcur * gt_); }
        p.out[O_HS + e] = hcur;
    }
}
__device__ __forceinline__ void scconv_phase(const Params& p, int vcu, int G, const int tid) {
    const int gt = vcu * 512 + tid, NGT = G * 512;
    const bf16_t* __restrict__ CX = (const bf16_t*)(p.ws + WS_S0); const bf16_t* __restrict__ BG = (const bf16_t*)(p.ws + WS_S1); bf16_t* __restrict__ YG = (bf16_t*)(p.ws + WS_S2);
    const float* __restrict__ cw = p.in[26]; const float* __restrict__ buf = p.in[6];
#pragma unroll 2
    for (int e = gt; e < M * 128; e += NGT) {
        const int row = e >> 7, ch = (e & 127) * 8;
        int t, T; const float* sb = nullptr;
        if (row < MP) { t = row & (SEQ - 1); T = SEQ; } else { t = (row - MP) & 7; T = 8; sb = buf + (size_t)((row - MP) >> 3) * 2 * DM; }
        float accv[8];
#pragma unroll
        for (int k = 0; k < 8; ++k) accv[k] = 0.f;
        u32x4 cur = (u32x4){0u, 0u, 0u, 0u};
#pragma unroll
        for (int jj = 0; jj < 3; ++jj) {
            const int tt = t - 2 + jj;
            float xv[8];
            if (tt >= 0) { const u32x4 w = *(const u32x4*)(CX + (size_t)(row - 2 + jj) * DM + ch); if (jj == 2) cur = w;
                xv[0] = bflo(w.x); xv[1] = bfhi(w.x); xv[2] = bflo(w.y); xv[3] = bfhi(w.y); xv[4] = bflo(w.z); xv[5] = bfhi(w.z); xv[6] = bflo(w.w); xv[7] = bfhi(w.w); }
            else if (sb) { const f32x4 a = *(const f32x4*)(sb + (size_t)(tt + 2) * DM + ch), c = *(const f32x4*)(sb + (size_t)(tt + 2) * DM + ch + 4);
#pragma unroll
                for (int k = 0; k < 4; ++k) { xv[k] = a[k]; xv[4 + k] = c[k]; } }
            else {
#pragma unroll
                for (int k = 0; k < 8; ++k) xv[k] = 0.f; }
            const f32x4 w0 = *(const f32x4*)(cw + jj * DM + ch), w1 = *(const f32x4*)(cw + jj * DM + ch + 4);
#pragma unroll
            for (int k = 0; k < 4; ++k) { accv[k] += xv[k] * w0[k]; accv[4 + k] += xv[4 + k] * w1[k]; }
        }
        const u32x4 g = *(const u32x4*)(BG + (size_t)row * DM + ch);
        u32x4 w; w.x = cvt_pk_bf16(accv[0] * bflo(g.x), accv[1] * bfhi(g.x)); w.y = cvt_pk_bf16(accv[2] * bflo(g.y), accv[3] * bfhi(g.y));
        w.z = cvt_pk_bf16(accv[4] * bflo(g.z), accv[5] * bfhi(g.z)); w.w = cvt_pk_bf16(accv[6] * bflo(g.w), accv[7] * bfhi(g.w));
        *(u32x4*)(YG + (size_t)row * DM + ch) = w;
        if (t >= T - 2) {
            float* dst = row < MP ? p.out + O_SCP + ((size_t)(row >> 12) * 2 + (t - (T - 2))) * DM + ch : p.out + O_SCS + ((size_t)((row - MP) >> 3) * 2 + (t - (T - 2))) * DM + ch;
            *(f32x4*)dst = (f32x4){bflo(cur.x), bfhi(cur.x), bflo(cur.y), bfhi(cur.y)}; *(f32x4*)(dst + 4) = (f32x4){bflo(cur.z), bfhi(cur.z), bflo(cur.w), bfhi(cur.w)};
        }
    }
}

#define XB_TMO      128
#define XB_XCNT(j)  (256  + 64 * (j))
#define XB_XSUB(j)  (1280 + 64 * (j))
#define XB_XGEN(j)  (2304 + 64 * (j))
#define XB_TOP      3328
#define XB_TOPGEN   3392
#define XCD_BAR_WORDS 3456
#define XB_SPIN_CAP (1u << 18)
__device__ __forceinline__ unsigned xb_ld(unsigned* p)              { return __hip_atomic_load(p, __ATOMIC_RELAXED, __HIP_MEMORY_SCOPE_AGENT); }
__device__ __forceinline__ unsigned xb_add(unsigned* p, unsigned v) { return __hip_atomic_fetch_add(p, v, __ATOMIC_RELAXED, __HIP_MEMORY_SCOPE_AGENT); }
__device__ __forceinline__ unsigned xb_xcc_id() { return (unsigned)__builtin_amdgcn_s_getreg((3 << 11) | 20) & 0xFu; }
#define XB_SPIN(cond, bar) do { unsigned _sp = 0; while (cond) { __builtin_amdgcn_s_sleep(1); \
    if ((++_sp & 255u) == 0u) { if (xb_ld(&(bar)[XB_TMO])) break; if (_sp > XB_SPIN_CAP) { atomicAdd(&(bar)[XB_TMO], 1u); break; } } } } while (0)
struct XcdBarrier { unsigned* bar; unsigned x; volatile LAS unsigned* st; };
__device__ __forceinline__ XcdBarrier xcd_barrier_post(unsigned* bar, volatile LAS unsigned* st) {
    XcdBarrier b; b.bar = bar; b.x = xb_xcc_id(); b.st = st;
    if (threadIdx.x == 0) (void)xb_add(&bar[XB_XCNT(b.x)], 1u);
    return b;
}
__device__ __forceinline__ void xcd_barrier_complete(unsigned* bar, unsigned x, unsigned& nloc, unsigned& nx) {
    const unsigned G = gridDim.x * gridDim.y * gridDim.z;
    unsigned sum, cnt, mine, sp = 0u;
    for (;;) {
        sum = 0u; cnt = 0u; mine = 0u;
#pragma unroll
        for (unsigned j = 0; j < 16; ++j) { const unsigned c = xb_ld(&bar[XB_XCNT(j)]); sum += c; cnt += (c > 0u) ? 1u : 0u; mine = (j == x) ? c : mine; }
        if (sum == G) break;
        __builtin_amdgcn_s_sleep(1);
        if ((++sp & 255u) == 0u) { if (xb_ld(&bar[XB_TMO])) break; if (sp > XB_SPIN_CAP) { atomicAdd(&bar[XB_TMO], 1u); break; } }
    }
    nloc = mine > 0u ? mine : 1u; nx = cnt > 0u ? cnt : 1u;
}
__device__ __forceinline__ void xcd_barrier(const XcdBarrier& b) {
    asm volatile("s_waitcnt vmcnt(0)" ::: "memory");
    __syncthreads();
    if (threadIdx.x == 0) {
        unsigned* bar = b.bar;
        __builtin_amdgcn_s_waitcnt(0);
        unsigned nloc = b.st[0], nx = b.st[1];
        if (nloc == 0u) { xcd_barrier_complete(bar, b.x, nloc, nx); b.st[0] = nloc; b.st[1] = nx; }
        const unsigned old = xb_add(&bar[XB_XSUB(b.x)], 1u);
        const unsigned gen = old / nloc;
        if (old + 1u == (gen + 1u) * nloc) {
            __builtin_amdgcn_fence(__ATOMIC_RELEASE, "agent");
            asm volatile("s_waitcnt vmcnt(0)" ::: "memory");
            const unsigned og = xb_add(&bar[XB_TOP], 1u);
            const unsigned tg = og / nx;
            if (og + 1u == (tg + 1u) * nx) xb_add(&bar[XB_TOPGEN], 1u);
            else XB_SPIN(xb_ld(&bar[XB_TOPGEN]) == tg, bar);
            __builtin_amdgcn_fence(__ATOMIC_ACQUIRE, "agent");
            xb_add(&bar[XB_XGEN(b.x)], 1u);
            asm volatile("s_waitcnt vmcnt(0)" ::: "memory");
        } else {
            XB_SPIN(xb_ld(&bar[XB_XGEN(b.x)]) == gen, bar);
            __builtin_amdgcn_fence(__ATOMIC_ACQUIRE, "agent");
            asm volatile("s_waitcnt vmcnt(0)" ::: "memory");
        }
    }
    __syncthreads();
}

enum Op { OP_PREP, OP_QKV, OP_ATTN, OP_RG1, OP_RGCONV, OP_RGGATES, OP_RGSCAN, OP_SC1, OP_SCCONV, OP_RESID_MIX, OP_NORM_F, OP_FFNUP, OP_RESID_FFN, OP_NORM_M };
constexpr int NSTEPS = 31;

__global__ void __launch_bounds__(512, 2) mega_fwd(Params p) {
    extern __shared__ __attribute__((aligned(16))) unsigned char lds_raw[];
    LAS unsigned char* lds = (LAS unsigned char*)lds_raw;
    const int G0 = gridDim.x, bx = blockIdx.x;
    volatile LAS unsigned* MISC = (volatile LAS unsigned*)(lds + 131072);
    if (threadIdx.x < 32) MISC[threadIdx.x] = 0u;
    __syncthreads();
    XcdBarrier bar = xcd_barrier_post((unsigned*)p.ws, MISC + 8);
    const int vcu0 = (G0 % 8 == 0) ? (bx % 8) * (G0 / 8) + bx / 8 : bx;
#if REP_MASK
    for (int it_ = 2 * p.ph_lo; it_ < 2 * p.ph_hi; ++it_) { const int step = it_ >> 1;
#else
    for (int step = p.ph_lo; step < p.ph_hi; ++step) {
#endif
        int tid = threadIdx.x, G = G0, vcu = vcu0; unsigned char* ws = p.ws; float* X = p.out;
        asm volatile("" : "+v"(tid)); asm volatile("" : "+s"(G)); asm volatile("" : "+s"(vcu)); asm volatile("" : "+s"(ws)); asm volatile("" : "+s"(X));
        bf16_t* XN = (bf16_t*)(ws + WS_XN);
        float* PART = (float*)(ws + WS_S3);
        int op, layer = 0;
        if (step == 0) op = OP_PREP;
        else {
            int s = step - 1, li;
            if (s < 7) { layer = 0; li = s; } else if (s < 16) { layer = 1; li = s - 7; } else if (s < 23) { layer = 2; li = s - 16; } else { layer = 3; li = s - 23; }
            const int kind = layer % 3, nmix = kind == 1 ? 4 : 2;
            if (li < nmix) op = kind == 0 ? (li == 0 ? OP_QKV : OP_ATTN) : kind == 1 ? (OP_RG1 + li) : (li == 0 ? OP_SC1 : OP_SCCONV);
            else op = OP_RESID_MIX + (li - nmix);
        }
        const int kind = layer % 3, j = layer / 3;
#if REP_MASK
        if ((it_ & 1) && !((REP_MASK >> op) & 1)) continue;
#endif
        pg8::GSched S; S.G = G; S.c = vcu; S.c2 = (int)blockIdx.x; S.mode = 0; S.nsplit = NSPLIT_MIX; S.lda = DM; S.ldb = DM; S.nt = 16; S.A = (const char*)XN;
        switch (op) {
        case OP_PREP: prep_phase(p, lds, vcu, G, tid); break;
        case OP_QKV: { S.Bt = (const char*)(ws + WS_WQKV + (size_t)j * NQKV * 1024 * 2); S.nN = 5;
            pg8::EpiQKV E{(bf16_t*)(ws + WS_S0), p.in[11] + j * NQKV, (const float*)(ws + WS_ROPE), (const float*)(ws + WS_RSTD)};
            pg8::gemm_phase<DM, DM>(lds, S, E, tid);
            if (layer == 0) convert_in_slack(p, ws, lds, 1, 68 * 5, vcu, G, tid); } break;
        case OP_ATTN: attn_phase(p, lds, j, vcu, G, tid); break;
        case OP_RG1: { S.Bt = (const char*)(ws + WS_WRG1); S.nN = 8;
            pg8::EpiPair<1> E{(bf16_t*)(ws + WS_S0), (bf16_t*)(ws + WS_S1), (const float*)(ws + WS_RSTD)};
            pg8::gemm_phase<DM, DM>(lds, S, E, tid);
            convert_in_slack(p, ws, lds, 2, 68 * 8, vcu, G, tid); } break;
        case OP_RGCONV: rgconv_phase(p, vcu, G, tid); break;
        case OP_RGGATES: { S.A = (const char*)(ws + WS_S3); S.Bt = (const char*)(ws + WS_WRG2); S.ldb = 256; S.nN = 8; S.nt = 4; S.mode = 2;
            pg8::EpiRgGates E{(const bf16_t*)(ws + WS_S3), (bf16_t*)(ws + WS_S1), (bf16_t*)(ws + WS_S2), p.in[20], p.in[22], (const float*)(ws + WS_C8)};
            pg8::gemm_phase<DM, 256>(lds, S, E, tid);
            convert_in_slack(p, ws, lds, 3, 68 * 8, vcu, G, tid); } break;
        case OP_RGSCAN: rgscan_phase(p, lds, vcu, G, tid); break;
        case OP_SC1: { S.Bt = (const char*)(ws + WS_WSC1); S.nN = 12;
            pg8::EpiPair<2> E{(bf16_t*)(ws + WS_S0), (bf16_t*)(ws + WS_S1), (const float*)(ws + WS_RSTD)};
            pg8::gemm_phase<DM, DM>(lds, S, E, tid);
            convert_in_slack(p, ws, lds, 4, 68 * 12, vcu, G, tid); } break;
        case OP_SCCONV: scconv_phase(p, vcu, G, tid); break;
        case OP_RESID_MIX: {
            const float* bias = (const float*)(ws + WS_ZB); S.nN = 4; S.mode = 1;
            if (kind == 0) { S.A = (const char*)(ws + WS_S2); S.Bt = (const char*)(ws + WS_WO + (size_t)j * 1024 * 1024 * 2); bias = p.in[13] + j * DM; }
            else if (kind == 1) { S.A = (const char*)(ws + WS_S0); S.Bt = (const char*)(ws + WS_WRG3); }
            else { S.A = (const char*)(ws + WS_S2); S.Bt = (const char*)(ws + WS_WSC2); }
            if (layer == 0) { pg8::EpiResid<true> E{p.in[0], PART, bias, XN, (float*)(ws + WS_SS)}; pg8::gemm_phase<DM, DM>(lds, S, E, tid); }
            else { pg8::EpiResid<false> E{nullptr, PART, bias, XN, (float*)(ws + WS_SS)}; pg8::gemm_phase<DM, DM>(lds, S, E, tid); }
            } break;
        case OP_RESID_FFN: {
            S.nN = 4; S.mode = 1; S.nsplit = NSPLIT_FFN; S.A = (const char*)(ws + WS_S0); S.lda = DFF; S.ldb = DFF; S.nt = 44; S.Bt = (const char*)(ws + WS_WFD + (size_t)layer * 1024 * DFF * 2);
            pg8::EpiResid<false> E{nullptr, PART, (const float*)(ws + WS_ZB), XN, (float*)(ws + WS_SS)};
            pg8::gemm_phase<DFF, DFF>(lds, S, E, tid); } break;
        case OP_NORM_F: fin_phase(layer == 0 ? p.in[1] : X + (size_t)MP * DM, X, PART, NSPLIT_MIX, kind == 0 ? p.in[13] + j * DM : nullptr, XN, (const float*)(ws + WS_SS), (float*)(ws + WS_RSTD), vcu, G, tid); break;
        case OP_FFNUP: { S.Bt = (const char*)(ws + WS_WFU + (size_t)layer * 5632 * 1024 * 2); S.nN = 22;
            pg8::EpiPair<0> E{(bf16_t*)(ws + WS_S0), nullptr, (const float*)(ws + WS_RSTD)};
            pg8::gemm_phase<DM, DM>(lds, S, E, tid); } break;
        case OP_NORM_M: if (layer == 3) norm_phase(X, PART, NSPLIT_FFN, nullptr, p.in[9], XN, true, vcu, G, tid);
                        else fin_phase(X + (size_t)MP * DM, X, PART, NSPLIT_FFN, nullptr, XN, (const float*)(ws + WS_SS), (float*)(ws + WS_RSTD), vcu, G, tid);
                        break;
        }
#if REP_MASK
        xcd_barrier(bar);
#else
        if (step + 1 < p.ph_hi) xcd_barrier(bar);
#endif
#if EXTRA_SYNC
        xcd_barrier(bar);
#endif
    }
}

#ifndef MK_N_LAUNCHES
#define MK_N_LAUNCHES 1
#endif
extern "C" void kernel_launch(void* const* d_in, const int* in_sizes, int n_in, void* d_out, int out_size, void* d_ws, size_t ws_size, hipStream_t stream) {
    static int grid = 0;
    if (grid == 0) {
        int dev = 0, cus = 0, per_cu = 0;
        hipGetDevice(&dev);
        hipDeviceGetAttribute(&cus, hipDeviceAttributeMultiprocessorCount, dev);
        hipFuncSetAttribute((const void*)mega_fwd, hipFuncAttributeMaxDynamicSharedMemorySize, LDS_BYTES);
        hipOccupancyMaxActiveBlocksPerMultiprocessor(&per_cu, (const void*)mega_fwd, 512, LDS_BYTES);
        if (per_cu < 1) { fprintf(stderr, "kernel_launch: occupancy query reports %d blocks per CU\n", per_cu); per_cu = 1; }
        if (per_cu > 1) per_cu = 1;
        grid = cus * per_cu;
        if (n_in != 31 || ws_size < 268 * MiB) fprintf(stderr, "kernel_launch: unexpected n_in %d / ws_size %zu\n", n_in, ws_size);
    }
    hipMemsetAsync(d_ws, 0, 16384, stream);
    Params p{};
    for (int i = 0; i < 31; ++i) p.in[i] = (const float*)d_in[i];
    p.out = (float*)d_out; p.ws = (unsigned char*)d_ws;
    const int nl = MK_N_LAUNCHES;
    for (int li = 0; li < nl; ++li) {
        p.ph_lo = (int)((long)NSTEPS * li / nl); p.ph_hi = (int)((long)NSTEPS * (li + 1) / nl);
        void* args[] = {&p};
        hipError_t e = hipLaunchCooperativeKernel((const void*)mega_fwd, dim3(grid), dim3(512), args, LDS_BYTES, stream);
        if (e != hipSuccess) fprintf(stderr, "cooperative launch failed: %s (grid %d)\n", hipGetErrorString(e), grid);
    }
}
```
